# Optimizing an MI355X kernel written in HIP

```python
import jax, jax.numpy as jnp
from jax import lax
import numpy as np

D_MODEL = 1024
BATCH = 8
SEQ = 4096
DEPTH = 2

HEAD_DIM = 64
ROPE_THETA = 10000.0
RMS_EPS = 1e-6

ATTN_HEADS = 8
ATTN_WIDTH = ATTN_HEADS * HEAD_DIM
MOBA_BLOCK = 256
MOBA_TOPK = 3
MOBA_QUERY_CHUNK = 16
NEG_INF = -1e30

CONV_WIDTH = 512
CONV_GROUPS = 8
CONV_KERNEL = 3

RET_HEADS = 4
RET_QK_WIDTH = RET_HEADS * HEAD_DIM
RET_V_DIM = 2 * HEAD_DIM
RET_V_WIDTH = RET_HEADS * RET_V_DIM
RET_CHUNK = 128

N_BRANCHES = 3
IN_PROJ_WIDTH = 3 * ATTN_WIDTH + 3 * CONV_WIDTH + 2 * RET_QK_WIDTH + 2 * RET_V_WIDTH + N_BRANCHES * D_MODEL

D_FF = 3584
N_EXPERTS = 8
TOP_K = 2
D_FF_EXPERT = 3584
N_DENSE = (DEPTH + 1) // 2
N_MOE = DEPTH // 2

kernel_name = "hybrid_moba_shortconv_retention_moe_block"


def rmsnorm(x, w):
    xf = x.astype(jnp.float32)
    y = xf * lax.rsqrt(jnp.mean(xf * xf, axis=-1, keepdims=True) + RMS_EPS)
    return y.astype(x.dtype) * w


def rope_tables(seq, dim):
    inv_freq = 1.0 / (ROPE_THETA ** (jnp.arange(0, dim, 2, dtype=jnp.float32) / dim))
    ang = jnp.arange(seq, dtype=jnp.float32)[:, None] * inv_freq[None, :]
    return jnp.cos(ang), jnp.sin(ang)


def apply_rope(x, cos, sin):
    x1, x2 = jnp.split(x, 2, axis=-1)
    c = cos[None, :, None, :]
    s = sin[None, :, None, :]
    return jnp.concatenate([x1 * c - x2 * s, x2 * c + x1 * s], axis=-1).astype(x.dtype)


def moba_attention(q, k, v):
    b, s, h, d = q.shape
    bh = b * h
    nb = -(-s // MOBA_BLOCK)
    pad = nb * MOBA_BLOCK - s
    k_p = jnp.pad(k, ((0, 0), (0, pad), (0, 0), (0, 0)))
    v_p = jnp.pad(v, ((0, 0), (0, pad), (0, 0), (0, 0)))
    kb = k_p.reshape(b, nb, MOBA_BLOCK, h, d).transpose(0, 3, 1, 2, 4).reshape(bh, nb, MOBA_BLOCK, d)
    vb = v_p.reshape(b, nb, MOBA_BLOCK, h, d).transpose(0, 3, 1, 2, 4).reshape(bh, nb, MOBA_BLOCK, d)
    qh = (q * HEAD_DIM ** -0.5).transpose(0, 2, 1, 3).reshape(bh, s, d)

    k_mean = jnp.mean(kb.astype(jnp.float32), axis=2)
    q_blk = jnp.arange(s) // MOBA_BLOCK
    gate = jnp.einsum('nsd,nkd->nsk', qh.astype(jnp.float32), k_mean)
    past = jnp.arange(nb)[None, :] < q_blk[:, None]
    gate = jnp.where(past[None], gate, -jnp.inf)
    n_sel = min(MOBA_TOPK, nb)
    _, sel = lax.top_k(gate, n_sel)
    valid = sel < q_blk[None, :, None]

    nq = s // MOBA_QUERY_CHUNK
    qc = qh.reshape(bh, nq, MOBA_QUERY_CHUNK, d).swapaxes(0, 1)
    selc = sel.reshape(bh, nq, MOBA_QUERY_CHUNK, n_sel).swapaxes(0, 1)
    valc = valid.reshape(bh, nq, MOBA_QUERY_CHUNK, n_sel).swapaxes(0, 1)
    bh_idx = jnp.arange(bh)[:, None, None]

    def one_chunk(args):
        c, q_c, sel_c, val_c = args
        j = (c * MOBA_QUERY_CHUNK) // MOBA_BLOCK
        k_sel = kb[bh_idx, sel_c]
        v_sel = vb[bh_idx, sel_c]
        s_sel = jnp.einsum('nqd,nqkld->nqkl', q_c, k_sel).astype(jnp.float32)
        s_sel = jnp.where(val_c[..., None], s_sel, NEG_INF)
        k_own = lax.dynamic_index_in_dim(kb, j, axis=1, keepdims=False)
        v_own = lax.dynamic_index_in_dim(vb, j, axis=1, keepdims=False)
        s_own = jnp.einsum('nqd,nld->nql', q_c, k_own).astype(jnp.float32)
        qpos = c * MOBA_QUERY_CHUNK + jnp.arange(MOBA_QUERY_CHUNK)
        kpos = j * MOBA_BLOCK + jnp.arange(MOBA_BLOCK)
        s_own = jnp.where((kpos[None, :] <= qpos[:, None])[None], s_own, NEG_INF)
        logits = jnp.concatenate([s_sel.reshape(bh, MOBA_QUERY_CHUNK, n_sel * MOBA_BLOCK), s_own], axis=-1)
        p = jax.nn.softmax(logits, axis=-1).astype(v.dtype)
        p_sel = p[..., :n_sel * MOBA_BLOCK].reshape(bh, MOBA_QUERY_CHUNK, n_sel, MOBA_BLOCK)
        p_own = p[..., n_sel * MOBA_BLOCK:]
        return (jnp.einsum('nqkl,nqkld->nqd', p_sel, v_sel)
                + jnp.einsum('nql,nld->nqd', p_own, v_own))

    out = lax.map(one_chunk, (jnp.arange(nq), qc, selc, valc))
    return out.swapaxes(0, 1).reshape(b, h, s, d).transpose(0, 2, 1, 3)


def retention(q, k, v):
    b, s, h, dk = q.shape
    dv = v.shape[-1]
    nc = s // RET_CHUNK
    log_g = jnp.log1p(-jnp.exp2(-5.0 - jnp.arange(h, dtype=jnp.float32)))
    n = jnp.arange(RET_CHUNK, dtype=jnp.float32)
    diff = n[:, None] - n[None, :]
    decay = jnp.where(diff[None] >= 0,
                      jnp.exp(jnp.maximum(diff, 0.0)[None] * log_g[:, None, None]), 0.0)
    xi = jnp.exp((n + 1.0)[None, :] * log_g[:, None]).T
    zeta = jnp.exp((RET_CHUNK - 1.0 - n)[None, :] * log_g[:, None]).T
    chunk_decay = jnp.exp(RET_CHUNK * log_g)

    def to_chunks(t):
        return t.astype(jnp.float32).reshape(b, nc, RET_CHUNK, h, t.shape[-1]).swapaxes(0, 1)

    def body(state, xs):
        q_i, k_i, v_i = xs
        scores = jnp.einsum('bnhd,bmhd->bhnm', q_i, k_i) * decay[None]
        o = jnp.einsum('bhnm,bmhe->bnhe', scores, v_i)
        o = o + jnp.einsum('bnhd,bhde->bnhe', q_i, state) * xi[None, :, :, None]
        state = (state * chunk_decay[None, :, None, None]
                 + jnp.einsum('bmhd,bmhe->bhde', k_i * zeta[None, :, :, None], v_i))
        return state, o

    state0 = jnp.zeros((b, h, dk, dv), jnp.float32)
    _, o = lax.scan(body, state0, (to_chunks(q), to_chunks(k), to_chunks(v)))
    return o.swapaxes(0, 1).reshape(b, s, h, dv).astype(v.dtype)


def hybrid_mixer(h, w_in, conv_w, conv_b, ret_norm_w, w_br_attn, w_br_conv, w_br_ret, w_out, cos, sin):
    b, s, _ = h.shape
    widths = (ATTN_WIDTH, ATTN_WIDTH, ATTN_WIDTH, CONV_WIDTH, CONV_WIDTH, CONV_WIDTH,
              RET_QK_WIDTH, RET_QK_WIDTH, RET_V_WIDTH, RET_V_WIDTH, N_BRANCHES * D_MODEL)
    points, acc = [], 0
    for wdt in widths[:-1]:
        acc += wdt
        points.append(acc)
    proj = h @ w_in
    aq, ak, av, cb, cc, ch, rq, rk, rv, rg, gates = jnp.split(proj, points, axis=-1)

    aq = apply_rope(aq.reshape(b, s, ATTN_HEADS, HEAD_DIM), cos, sin)
    ak = apply_rope(ak.reshape(b, s, ATTN_HEADS, HEAD_DIM), cos, sin)
    av = av.reshape(b, s, ATTN_HEADS, HEAD_DIM)
    y_attn = moba_attention(aq, ak, av).reshape(b, s, ATTN_WIDTH)

    u = cc * ch
    conv = lax.conv_general_dilated(u, conv_w[:, None, :], window_strides=(1,),
                                    padding=((CONV_KERNEL - 1, 0),),
                                    dimension_numbers=('NWC', 'WIO', 'NWC'),
                                    feature_group_count=CONV_WIDTH) + conv_b
    y_conv = cb * conv

    rq = apply_rope(rq.reshape(b, s, RET_HEADS, HEAD_DIM), cos, sin)
    rk = apply_rope(rk.reshape(b, s, RET_HEADS, HEAD_DIM), cos, sin) * HEAD_DIM ** -0.5
    rv = rv.reshape(b, s, RET_HEADS, RET_V_DIM)
    o = retention(rq, rk, rv)
    o = rmsnorm(o, ret_norm_w.reshape(RET_HEADS, RET_V_DIM)).reshape(b, s, RET_V_WIDTH)
    y_ret = jax.nn.silu(rg) * o

    g_attn, g_conv, g_ret = jnp.split(jax.nn.sigmoid(gates), N_BRANCHES, axis=-1)
    merged = (g_attn * (y_attn @ w_br_attn)
              + g_conv * (y_conv @ w_br_conv)
              + g_ret * (y_ret @ w_br_ret))
    return merged @ w_out


def swiglu(h, w_gate, w_up, w_down):
    return (jax.nn.silu(h @ w_gate) * (h @ w_up)) @ w_down


def moe_swiglu(h, w_router, w_gate, w_up, w_down):
    logits = (h @ w_router).astype(jnp.float32)
    top_v, top_i = lax.top_k(logits, TOP_K)
    top_p = jax.nn.softmax(top_v, axis=-1)
    combine = jnp.sum(jax.nn.one_hot(top_i, N_EXPERTS, dtype=jnp.float32) * top_p[..., None], axis=-2)
    combine = combine.astype(h.dtype)
    out = jnp.zeros_like(h)
    for e in range(N_EXPERTS):
        out = out + combine[..., e:e + 1] * swiglu(h, w_gate[e], w_up[e], w_down[e])
    return out


def setup_inputs(seed: int = 0) -> dict:
    key = jax.random.key(seed)
    ks = jax.random.split(key, 20)
    f32 = jnp.float32

    def nrm(k, shape, scale):
        return jax.random.normal(k, shape, f32) * scale

    def gain(k, shape):
        return 1.0 + 0.02 * jax.random.normal(k, shape, f32)

    return {
        "x": nrm(ks[0], (BATCH, SEQ, D_MODEL), 1.0),
        "mix_norm_w": gain(ks[1], (DEPTH, D_MODEL)),
        "w_in": nrm(ks[2], (DEPTH, D_MODEL, IN_PROJ_WIDTH), D_MODEL ** -0.5),
        "conv_w": nrm(ks[3], (DEPTH, CONV_KERNEL, CONV_WIDTH), CONV_KERNEL ** -0.5),
        "conv_b": nrm(ks[4], (DEPTH, CONV_WIDTH), 0.01),
        "ret_norm_w": gain(ks[5], (DEPTH, RET_V_WIDTH)),
        "w_br_attn": nrm(ks[6], (DEPTH, ATTN_WIDTH, D_MODEL), ATTN_WIDTH ** -0.5),
        "w_br_conv": nrm(ks[7], (DEPTH, CONV_WIDTH, D_MODEL), CONV_WIDTH ** -0.5),
        "w_br_ret": nrm(ks[8], (DEPTH, RET_V_WIDTH, D_MODEL), RET_V_WIDTH ** -0.5),
        "w_out": nrm(ks[9], (DEPTH, D_MODEL, D_MODEL), D_MODEL ** -0.5),
        "ffn_norm_w": gain(ks[10], (DEPTH, D_MODEL)),
        "dense_w_gate": nrm(ks[11], (N_DENSE, D_MODEL, D_FF), D_MODEL ** -0.5),
        "dense_w_up": nrm(ks[12], (N_DENSE, D_MODEL, D_FF), D_MODEL ** -0.5),
        "dense_w_down": nrm(ks[13], (N_DENSE, D_FF, D_MODEL), D_FF ** -0.5),
        "moe_router": nrm(ks[14], (N_MOE, D_MODEL, N_EXPERTS), D_MODEL ** -0.5),
        "moe_w_gate": nrm(ks[15], (N_MOE, N_EXPERTS, D_MODEL, D_FF_EXPERT), D_MODEL ** -0.5),
        "moe_w_up": nrm(ks[16], (N_MOE, N_EXPERTS, D_MODEL, D_FF_EXPERT), D_MODEL ** -0.5),
        "moe_w_down": nrm(ks[17], (N_MOE, N_EXPERTS, D_FF_EXPERT, D_MODEL), D_FF_EXPERT ** -0.5),
        "final_norm_w": gain(ks[18], (D_MODEL,)),
    }


def reference(x, mix_norm_w, w_in, conv_w, conv_b, ret_norm_w, w_br_attn, w_br_conv, w_br_ret,
              w_out, ffn_norm_w, dense_w_gate, dense_w_up, dense_w_down, moe_router,
              moe_w_gate, moe_w_up, moe_w_down, final_norm_w):
    cos, sin = rope_tables(x.shape[1], HEAD_DIM)
    for layer in range(DEPTH):
        h = rmsnorm(x, mix_norm_w[layer])
        x = x + hybrid_mixer(h, w_in[layer], conv_w[layer], conv_b[layer], ret_norm_w[layer],
                             w_br_attn[layer], w_br_conv[layer], w_br_ret[layer], w_out[layer],
                             cos, sin)
        h = rmsnorm(x, ffn_norm_w[layer])
        if layer % 2 == 0:
            i = layer // 2
            x = x + swiglu(h, dense_w_gate[i], dense_w_up[i], dense_w_down[i])
        else:
            i = layer // 2
            x = x + moe_swiglu(h, moe_router[i], moe_w_gate[i], moe_w_up[i], moe_w_down[i])
    return rmsnorm(x, final_norm_w)
```

```cpp
#include <hip/hip_runtime.h>
#include <hip/hip_bf16.h>
#include <cstdio>
#include <cstdint>
#include <cmath>

#ifndef MK_SPLIT
#define MK_SPLIT 0
#endif

namespace pg8 {
#define PG8_LAS __attribute__((address_space(3)))
typedef unsigned short bf16_t;
typedef short bf16x8 __attribute__((ext_vector_type(8)));
typedef float f32x4 __attribute__((ext_vector_type(4)));
typedef float f32x2 __attribute__((ext_vector_type(2)));
typedef unsigned u32x4 __attribute__((ext_vector_type(4)));
typedef unsigned u32x2 __attribute__((ext_vector_type(2)));
constexpr int BM = 256, BK = 64, HALF = 128, HTB = HALF * BK * 2  , STAGE_BYTES = 8 * HTB, NXCD = 8, WGM = 8;

__host__ __device__ __forceinline__ int lds_byte(int r, int c) { const int st = (r >> 4) * 2 + (c >> 5), rr = r & 15, cc = c & 31, ob = rr * 64 + cc * 2; return st * 1024 + (ob ^ (((ob >> 9) & 1) << 5)); }
__host__ __device__ __forceinline__ void stage_rc(int b, int& R, int& C) { const int st = b / 1024, sb = b % 1024, swz = sb ^ (((sb >> 9) & 1) << 5); R = (st >> 1) * 16 + swz / 64; C = (st & 1) * 32 + (swz % 64) / 2; }
__host__ __device__ __forceinline__ int perm32(int rho) { const int n = rho >> 4, i = rho & 15; return 8 * (i >> 2) + 4 * n + (i & 3); }

struct Unit { int pm, pn, z; };

struct TileOrder {
    int nM, nN, nwg, G, c;
    __device__ __forceinline__ void init(int nM_, int nN_, int G_, int c_) { nM = nM_; nN = nN_; nwg = nM * nN; G = G_; c = c_; }
    __device__ __forceinline__ bool tile(int i, int& pm, int& pn) const {
        const long L = (long)i * G + c; if (L >= nwg) return false;
        int wgid = (int)L; { const int q = nwg / NXCD, r = nwg % NXCD, xcd = wgid % NXCD, off = wgid / NXCD; wgid = (xcd < r ? xcd * (q + 1) : r * (q + 1) + (xcd - r) * q) + off; }
        const int nig = WGM * nN, gid = wgid / nig, fm = gid * WGM, gsz = (nM - fm) < WGM ? (nM - fm) : WGM;
        pm = fm + ((wgid % nig) % gsz); pn = (wgid % nig) / gsz; return true;
    }
};
struct SchedStd {
    TileOrder T; const char* A; const char* B; size_t atile, btile;
    __device__ __forceinline__ bool next(int i, Unit& u) const { u.z = 0; return T.tile(i, u.pm, u.pn); }
    __device__ __forceinline__ const char* a_ptr(const Unit& u) const { return A + (size_t)u.pm * atile; }
    __device__ __forceinline__ const char* b_ptr(const Unit& u) const { return B + (size_t)u.pn * btile; }
};
struct SchedBranch {
    TileOrder T; const char* A; const char* B; size_t atile, btile, bmat;
    __device__ __forceinline__ bool next(int i, Unit& u) const { u.z = i % 3; return T.tile(i / 3, u.pm, u.pn); }
    __device__ __forceinline__ const char* a_ptr(const Unit& u) const { return A + (size_t)u.pm * atile + (size_t)((256 * u.z * u.z + 1280 * u.z) * 2); }
    __device__ __forceinline__ const char* b_ptr(const Unit& u) const { return B + (size_t)u.z * bmat + (size_t)u.pn * btile; }
};
struct SchedMoe {
    TileOrder T; const char* A; const char* B; size_t atile, btile, bexp; const PG8_LAS int* tbase;
    __device__ __forceinline__ bool next(int i, Unit& u) const { u.z = 0; return T.tile(i, u.pm, u.pn); }
    __device__ __forceinline__ const char* a_ptr(const Unit& u) const { return A + (size_t)u.pm * atile; }
    __device__ __forceinline__ const char* b_ptr(const Unit& u) const {
        int e = 0;
#pragma unroll
        for (int j = 1; j < 8; ++j) e += (u.pm >= tbase[j]) ? 1 : 0;
        return B + (size_t)e * bexp + (size_t)u.pn * btile; }
};

__device__ __forceinline__ unsigned cvt_pk_bf16(float lo, float hi) { unsigned r; asm volatile("v_cvt_pk_bf16_f32 %0, %1, %2" : "=v"(r) : "v"(lo), "v"(hi)); return r; }
__device__ __forceinline__ float bf_lo(unsigned w) { return __builtin_bit_cast(float, w << 16); }
__device__ __forceinline__ float bf_hi(unsigned w) { return __builtin_bit_cast(float, w & 0xffff0000u); }
__device__ __forceinline__ float fsigmoid(float x) { return __builtin_amdgcn_rcpf(1.0f + __builtin_amdgcn_exp2f(-1.4426950408889634f * x)); }

template <class Epi, class Sched>
__device__ __forceinline__ void gemm_phase(PG8_LAS unsigned char* lds, const int K, const int lda, const int ldb, const Sched& S, const Epi& E) {
    int tid_ = threadIdx.x; asm volatile("" : "+v"(tid_));
    const int tid = tid_, wid = __builtin_amdgcn_readfirstlane(tid >> 6), lane = tid & 63, wr = wid >> 2, wc = wid & 3, fr = lane & 15, fq = lane >> 4;
    const int nt = K / BK;
    unsigned voffA[2], voffB[2];
#pragma unroll
    for (int i = 0; i < 2; ++i) { int R, C; stage_rc(tid * 16 + i * 8192, R, C); const int Rb = Epi::PERM ? ((R & ~31) + perm32(R & 31)) : R;
        voffA[i] = (unsigned)(R * lda + C) * 2u; voffB[i] = (unsigned)(Rb * ldb + C) * 2u; }
    const size_t kstep = (size_t)(BK * 2);
    const size_t hsA = (size_t)HALF * lda * 2, hsB = (size_t)HALF * ldb * 2;
    const unsigned ldsw = (unsigned)wid * 1024u;
    const int aoff = lds_byte(wr * 64 + fr, fq * 8), boff = lds_byte(wc * 32 + fr, fq * 8);
#define PG8_SA(b, h) (((b) * 2 + (h)) * HTB)
#define PG8_SB(b, h) ((4 + (b) * 2 + (h)) * HTB)
#define PG8_STAGE(bufoff, gbase, voff) do { _Pragma("unroll") for (int _i = 0; _i < 2; ++_i) \
        __builtin_amdgcn_global_load_lds((const unsigned*)((const char*)(gbase) + (voff)[_i]), (PG8_LAS unsigned*)(lds + (bufoff) + ldsw + _i * 8192), 16, 0, 0); } while (0)
#define PG8_LDA(dst, b, h) do { _Pragma("unroll") for (int m = 0; m < 4; ++m) _Pragma("unroll") for (int k = 0; k < 2; ++k) dst[m][k] = *(const PG8_LAS bf16x8*)(lds + PG8_SA(b, h) + aoff + m * 2048 + k * 1024); } while (0)
#define PG8_LDB(dst, b, h) do { _Pragma("unroll") for (int n = 0; n < 2; ++n) _Pragma("unroll") for (int k = 0; k < 2; ++k) dst[n][k] = *(const PG8_LAS bf16x8*)(lds + PG8_SB(b, h) + boff + n * 2048 + k * 1024); } while (0)
#define PG8_MMA(ai, bj, At, Bt) do { __builtin_amdgcn_s_setprio(1); _Pragma("unroll") for (int m = 0; m < 4; ++m) _Pragma("unroll") for (int n = 0; n < 2; ++n) _Pragma("unroll") for (int k = 0; k < 2; ++k) \
        acc[ai][bj][m][n] = __builtin_amdgcn_mfma_f32_16x16x32_bf16(Bt[n][k], At[m][k], acc[ai][bj][m][n], 0, 0, 0); __builtin_amdgcn_s_setprio(0); } while (0)
#define PG8_WAIT_V(n) asm volatile("s_waitcnt vmcnt(" #n ")" ::: "memory")
#define PG8_WAIT_L(n) asm volatile("s_waitcnt lgkmcnt(" #n ")" ::: "memory")
#define PG8_BAR __builtin_amdgcn_s_barrier()
#define PG8_SCHED __builtin_amdgcn_sched_barrier(0)
    Unit cur, nxt; int ui = 0;
    if (!S.next(0, cur)) return;
    f32x4 acc[2][2][4][2];
#pragma unroll
    for (int a = 0; a < 2; ++a)
#pragma unroll
        for (int b = 0; b < 2; ++b)
#pragma unroll
            for (int m = 0; m < 4; ++m)
#pragma unroll
                for (int n = 0; n < 2; ++n) acc[a][b][m][n] = (f32x4){0.f, 0.f, 0.f, 0.f};
    bf16x8 At[4][2], B0[2][2], B1[2][2];
    const char* cA = S.a_ptr(cur); const char* cB = S.b_ptr(cur);
    PG8_STAGE(PG8_SB(0, 0), cB, voffB); PG8_STAGE(PG8_SB(0, 1), cB + hsB, voffB); PG8_STAGE(PG8_SA(0, 0), cA, voffA); PG8_STAGE(PG8_SA(0, 1), cA + hsA, voffA);
    if (wr == 1) PG8_BAR;
    PG8_WAIT_V(2); PG8_BAR;
    PG8_STAGE(PG8_SB(1, 0), cB + kstep, voffB); PG8_STAGE(PG8_SA(1, 0), cA + kstep, voffA); PG8_STAGE(PG8_SB(1, 1), cB + hsB + kstep, voffB);
    PG8_WAIT_V(6); PG8_BAR;
    for (;;) {
        const bool has_next = S.next(ui + 1, nxt);
        const char* nA = has_next ? S.a_ptr(nxt) : cA; const char* nB = has_next ? S.b_ptr(nxt) : cB;
        for (int t = 0; t < nt; t += 2) {
            const bool last = (t == nt - 2);
            const char* a1 = cA + (size_t)(t + 1) * kstep;
            const char* a2 = last ? nA : cA + (size_t)(t + 2) * kstep; const char* b2 = last ? nB : cB + (size_t)(t + 2) * kstep;
            const char* a3 = a2 + kstep; const char* b3 = b2 + kstep;
            PG8_LDB(B0, 0, 0); PG8_LDB(B1, 0, 1); PG8_SCHED; PG8_LDA(At, 0, 0); PG8_STAGE(PG8_SA(1, 1), a1 + hsA, voffA);
            PG8_WAIT_V(8); PG8_WAIT_L(0); PG8_BAR; PG8_MMA(0, 0, At, B0); PG8_MMA(0, 1, At, B1); PG8_BAR; PG8_SCHED;
            PG8_LDA(At, 0, 1); PG8_STAGE(PG8_SB(0, 0), b2, voffB); PG8_STAGE(PG8_SB(0, 1), b2 + hsB, voffB); PG8_STAGE(PG8_SA(0, 0), a2, voffA);
            PG8_WAIT_V(8); PG8_WAIT_L(0); PG8_BAR; PG8_MMA(1, 0, At, B0); PG8_MMA(1, 1, At, B1); PG8_BAR; PG8_SCHED;
            PG8_LDB(B0, 1, 0); PG8_LDB(B1, 1, 1); PG8_SCHED; PG8_LDA(At, 1, 0); PG8_STAGE(PG8_SA(0, 1), a2 + hsA, voffA);
            PG8_WAIT_V(8); PG8_WAIT_L(0); PG8_BAR; PG8_MMA(0, 0, At, B0); PG8_MMA(0, 1, At, B1); PG8_BAR; PG8_SCHED;
            PG8_LDA(At, 1, 1); PG8_STAGE(PG8_SB(1, 0), b3, voffB); PG8_STAGE(PG8_SB(1, 1), b3 + hsB, voffB); PG8_STAGE(PG8_SA(1, 0), a3, voffA);
            PG8_WAIT_V(8); PG8_WAIT_L(0); PG8_BAR; PG8_MMA(1, 0, At, B0); PG8_MMA(1, 1, At, B1); PG8_BAR; PG8_SCHED;
        }
        if (wr == 0) PG8_BAR;
        E(acc, cur, wr, wc, fr, fq);
        if (!has_next) break;
#pragma unroll
        for (int a = 0; a < 2; ++a)
#pragma unroll
            for (int b = 0; b < 2; ++b)
#pragma unroll
                for (int m = 0; m < 4; ++m)
#pragma unroll
                    for (int n = 0; n < 2; ++n) acc[a][b][m][n] = (f32x4){0.f, 0.f, 0.f, 0.f};
        cur = nxt; cA = nA; cB = nB; ++ui;
        if (wr == 1) PG8_BAR;
    }
    PG8_WAIT_V(0);
    PG8_BAR;
#undef PG8_SA
#undef PG8_SB
#undef PG8_STAGE
#undef PG8_LDA
#undef PG8_LDB
#undef PG8_MMA
#undef PG8_WAIT_V
#undef PG8_WAIT_L
#undef PG8_BAR
#undef PG8_SCHED
}

constexpr int PW = 7168;
constexpr int PC_Q = 0, PC_K = 512, PC_V = 1024, PC_CB = 1536, PC_U = 2048, PC_RQ = 2560, PC_RK = 2816, PC_RV = 3072, PC_RG = 3584, PC_G = 4096;
constexpr float QSCALE = 0.125f * 1.4426950408889634f;

__device__ __forceinline__ u32x4 pack8(const f32x4& a, const f32x4& b) { u32x4 w; w.x = cvt_pk_bf16(a[0], a[1]); w.y = cvt_pk_bf16(a[2], a[3]); w.z = cvt_pk_bf16(b[0], b[1]); w.w = cvt_pk_bf16(b[2], b[3]); return w; }

struct EpiInproj {
    static constexpr bool PERM = true;
    bf16_t* P; const float* cs;
    __device__ __forceinline__ void operator()(const f32x4 (&acc)[2][2][4][2], const Unit& u, int wr, int wc, int fr, int fq) const {
        const int pn = u.pn, row0 = u.pm * BM + wr * 64 + fr;
        const int tb = (pn < 8) ? pn * 256 : pn * 256 - 512;
        if (pn < 4 || pn == 12 || pn == 13) {
            const float sc = (pn < 2) ? QSCALE : ((pn == 13) ? 0.125f : 1.0f);
            const int ob = tb + wc * 64 + 8 * fq;
#pragma unroll
            for (int ai = 0; ai < 2; ++ai)
#pragma unroll
                for (int m = 0; m < 4; ++m) { const int row = row0 + ai * HALF + m * 16; const float* t = cs + (size_t)(row & 4095) * 64 + 8 * fq;
                    const f32x4 c0 = *(const f32x4*)(t), c1 = *(const f32x4*)(t + 4), s0 = *(const f32x4*)(t + 32), s1 = *(const f32x4*)(t + 36);
                    const f32x4 x1a = acc[ai][0][m][0], x1b = acc[ai][0][m][1], x2a = acc[ai][1][m][0], x2b = acc[ai][1][m][1];
                    const f32x4 o1a = (x1a * c0 - x2a * s0) * sc, o1b = (x1b * c1 - x2b * s1) * sc, o2a = (x2a * c0 + x1a * s0) * sc, o2b = (x2b * c1 + x1b * s1) * sc;
                    bf16_t* rp = P + (size_t)row * PW + ob;
                    *(u32x4*)(rp) = pack8(o1a, o1b); *(u32x4*)(rp + 32) = pack8(o2a, o2b);
                    if (m & 1) asm volatile("" ::: "memory"); }
        } else if (pn >= 8 && pn < 12) {
            const int ob = PC_U + 128 * (pn - 8) + 32 * wc + 8 * fq;
#pragma unroll
            for (int ai = 0; ai < 2; ++ai)
#pragma unroll
                for (int m = 0; m < 4; ++m) { const int row = row0 + ai * HALF + m * 16;
                    *(u32x4*)(P + (size_t)row * PW + ob) = pack8(acc[ai][0][m][0] * acc[ai][1][m][0], acc[ai][0][m][1] * acc[ai][1][m][1]); }
        } else {
            const int kind = (pn >= 18) ? 2 : ((pn >= 16) ? 1 : 0);
            const int ob = tb + 32 * wc + 8 * fq;
#pragma unroll
            for (int ai = 0; ai < 2; ++ai)
#pragma unroll
                for (int m = 0; m < 4; ++m) { const int row = row0 + ai * HALF + m * 16;
#pragma unroll
                    for (int bj = 0; bj < 2; ++bj) { f32x4 v0 = acc[ai][bj][m][0], v1 = acc[ai][bj][m][1];
                        if (kind != 0) {
#pragma unroll
                            for (int e = 0; e < 4; ++e) { const float g0 = fsigmoid(v0[e]), g1 = fsigmoid(v1[e]); v0[e] = (kind == 1) ? v0[e] * g0 : g0; v1[e] = (kind == 1) ? v1[e] * g1 : g1; } }
                        *(u32x4*)(P + (size_t)row * PW + ob + bj * HALF) = pack8(v0, v1); } }
        }
    }
};
struct EpiBranch {
    static constexpr bool PERM = true;
    const bf16_t* P; bf16_t* Mg;
    __device__ __forceinline__ void operator()(const f32x4 (&acc)[2][2][4][2], const Unit& u, int wr, int wc, int fr, int fq) const {
        const int row0 = u.pm * BM + wr * 64 + fr, col0 = u.pn * BM + wc * 32 + 8 * fq, z = u.z;
#pragma unroll
        for (int ai = 0; ai < 2; ++ai) {
            u32x4 g[4][2], p[4][2];
#pragma unroll
            for (int m = 0; m < 4; ++m)
#pragma unroll
                for (int bj = 0; bj < 2; ++bj) { const int row = row0 + ai * HALF + m * 16, col = col0 + bj * HALF;
                    g[m][bj] = *(const u32x4*)(P + (size_t)row * PW + PC_G + 1024 * z + col);
                    p[m][bj] = (z != 0) ? *(const u32x4*)(Mg + (size_t)row * 1024 + col) : (u32x4){0u, 0u, 0u, 0u}; }
#pragma unroll
            for (int m = 0; m < 4; ++m)
#pragma unroll
                for (int bj = 0; bj < 2; ++bj) { const int row = row0 + ai * HALF + m * 16, col = col0 + bj * HALF;
                    f32x4 v0 = acc[ai][bj][m][0], v1 = acc[ai][bj][m][1]; const u32x4 gg = g[m][bj], pp = p[m][bj];
                    v0[0] = v0[0] * bf_lo(gg.x) + bf_lo(pp.x); v0[1] = v0[1] * bf_hi(gg.x) + bf_hi(pp.x); v0[2] = v0[2] * bf_lo(gg.y) + bf_lo(pp.y); v0[3] = v0[3] * bf_hi(gg.y) + bf_hi(pp.y);
                    v1[0] = v1[0] * bf_lo(gg.z) + bf_lo(pp.z); v1[1] = v1[1] * bf_hi(gg.z) + bf_hi(pp.z); v1[2] = v1[2] * bf_lo(gg.w) + bf_lo(pp.w); v1[3] = v1[3] * bf_hi(gg.w) + bf_hi(pp.w);
                    *(u32x4*)(Mg + (size_t)row * 1024 + col) = pack8(v0, v1); }
            asm volatile("" ::: "memory");
        }
    }
};
struct EpiResid {
    static constexpr bool PERM = false;
    const float* res; float* out; int ldc;
    __device__ __forceinline__ void operator()(const f32x4 (&acc)[2][2][4][2], const Unit& u, int wr, int wc, int fr, int fq) const {
        const int row0 = u.pm * BM + wr * 64 + fr, col0 = u.pn * BM + wc * 32 + 4 * fq;
#pragma unroll
        for (int ai = 0; ai < 2; ++ai) {
            f32x4 r[4][2][2];
#pragma unroll
            for (int m = 0; m < 4; ++m) { const size_t off = (size_t)(row0 + ai * HALF + m * 16) * ldc + col0;
#pragma unroll
                for (int bj = 0; bj < 2; ++bj)
#pragma unroll
                    for (int n = 0; n < 2; ++n) r[m][bj][n] = *(const f32x4*)(res + off + bj * HALF + n * 16); }
#pragma unroll
            for (int m = 0; m < 4; ++m) { const size_t off = (size_t)(row0 + ai * HALF + m * 16) * ldc + col0;
#pragma unroll
                for (int bj = 0; bj < 2; ++bj)
#pragma unroll
                    for (int n = 0; n < 2; ++n) *(f32x4*)(out + off + bj * HALF + n * 16) = r[m][bj][n] + acc[ai][bj][m][n]; }
            asm volatile("" ::: "memory");
        }
    }
};
struct EpiSwiglu {
    static constexpr bool PERM = true;
    bf16_t* O; int ldo;
    __device__ __forceinline__ void operator()(const f32x4 (&acc)[2][2][4][2], const Unit& u, int wr, int wc, int fr, int fq) const {
        const int row0 = u.pm * BM + wr * 64 + fr, col0 = u.pn * HALF + wc * 32 + 8 * fq;
#pragma unroll
        for (int ai = 0; ai < 2; ++ai)
#pragma unroll
            for (int m = 0; m < 4; ++m) { f32x4 v0, v1; const f32x4 g0 = acc[ai][0][m][0], g1 = acc[ai][0][m][1], u0 = acc[ai][1][m][0], u1 = acc[ai][1][m][1];
#pragma unroll
                for (int e = 0; e < 4; ++e) { v0[e] = g0[e] * fsigmoid(g0[e]) * u0[e]; v1[e] = g1[e] * fsigmoid(g1[e]) * u1[e]; }
                *(u32x4*)(O + (size_t)(row0 + ai * HALF + m * 16) * ldo + col0) = pack8(v0, v1); }
    }
};
struct EpiMoeDown {
    static constexpr bool PERM = false;
    float* X; const int* tok; const float* pw;
    __device__ __forceinline__ void operator()(const f32x4 (&acc)[2][2][4][2], const Unit& u, int wr, int wc, int fr, int fq) const {
        const int slot0 = u.pm * BM + wr * 64 + fr, col0 = u.pn * BM + wc * 32 + 4 * fq;
#pragma unroll
        for (int ai = 0; ai < 2; ++ai) {
            int t[4]; float p[4]; f32x4 r[4][2][2];
#pragma unroll
            for (int m = 0; m < 4; ++m) { const int slot = slot0 + ai * HALF + m * 16; t[m] = tok[slot]; p[m] = pw[slot]; }
#pragma unroll
            for (int m = 0; m < 4; ++m) { const float* xp = X + (size_t)(t[m] < 0 ? 0 : t[m]) * 1024 + col0;
#pragma unroll
                for (int bj = 0; bj < 2; ++bj)
#pragma unroll
                    for (int n = 0; n < 2; ++n) r[m][bj][n] = *(const f32x4*)(xp + bj * HALF + n * 16); }
#pragma unroll
            for (int m = 0; m < 4; ++m) if (t[m] >= 0) { float* xp = X + (size_t)t[m] * 1024 + col0;
#pragma unroll
                for (int bj = 0; bj < 2; ++bj)
#pragma unroll
                    for (int n = 0; n < 2; ++n) *(f32x4*)(xp + bj * HALF + n * 16) = r[m][bj][n] + acc[ai][bj][m][n] * p[m]; }
            asm volatile("" ::: "memory");
        }
    }
};
}
namespace attn_body {
using bf16=__hip_bfloat16;
using bf16x8=__attribute__((ext_vector_type(8)))short;
using s16x4=__attribute__((ext_vector_type(4)))short;
using f32x16=__attribute__((ext_vector_type(16)))float;
using u32x4=__attribute__((ext_vector_type(4)))unsigned;
constexpr int BATCH=8,NHEAD=8,SEQ=4096,D=64,DM=7168;
constexpr int NW=8,QBLK=32,QB=QBLK*NW,KVBLK=64,NQB=SEQ/QB;
constexpr int ATTN_PITCH=DM, ATTN_UNIT_ROWS=QB;
__device__ __forceinline__ int crow(int r,int hi){return (r&3)+8*(r>>2)+4*hi;}
#define SBAR() __builtin_amdgcn_sched_barrier(0)
__device__ __forceinline__ void cmask(f32x16&p0,f32x16&p1,int jb,int qrel,int hi){
  const float NEG=-INFINITY; int kb=64*jb+4*hi;
  #pragma unroll
  for(int r=0;r<16;++r){int kv=kb+(r&3)+8*(r>>2); if(kv>qrel)p0[r]=NEG; if(kv+32>qrel)p1[r]=NEG;}
}

__device__ __forceinline__ void bmask(f32x16&p0,f32x16&p1,unsigned keep){
  const float NEG=-INFINITY;
  if(!keep){
  #pragma unroll
  for(int r=0;r<16;++r){p0[r]=NEG;p1[r]=NEG;} }
}
constexpr int NSLOT=3, SLOTB=8192;
constexpr int LDS_K=0, LDS_V=NSLOT*SLOTB, LDS_WS=2*NSLOT*SLOTB, LDS_OST=LDS_WS+NW*64*4, LDS_BYTES=LDS_OST+NW*4096;
constexpr float C2=0.125f*1.4426950408889634f;
__device__ __forceinline__ void glds16(const void*gsrc,unsigned lds_dst){unsigned keep;
  asm volatile("s_mov_b32 %0, m0\n\ts_mov_b32 m0, %2\n\ts_nop 0\n\tglobal_load_lds_dwordx4 %1, off\n\ts_mov_b32 m0, %0":"=&s"(keep):"v"(gsrc),"s"(lds_dst):"memory");}
__device__ __forceinline__ float max3f(float a,float b,float c){float r;asm("v_max3_f32 %0, %1, %2, %3":"=v"(r):"v"(a),"v"(b),"v"(c));return r;}
__device__ __forceinline__ float max2f(float a,float b){float r;asm("v_max_f32_e32 %0, %1, %2":"=v"(r):"v"(a),"v"(b));return r;}
__device__ __forceinline__ float fadd_s(float a,float b){float r;asm("v_add_f32_e32 %0, %1, %2":"=v"(r):"v"(a),"v"(b));return r;}
__device__ __forceinline__ float fsub_s(float a,float b){float r;asm("v_sub_f32_e32 %0, %1, %2":"=v"(r):"v"(a),"v"(b));return r;}
typedef float f32x2_t __attribute__((ext_vector_type(2))); typedef __bf16 bf16x2_t __attribute__((ext_vector_type(2)));
__device__ __forceinline__ unsigned cvtpk_s(float lo,float hi){f32x2_t v={lo,hi};bf16x2_t b=__builtin_convertvector(v,bf16x2_t);return __builtin_bit_cast(unsigned,b);}
#define WAIT_BAR(N) asm volatile("s_waitcnt vmcnt(" #N ") lgkmcnt(0)\n\ts_barrier":::"memory")

__device__ __forceinline__ void qkt(f32x16&p0,f32x16&p1,const char*Kslot,const bf16x8*qr,const f32x16&negm,int r32,int hi){
  const char*kb=Kslot+hi*1024+r32*16;
  #pragma unroll
  for(int d0=0;d0<4;++d0){
    const bf16x8 b0=*reinterpret_cast<const bf16x8*>(kb+d0*2048);
    const bf16x8 b1=*reinterpret_cast<const bf16x8*>(kb+d0*2048+512);
    if(d0==0){p0=__builtin_amdgcn_mfma_f32_32x32x16_bf16(b0,qr[0],negm,0,0,0);p1=__builtin_amdgcn_mfma_f32_32x32x16_bf16(b1,qr[0],negm,0,0,0);}
    else{p0=__builtin_amdgcn_mfma_f32_32x32x16_bf16(b0,qr[d0],p0,0,0,0);p1=__builtin_amdgcn_mfma_f32_32x32x16_bf16(b1,qr[d0],p1,0,0,0);}}
}
typedef __attribute__((address_space(3))) const char* lds_cptr;
typedef short v4i16_t __attribute__((ext_vector_type(4)));
__device__ __forceinline__ void kload8(bf16x8*kf,lds_cptr kp){
  kf[0]=*(const __attribute__((address_space(3))) bf16x8*)(kp);      kf[1]=*(const __attribute__((address_space(3))) bf16x8*)(kp+512);
  kf[2]=*(const __attribute__((address_space(3))) bf16x8*)(kp+2048); kf[3]=*(const __attribute__((address_space(3))) bf16x8*)(kp+2560);
  kf[4]=*(const __attribute__((address_space(3))) bf16x8*)(kp+4096); kf[5]=*(const __attribute__((address_space(3))) bf16x8*)(kp+4608);
  kf[6]=*(const __attribute__((address_space(3))) bf16x8*)(kp+6144); kf[7]=*(const __attribute__((address_space(3))) bf16x8*)(kp+6656);
}
__device__ __forceinline__ void kload2(bf16x8*kf,lds_cptr kp,int j){ kf[2*j]=*(const __attribute__((address_space(3))) bf16x8*)(kp+j*2048); kf[2*j+1]=*(const __attribute__((address_space(3))) bf16x8*)(kp+j*2048+512); }
__device__ __forceinline__ s16x4 vtr(lds_cptr p){ return __builtin_bit_cast(s16x4,__builtin_amdgcn_ds_read_tr16_b64_v4i16((__attribute__((address_space(3))) v4i16_t*)p)); }
__device__ __forceinline__ float rowmax(const f32x16&p0,const f32x16&p1){
  float a=max3f(p0[0],p0[1],p1[0]),b=max3f(p0[2],p0[3],p1[1]);a=max3f(a,p1[2],p1[3]);
  #pragma unroll
  for(int r=4;r<16;r+=4){a=max3f(a,p0[r],p0[r+1]);b=max3f(b,p0[r+2],p0[r+3]);a=max3f(a,p1[r],p1[r+1]);b=max3f(b,p1[r+2],p1[r+3]);}
  const float m=max2f(a,b);
  auto rr=__builtin_amdgcn_permlane32_swap(__float_as_uint(m),__float_as_uint(m),false,false);
  return max2f(__uint_as_float(rr[0]),__uint_as_float(rr[1]));
}
__device__ __forceinline__ void pv(f32x16*o,int vb,bf16x8 pa0,bf16x8 pa1,bf16x8 pa2,bf16x8 pa3){
  #pragma unroll
  for(int d0=0;d0<2;++d0){s16x4 lo[4],hi[4];
    #pragma unroll
    for(int ks=0;ks<4;++ks){
      asm volatile("ds_read_b64_tr_b16 %0,%1 offset:%c2":"=&v"(lo[ks]):"v"(vb),"i"(d0*4096+ks*1024):"memory");
      asm volatile("ds_read_b64_tr_b16 %0,%1 offset:%c2":"=&v"(hi[ks]):"v"(vb),"i"(d0*4096+ks*1024+512):"memory");}
    asm volatile("s_waitcnt lgkmcnt(0)":::"memory");SBAR();
    #define PK(k) (bf16x8){lo[k][0],lo[k][1],lo[k][2],lo[k][3],hi[k][0],hi[k][1],hi[k][2],hi[k][3]}
    o[d0]=__builtin_amdgcn_mfma_f32_32x32x16_bf16(pa0,PK(0),o[d0],0,0,0);
    o[d0]=__builtin_amdgcn_mfma_f32_32x32x16_bf16(pa1,PK(1),o[d0],0,0,0);
    o[d0]=__builtin_amdgcn_mfma_f32_32x32x16_bf16(pa2,PK(2),o[d0],0,0,0);
    o[d0]=__builtin_amdgcn_mfma_f32_32x32x16_bf16(pa3,PK(3),o[d0],0,0,0);
    #undef PK
  }
}

#ifndef ATTN_STORE16
#define ATTN_STORE16(p,v) (*(u32x4*)(p)=(v))
#endif
template<int THRL> __device__ __forceinline__ void attn_unit(int b,int h,int qb,const bf16*Q,const bf16*__restrict__ K,const bf16*__restrict__ V,bf16*O,const float*__restrict__ KM,char*shm){
  int tid_=threadIdx.x; asm volatile("":"+v"(tid_));
  const int tid=tid_,lane=tid&63,r32=lane&31,hi=lane>>5; const int wid=__builtin_amdgcn_readfirstlane(tid>>6);
  const long rowbase=(long)b*SEQ; const int q0=qb*QB;
  const bf16*Qw=Q+(rowbase+q0+wid*QBLK)*DM+h*D;
  const bf16*Kh=K+rowbase*DM+h*D,*Vh=V+rowbase*DM+h*D;
  const unsigned lds0=(unsigned)(uintptr_t)shm;
  float*wsf=(float*)(shm+LDS_WS)+wid*64;
  const bf16*ksrc=Kh+(long)lane*DM+wid*8;
  const bf16*vsrc=Vh+(long)(16*(wid&3)+(lane>>2))*DM+(wid>>2)*32+(lane&3)*8;
  const unsigned kdst=lds0+LDS_K+wid*1024, vdst=lds0+LDS_V+wid*1024;
  #define DMA_K(t,slot) glds16(ksrc+(long)(t)*KVBLK*DM,(unsigned)__builtin_amdgcn_readfirstlane(kdst+(slot)))
  #define DMA_V(t,slot) glds16(vsrc+(long)(t)*KVBLK*DM,(unsigned)__builtin_amdgcn_readfirstlane(vdst+(slot)))
  const int vb0=(int)(lds0+LDS_V)+((lane>>4)&1)*32+(lane&3)*8+(4*hi+((lane&15)>>2))*64;
  const char*Kbase=shm+LDS_K; bf16x8 kf[8];
  const lds_cptr shm3=(lds_cptr)shm; const lds_cptr kp0=shm3+LDS_K+hi*1024+r32*16; const lds_cptr vp0=shm3+LDS_V+((lane>>4)&1)*32+(lane&3)*8+(4*hi+((lane&15)>>2))*64;
  const int NT=(q0+QB)/KVBLK;
  DMA_K(0,0);DMA_V(0,0);DMA_K(1,SLOTB);
  bf16x8 qr[4];
  #pragma unroll
  for(int d0=0;d0<4;++d0)qr[d0]=*reinterpret_cast<const bf16x8*>(&Qw[(long)r32*DM+d0*16+hi*8]);
  unsigned sel=0u;
  if(qb>0){
    float g[15];
    const float*kmb=KM+(long)(b*NHEAD+h)*16*64+8*hi;
    #pragma unroll
    for(int kb=0;kb<15;++kb){ g[kb]=-INFINITY;
      if(kb<qb){ float sacc_=0.f;
        #pragma unroll
        for(int d0=0;d0<4;++d0){ const float4 ka=*reinterpret_cast<const float4*>(kmb+kb*64+16*d0),kc=*reinterpret_cast<const float4*>(kmb+kb*64+16*d0+4);
          sacc_+=__uint_as_float((unsigned)(unsigned short)qr[d0][0]<<16)*ka.x+__uint_as_float((unsigned)(unsigned short)qr[d0][1]<<16)*ka.y+__uint_as_float((unsigned)(unsigned short)qr[d0][2]<<16)*ka.z+__uint_as_float((unsigned)(unsigned short)qr[d0][3]<<16)*ka.w
                +__uint_as_float((unsigned)(unsigned short)qr[d0][4]<<16)*kc.x+__uint_as_float((unsigned)(unsigned short)qr[d0][5]<<16)*kc.y+__uint_as_float((unsigned)(unsigned short)qr[d0][6]<<16)*kc.z+__uint_as_float((unsigned)(unsigned short)qr[d0][7]<<16)*kc.w; }
        sacc_+=__shfl_xor(sacc_,32); g[kb]=sacc_; } }
    #pragma unroll
    for(int pass=0;pass<3;++pass){ float bv=-INFINITY; int bi=-1;
      #pragma unroll
      for(int kb=0;kb<15;++kb){ if(kb<qb && !((sel>>kb)&1u) && g[kb]>bv){bv=g[kb];bi=kb;} }
      if(bi>=0)sel|=1u<<bi; }
  }
  float mhat=0.f,l_reg=0.f;f32x16 o[2];o[0]=f32x16{};o[1]=f32x16{};f32x16 negm=f32x16{};asm volatile("":"+v"(negm));
  const int qrel=wid*QBLK+r32;
  #define CMASK(P0,P1,t) do{int jb_=(t)-(NT-4); if(jb_>=0)cmask(P0,P1,jb_,qrel,hi); else bmask(P0,P1,(sel>>((t)>>2))&1u);}while(0)
  bool resc=false;
  #define START(P0,P1) do{ const float rm=rowmax(P0,P1); resc=false; \
    { const float dl=__builtin_fmaxf(rm,-20.f); mhat=fadd_s(mhat,dl); \
      _Pragma("unroll") for(int r=0;r<16;++r){P0[r]=fsub_s(P0[r],dl);P1[r]=fsub_s(P1[r],dl);} \
      _Pragma("unroll") for(int r=0;r<16;++r)negm[r]=-mhat; asm volatile("":"+v"(negm)); } \
    _Pragma("unroll") for(int r=0;r<16;++r)P0[r]=__builtin_amdgcn_exp2f(P0[r]); }while(0)
  #define RESC() do{ if(resc){ asm volatile("s_waitcnt lgkmcnt(0)":::"memory"); \
      _Pragma("unroll") for(int d_=0;d_<2;++d_) _Pragma("unroll") for(int r=0;r<16;++r)o[d_][r]*=wsf[crow(r,hi)]; } }while(0)
  f32x16 pA0,pA1,pB0,pB1;
  int sl_prev=0,sl_cur=0,sl_next=SLOTB;
  #define ROT() do{sl_prev=sl_cur;sl_cur=sl_next;sl_next=(sl_next==(NSLOT-1)*SLOTB)?0:sl_next+SLOTB;}while(0)
  DMA_K(2,2*SLOTB);
  WAIT_BAR(3);
  qkt(pA0,pA1,Kbase,qr,negm,r32,hi);asm volatile("s_nop 15\n\ts_nop 7":"+v"(pA0),"+v"(pA1));CMASK(pA0,pA1,0);
  START(pA0,pA1);
  _Pragma("unroll") for(int r=0;r<16;++r)pA1[r]=__builtin_amdgcn_exp2f(pA1[r]);
  WAIT_BAR(0);
  DMA_K(3,0);DMA_V(1,SLOTB);
  ROT();
  kload8(kf,kp0+sl_cur);
  WAIT_BAR(2);
  s16x4 vlo[8],vhi[8]; u32x4 pw0,pw1,pw2,pw3;
  #define PKW(P,B) cvtpk_s(P[B],P[B+1])
  #define PAF(k) __builtin_bit_cast(bf16x8,pw##k)
  #define VFR(i) (bf16x8){vlo[i][0],vlo[i][1],vlo[i][2],vlo[i][3],vhi[i][0],vhi[i][1],vhi[i][2],vhi[i][3]}
  #define PIN(x) asm volatile("":"+v"(x))
  #define MX3(a,b,c) __builtin_fmaxf(__builtin_fmaxf((a),(b)),(c))
  #define GAPA(MF,A0,A1,A2,A3,W0,W1,PW) do{ MF; sacc+=A0; sacc+=A1; sacc+=A2; sacc+=A3; PIN(sacc); W0; W1; PIN(PW); SBAR(); }while(0)
  #define EX(v) __builtin_amdgcn_exp2f(v)
  #define GAPB(MF,X,B) do{ MF; X[B]=EX(X[B]); X[B+1]=EX(X[B+1]); X[B+2]=EX(X[B+2]); X[B+3]=EX(X[B+3]); PIN(X); SBAR(); }while(0)
  #define VRD(i) do{ vlo[i]=vtr(vp_+(((i)>>2)*4096+((i)&3)*1024)); vhi[i]=vtr(vp_+(((i)>>2)*4096+((i)&3)*1024+512)); }while(0)
  #define KRD(G,j) do{ if(G){ kload2(kf,kp0+sl_next,j); SBAR(); } }while(0)
  #define STEP(C0,C1,P0,P1,t,GK,GV,GL) do{ SBAR(); \
    const lds_cptr vp_=vp0+sl_prev; \
    VRD(0); SBAR(); float sacc=(P0[0]+P0[1]); \
    GAPA(C0=__builtin_amdgcn_mfma_f32_32x32x16_bf16(kf[0],qr[0],negm,0,0,0), P0[2],P0[3],P0[4],P0[5],     pw0[0]=PKW(P0,0), pw0[1]=PKW(P0,2), pw0); \
    VRD(4); SBAR(); GAPA(C1=__builtin_amdgcn_mfma_f32_32x32x16_bf16(kf[1],qr[0],negm,0,0,0), P0[6],P0[7],P0[8],P0[9],     pw0[2]=PKW(P0,4), pw0[3]=PKW(P0,6), pw0); \
    VRD(1); SBAR(); GAPA(C0=__builtin_amdgcn_mfma_f32_32x32x16_bf16(kf[2],qr[1],C0,0,0,0),   P0[10],P0[11],P0[12],P0[13], pw1[0]=PKW(P0,8), pw1[1]=PKW(P0,10), pw1); \
    VRD(5); SBAR(); GAPA(C1=__builtin_amdgcn_mfma_f32_32x32x16_bf16(kf[3],qr[1],C1,0,0,0),   P0[14],P0[15],P1[0],P1[1],   pw1[2]=PKW(P0,12),pw1[3]=PKW(P0,14), pw1); \
    VRD(2); SBAR(); GAPA(C0=__builtin_amdgcn_mfma_f32_32x32x16_bf16(kf[4],qr[2],C0,0,0,0),   P1[2],P1[3],P1[4],P1[5],     pw2[0]=PKW(P1,0), pw2[1]=PKW(P1,2), pw2); \
    VRD(6); SBAR(); GAPA(C1=__builtin_amdgcn_mfma_f32_32x32x16_bf16(kf[5],qr[2],C1,0,0,0),   P1[6],P1[7],P1[8],P1[9],     pw2[2]=PKW(P1,4), pw2[3]=PKW(P1,6), pw2); \
    VRD(3); SBAR(); GAPA(C0=__builtin_amdgcn_mfma_f32_32x32x16_bf16(kf[6],qr[3],C0,0,0,0),   P1[10],P1[11],P1[12],P1[13], pw3[0]=PKW(P1,8), pw3[1]=PKW(P1,10), pw3); \
    VRD(7); SBAR(); GAPA(C1=__builtin_amdgcn_mfma_f32_32x32x16_bf16(kf[7],qr[3],C1,0,0,0),   P1[14],P1[15],0.f,0.f,       pw3[2]=PKW(P1,12),pw3[3]=PKW(P1,14), pw3); \
    l_reg+=sacc; \
    if(GK){DMA_K((t)+3,sl_cur);} if(GV){DMA_V((t)+1,sl_next);} \
    CMASK(C0,C1,t); \
    { float a=MX3(C0[0],C0[1],C1[0]),b=MX3(C0[2],C0[3],C1[1]); a=MX3(a,C1[2],C1[3]); \
      _Pragma("unroll") for(int r=4;r<16;r+=4){a=MX3(a,C0[r],C0[r+1]);b=MX3(b,C0[r+2],C0[r+3]);a=MX3(a,C1[r],C1[r+1]);b=MX3(b,C1[r+2],C1[r+3]);} \
      float rm=__builtin_fmaxf(a,b); { auto rr=__builtin_amdgcn_permlane32_swap(__float_as_uint(rm),__float_as_uint(rm),false,false); rm=__builtin_fmaxf(__uint_as_float(rr[0]),__uint_as_float(rr[1])); } \
      resc=false; \
      if(__builtin_expect(__any(rm>(float)THRL),0)){ const float dl=__builtin_fmaxf(rm,0.f); mhat+=dl; \
        _Pragma("unroll") for(int r=0;r<16;++r){C0[r]-=dl;C1[r]-=dl;} \
        _Pragma("unroll") for(int r=0;r<16;++r)negm[r]=-mhat; asm volatile("":"+v"(negm)); \
        const float f=__builtin_amdgcn_exp2f(-dl); l_reg*=f; if(hi==0)wsf[r32]=f; resc=true; } } \
    SBAR(); \
    GAPB(o[0]=__builtin_amdgcn_mfma_f32_32x32x16_bf16(PAF(0),VFR(0),o[0],0,0,0), C0,0); \
    GAPB(o[1]=__builtin_amdgcn_mfma_f32_32x32x16_bf16(PAF(0),VFR(4),o[1],0,0,0), C0,4); \
    KRD(GL,0); GAPB(o[0]=__builtin_amdgcn_mfma_f32_32x32x16_bf16(PAF(1),VFR(1),o[0],0,0,0), C0,8); \
    KRD(GL,1); GAPB(o[1]=__builtin_amdgcn_mfma_f32_32x32x16_bf16(PAF(1),VFR(5),o[1],0,0,0), C0,12); \
    KRD(GL,2); GAPB(o[0]=__builtin_amdgcn_mfma_f32_32x32x16_bf16(PAF(2),VFR(2),o[0],0,0,0), C1,0); \
    KRD(GL,3); GAPB(o[1]=__builtin_amdgcn_mfma_f32_32x32x16_bf16(PAF(2),VFR(6),o[1],0,0,0), C1,4); \
    GAPB(o[0]=__builtin_amdgcn_mfma_f32_32x32x16_bf16(PAF(3),VFR(3),o[0],0,0,0), C1,8); \
    GAPB(o[1]=__builtin_amdgcn_mfma_f32_32x32x16_bf16(PAF(3),VFR(7),o[1],0,0,0), C1,12); \
    }while(0)
  int t=1;
  #undef CMASK
  #define CMASK(P0,P1,t) bmask(P0,P1,(sel>>((t)>>2))&1u)
  for(;t+5<NT;t+=2){
    STEP(pB0,pB1,pA0,pA1,t,true,true,true);     WAIT_BAR(2); RESC(); ROT();
    STEP(pA0,pA1,pB0,pB1,t+1,true,true,true);   WAIT_BAR(2); RESC(); ROT();
  }
  #undef CMASK
  #define CMASK(P0,P1,t) do{int jb_=(t)-(NT-4); if(jb_>=0)cmask(P0,P1,jb_,qrel,hi); else bmask(P0,P1,(sel>>((t)>>2))&1u);}while(0)
  #define ENDW(tt) do{ if((tt)+3<NT){WAIT_BAR(2);} else if((tt)+2<NT){WAIT_BAR(1);} else {WAIT_BAR(0);} }while(0)
  for(;t+1<NT;t+=2){
    STEP(pB0,pB1,pA0,pA1,t,(t+3<NT),(t+1<NT),(t+1<NT));       ENDW(t);   RESC(); ROT();
    STEP(pA0,pA1,pB0,pB1,t+1,(t+4<NT),(t+2<NT),(t+2<NT));     ENDW(t+1); RESC(); ROT();
  }
  STEP(pB0,pB1,pA0,pA1,NT-1,false,false,false); RESC();
  { float sacc=pB0[0]+pB0[1]; _Pragma("unroll") for(int r=2;r<16;++r)sacc+=pB0[r]; _Pragma("unroll") for(int r=0;r<16;++r)sacc+=pB1[r]; l_reg+=sacc;
    pw0=(u32x4){PKW(pB0,0),PKW(pB0,2),PKW(pB0,4),PKW(pB0,6)};pw1=(u32x4){PKW(pB0,8),PKW(pB0,10),PKW(pB0,12),PKW(pB0,14)};pw2=(u32x4){PKW(pB1,0),PKW(pB1,2),PKW(pB1,4),PKW(pB1,6)};pw3=(u32x4){PKW(pB1,8),PKW(pB1,10),PKW(pB1,12),PKW(pB1,14)};
    SBAR(); pv(o,vb0+sl_cur,PAF(0),PAF(1),PAF(2),PAF(3)); }
  #undef PKW
  #undef PAF
  #undef VFR
  #undef PIN
  #undef MX3
  #undef GAPA
  #undef GAPB
  #undef EX
  #undef VRD
  #undef KRD
  #undef STEP
  #undef ENDW
  {auto rr=__builtin_amdgcn_permlane32_swap(__float_as_uint(l_reg),__float_as_uint(l_reg),false,false);l_reg=__uint_as_float(rr[0])+__uint_as_float(rr[1]);}
  if(hi==0)wsf[32+r32]=l_reg;asm volatile("s_waitcnt lgkmcnt(0)":::"memory");
  float rli[16];
  #pragma unroll
  for(int r=0;r<16;++r)rli[r]=__builtin_amdgcn_rcpf(wsf[32+crow(r,hi)]);
  bf16*Ow=O+(rowbase+q0+wid*QBLK)*DM+h*D;
  { bf16*stg=(bf16*)(shm+LDS_OST)+wid*2048;
    #pragma unroll
    for(int r=0;r<16;++r){const int orow=crow(r,hi);
      #pragma unroll
      for(int d0=0;d0<2;++d0)stg[orow*64+d0*32+r32]=__float2bfloat16(o[d0][r]*rli[r]);}
    asm volatile("s_waitcnt lgkmcnt(0)":::"memory");
    #pragma unroll
    for(int i=0;i<4;++i){const int row=i*8+(lane>>3),ch=lane&7; const u32x4 v=*(const u32x4*)(stg+row*64+ch*8); ATTN_STORE16(Ow+(long)row*DM+ch*8,v);} }
  asm volatile("s_waitcnt lgkmcnt(0)\n\ts_barrier":::"memory");
  #undef DMA_K
  #undef DMA_V
  #undef CMASK
  #undef START
  #undef RESC
  #undef ROT
}
constexpr int ATTN_LDS_BYTES=LDS_BYTES;
struct AttnTensors { const bf16* Q; const bf16* K; const bf16* V; bf16* O; const float* KM; };
struct AttnUnit { int bh; int qb; };
struct StaticOrder {
  int vcu,grid;
  __device__ __forceinline__ explicit StaticOrder(int grid_,int block):vcu((grid_%8==0)?(block%8)*(grid_/8)+block/8:block),grid(grid_){}
  __device__ __forceinline__ bool next(int i,AttnUnit&u)const{
    if(grid==256){ if(i>=4)return false; const int s=vcu&3; u.bh=vcu>>2; u.qb=(i==0)?s:(i==1)?7-s:(i==2)?8+s:15-s; return true; }
    const int L=vcu+i*grid; if(L>=BATCH*NHEAD*NQB)return false; u.bh=L/NQB; u.qb=L%NQB; return true; }
  __device__ __forceinline__ void a_ready(const AttnUnit&)const{}
  __device__ __forceinline__ void done(const AttnUnit&)const{}
};
template<class Sched,int THRL=8> __device__ __forceinline__ void attn_phase(char*lds,const AttnTensors&T,const Sched&S){
  AttnUnit u;
  for(int i=0;S.next(i,u);++i){ S.a_ready(u); attn_unit<THRL>(u.bh/NHEAD,u.bh%NHEAD,u.qb,T.Q,T.K,T.V,T.O,T.KM,lds); S.done(u); }
}
#undef SBAR
#undef WAIT_BAR
}

constexpr int NWAVES = 8;
constexpr int BATCH = 8, SEQ = 4096, D = 1024, M = BATCH * SEQ;
constexpr int NPROJ = 7680, FF = 3584, NEXP = 8;
constexpr int PW = pg8::PW;
constexpr int MAXSLOT = M + NEXP * 256;
constexpr float RMS_EPS = 1e-6f;

constexpr size_t MiB = 1u << 20;
constexpr size_t WS_CTL = 0, CTL_ZERO_BYTES = 1 * MiB;
constexpr size_t WS_TAB = 1 * MiB;
constexpr size_t WS_KMEAN = 2 * MiB;
constexpr size_t WS_TOKE = WS_KMEAN + 256 * 1024;
constexpr size_t WS_TOKIDX = WS_TOKE + 128 * 1024;
constexpr size_t WS_TOKP = WS_TOKIDX + 256 * 1024;
constexpr size_t WS_TOKOF = WS_TOKP + 128 * 1024;
constexpr size_t WS_PWOF = WS_TOKOF + 2 * (size_t)MAXSLOT * 4;
static_assert(WS_PWOF + 2 * (size_t)MAXSLOT * 4 <= 4 * MiB, "small tables");
constexpr size_t WS_WIN = 4 * MiB, WS_WBR = 19 * MiB, WS_WOUT = 22 * MiB;
constexpr size_t WS_H = 24 * MiB;
constexpr size_t WS_KVT = WS_H, WS_ST = WS_H + 32 * MiB;
constexpr size_t WS_W1 = 88 * MiB, WS_W2 = 102 * MiB;
constexpr size_t WS_P = 109 * MiB;
constexpr size_t WS_ACT = WS_P;
constexpr size_t WS_MW1 = 88 * MiB, WS_MW2 = 200 * MiB;
constexpr size_t WS_XG = 256 * MiB;
constexpr size_t WS_ACTM = 324 * MiB;
constexpr size_t WS_END = 562 * MiB;
static_assert(WS_P + (size_t)M * PW * 2 <= WS_END && WS_ACTM + (size_t)MAXSLOT * FF * 2 <= WS_END && WS_XG + (size_t)MAXSLOT * D * 2 <= WS_ACTM && WS_MW2 + (size_t)NEXP * D * FF * 2 <= WS_XG, "d_ws map");
constexpr int CW_BAR = 4096;
constexpr int CW_CNT = 16384;

constexpr int RING_OFF = 0, RING_BYTES = 131072;
constexpr int LDSCTL_OFF = RING_BYTES, MISC_OFF = LDSCTL_OFF + 320;
constexpr int LDS_BYTES = 147456;

#define GAS __attribute__((address_space(1)))
#define LAS __attribute__((address_space(3)))
typedef unsigned short bf16;
typedef unsigned v4u __attribute__((ext_vector_type(4)));
typedef unsigned v2u __attribute__((ext_vector_type(2)));
typedef float f32x4 __attribute__((ext_vector_type(4)));
typedef short bf16x8 __attribute__((ext_vector_type(8)));
typedef short s16x4 __attribute__((ext_vector_type(4)));
typedef GAS unsigned gu32;
#define RLX_AGENT __ATOMIC_RELAXED, __HIP_MEMORY_SCOPE_AGENT
#define LDS_WAIT() asm volatile("s_waitcnt lgkmcnt(0)" ::: "memory")
__device__ __forceinline__ unsigned f2bf(float f) { unsigned u = __builtin_bit_cast(unsigned, f); return (u + 0x7fffu + ((u >> 16) & 1u)) >> 16; }
__device__ __forceinline__ unsigned pk2(float lo, float hi) { return f2bf(lo) | (f2bf(hi) << 16); }
__device__ __forceinline__ float bflo(unsigned w) { return __builtin_bit_cast(float, w << 16); }
__device__ __forceinline__ float bfhi(unsigned w) { return __builtin_bit_cast(float, w & 0xffff0000u); }

#define XB_TMO      128
#define XB_XCNT(j)  (256  + 64 * (j))
#define XB_XSUB(j)  (1280 + 64 * (j))
#define XB_XGEN(j)  (2304 + 64 * (j))
#define XB_TOP      3328
#define XB_TOPGEN   3392
#define XCD_BAR_WORDS 3456
#define XB_SPIN_CAP (1u << 18)
__device__ __forceinline__ unsigned xb_ld(unsigned* p)              { return __hip_atomic_load(p, __ATOMIC_RELAXED, __HIP_MEMORY_SCOPE_AGENT); }
__device__ __forceinline__ unsigned xb_add(unsigned* p, unsigned v) { return __hip_atomic_fetch_add(p, v, __ATOMIC_RELAXED, __HIP_MEMORY_SCOPE_AGENT); }
__device__ __forceinline__ unsigned xb_xcc_id() { return (unsigned)__builtin_amdgcn_s_getreg((3 << 11) | 20) & 0xFu; }
#define XB_SPIN(cond, bar) do { unsigned _sp = 0; while (cond) { __builtin_amdgcn_s_sleep(1); \
    if ((++_sp & 255u) == 0u) { if (xb_ld(&(bar)[XB_TMO])) break; if (_sp > XB_SPIN_CAP) { atomicAdd(&(bar)[XB_TMO], 1u); break; } } } } while (0)
struct XcdBarrier { unsigned* bar; unsigned x; volatile LAS unsigned* st; };
__device__ __forceinline__ XcdBarrier xcd_barrier_post(unsigned* bar, volatile LAS unsigned* st) {
    XcdBarrier b; b.bar = bar; b.x = xb_xcc_id(); b.st = st;
    if (threadIdx.x == 0) (void)xb_add(&bar[XB_XCNT(b.x)], 1u);
    return b;
}
__device__ __forceinline__ void xcd_barrier_complete(unsigned* bar, unsigned x, unsigned& nloc, unsigned& nx) {
    const unsigned G = gridDim.x * gridDim.y * gridDim.z;
    unsigned sum, cnt, mine, sp = 0u;
    for (;;) {
        sum = 0u; cnt = 0u; mine = 0u;
#pragma unroll
        for (unsigned j = 0; j < 16; ++j) { const unsigned c = xb_ld(&bar[XB_XCNT(j)]); sum += c; cnt += (c > 0u) ? 1u : 0u; mine = (j == x) ? c : mine; }
        if (sum == G) break;
        __builtin_amdgcn_s_sleep(1);
        if ((++sp & 255u) == 0u) { if (xb_ld(&bar[XB_TMO])) break; if (sp > XB_SPIN_CAP) { atomicAdd(&bar[XB_TMO], 1u); break; } }
    }
    nloc = mine > 0u ? mine : 1u; nx = cnt > 0u ? cnt : 1u;
}
__device__ __forceinline__ void xcd_barrier(const XcdBarrier& b) {
    asm volatile("s_waitcnt vmcnt(0)" ::: "memory");
    __syncthreads();
    if (threadIdx.x == 0) {
        unsigned* bar = b.bar;
        __builtin_amdgcn_s_waitcnt(0);
        unsigned nloc = b.st[0], nx = b.st[1];
        if (nloc == 0u) { xcd_barrier_complete(bar, b.x, nloc, nx); b.st[0] = nloc; b.st[1] = nx; }
        const unsigned old = xb_add(&bar[XB_XSUB(b.x)], 1u);
        const unsigned gen = old / nloc;
        if (old + 1u == (gen + 1u) * nloc) {
            __builtin_amdgcn_fence(__ATOMIC_RELEASE, "agent");
            asm volatile("s_waitcnt vmcnt(0)" ::: "memory");
            const unsigned og = xb_add(&bar[XB_TOP], 1u);
            const unsigned tg = og / nx;
            if (og + 1u == (tg + 1u) * nx) xb_add(&bar[XB_TOPGEN], 1u);
            else XB_SPIN(xb_ld(&bar[XB_TOPGEN]) == tg, bar);
            __builtin_amdgcn_fence(__ATOMIC_ACQUIRE, "agent");
            xb_add(&bar[XB_XGEN(b.x)], 1u);
            asm volatile("s_waitcnt vmcnt(0)" ::: "memory");
        } else {
            XB_SPIN(xb_ld(&bar[XB_XGEN(b.x)]) == gen, bar);
            __builtin_amdgcn_fence(__ATOMIC_ACQUIRE, "agent");
            asm volatile("s_waitcnt vmcnt(0)" ::: "memory");
        }
    }
    __syncthreads();
}

struct Frame {
    LAS unsigned char* lds;
    volatile LAS unsigned* MISC;
    gu32* ctl;
    int tid, lane, wave;
    int vcu, G;
    GAS unsigned char* ws;
};

__device__ __forceinline__ float wave_sum(float v) {
#pragma unroll
    for (int o = 1; o < 64; o <<= 1) v += __shfl_xor(v, o);
    return v;
}

__device__ __forceinline__ void transpose_item(const float* W, int K, int Nsrc, bf16* WT, int drow0, int scol0, int kb, LAS float* scr, int lane) {
    const int k0 = 64 * kb;
#pragma unroll 8
    for (int i = 0; i < 32; ++i) { const int kk = 2 * i + (lane >> 5); scr[kk * 33 + (lane & 31)] = W[(size_t)(k0 + kk) * Nsrc + scol0 + (lane & 31)]; }
    LDS_WAIT(); asm volatile("" ::: "memory");
    const int c = lane & 7;
#pragma unroll
    for (int j = 0; j < 4; ++j) { const int n = (lane >> 3) + 8 * j; const LAS float* s = scr + (8 * c) * 33 + n;
        v4u o; o.x = pk2(s[0 * 33], s[1 * 33]); o.y = pk2(s[2 * 33], s[3 * 33]); o.z = pk2(s[4 * 33], s[5 * 33]); o.w = pk2(s[6 * 33], s[7 * 33]);
        *(GAS v4u*)(WT + (size_t)(drow0 + n) * K + k0 + 8 * c) = o; }
    LDS_WAIT(); asm volatile("" ::: "memory");
}
template <int KIND>
__device__ __forceinline__ void convert_matrix(Frame& F, const float* W, const float* W2, int K, int Nsrc, bf16* WT, int ndb) {
    LAS float* scr = (LAS float*)(F.lds + RING_OFF + F.wave * 16384);
    const int gw = F.vcu * NWAVES + F.wave, NGW = F.G * NWAVES, nitems = (K / 64) * ndb;
    for (int it = gw; it < nitems; it += NGW) {
        const int kb = it / ndb, db = it % ndb; const float* src = W; int scol;
        if (KIND == 0) scol = 32 * db;
        else if (KIND == 1) { const int pn = db >> 3, blk = db & 7, bj = blk >> 2, wc = blk & 3;
            if (pn < 4 || pn == 12 || pn == 13) scol = 256 * pn + 64 * wc + 32 * bj;
            else if (pn >= 8 && pn < 12) scol = (bj ? 2560 : 2048) + 128 * (pn - 8) + 32 * wc;
            else scol = 32 * db; }
        else { const int t = db >> 3, blk = db & 7, bj = blk >> 2, wc = blk & 3; src = bj ? W2 : W; scol = 128 * t + 32 * wc; }
        transpose_item(src, K, Nsrc, WT, 32 * db, scol, kb, scr, F.lane);
    }
}
__device__ __forceinline__ const float* arg_in(int i) {
    int off = i * 8; asm volatile("" : "+s"(off));
    const char __attribute__((address_space(4)))* ka = (const char __attribute__((address_space(4)))*)__builtin_amdgcn_kernarg_segment_ptr();
    return (const float*)(const GAS float*)*(const float* const __attribute__((address_space(4)))*)(ka + off);
}
__device__ __forceinline__ void convert_mixer_weights(Frame& F, int layer) {
    convert_matrix<1>(F, arg_in(2) + (size_t)layer * D * NPROJ, nullptr, D, NPROJ, (bf16*)(F.ws + WS_WIN), NPROJ / 32);
    convert_matrix<0>(F, arg_in(6) + (size_t)layer * 512 * D, nullptr, 512, D, (bf16*)(F.ws + WS_WBR), D / 32);
    convert_matrix<0>(F, arg_in(7) + (size_t)layer * 512 * D, nullptr, 512, D, (bf16*)(F.ws + WS_WBR) + (size_t)D * 512, D / 32);
    convert_matrix<0>(F, arg_in(8) + (size_t)layer * 512 * D, nullptr, 512, D, (bf16*)(F.ws + WS_WBR) + (size_t)2 * D * 512, D / 32);
    convert_matrix<0>(F, arg_in(9) + (size_t)layer * D * D, nullptr, D, D, (bf16*)(F.ws + WS_WOUT), D / 32);
}

__constant__ float c_inv_freq[32] = {1.000000000e+00f, 7.498942018e-01f, 5.623413324e-01f, 4.216965139e-01f, 3.162277639e-01f, 2.371373922e-01f, 1.778279394e-01f, 1.333521456e-01f,
    1.000000015e-01f, 7.498941571e-02f, 5.623412877e-02f, 4.216964915e-02f, 3.162277862e-02f, 2.371373586e-02f, 1.778279431e-02f, 1.333521493e-02f,
    9.999999776e-03f, 7.498942316e-03f, 5.623413250e-03f, 4.216964822e-03f, 3.162277862e-03f, 2.371373819e-03f, 1.778279431e-03f, 1.333521446e-03f,
    1.000000047e-03f, 7.498941850e-04f, 5.623413017e-04f, 4.216965463e-04f, 3.162277862e-04f, 2.371373848e-04f, 1.778279402e-04f, 1.333521504e-04f};
__device__ __forceinline__ void rope_table(Frame& F) {
    float* cs = (float*)(F.ws + WS_TAB);
    for (int idx = F.vcu * 512 + F.tid; idx < 4096 * 32; idx += F.G * 512) {
        const int pos = idx >> 5, i = idx & 31;
        const float ang = (float)pos * c_inv_freq[i];
        const double rev = (double)ang * 0.15915494309189535; const double fr = rev - __builtin_rint(rev);
        const float f = (float)fr;
        cs[pos * 64 + i] = __builtin_amdgcn_cosf(f); cs[pos * 64 + 32 + i] = __builtin_amdgcn_sinf(f);
    }
}

__device__ __forceinline__ void norm_rows(Frame& F, const float* x, const float* gain, bf16* out) {
    const int gw = F.vcu * NWAVES + F.wave, NGW = F.G * NWAVES;
    f32x4 gv[4];
#pragma unroll
    for (int j = 0; j < 4; ++j) gv[j] = *((const f32x4*)gain + F.lane + 64 * j);
    for (int m = gw; m < M; m += NGW) {
        const GAS f32x4* xr = (const GAS f32x4*)(x + (size_t)m * D) + F.lane;
        f32x4 v[4]; float s = 0.f;
#pragma unroll
        for (int j = 0; j < 4; ++j) { v[j] = xr[64 * j]; s += (v[j].x * v[j].x + v[j].y * v[j].y) + (v[j].z * v[j].z + v[j].w * v[j].w); }
        const float r = 1.0f / sqrtf(wave_sum(s) * (1.f / D) + RMS_EPS);
        GAS v2u* o8 = (GAS v2u*)(out + (size_t)m * D) + F.lane;
#pragma unroll
        for (int j = 0; j < 4; ++j) { v2u w; w.x = pk2(v[j].x * r * gv[j].x, v[j].y * r * gv[j].y); w.y = pk2(v[j].z * r * gv[j].z, v[j].w * r * gv[j].w); o8[64 * j] = w; }
    }
}
__device__ __forceinline__ void final_norm(Frame& F, float* x, const float* gain) {
    const int gw = F.vcu * NWAVES + F.wave, NGW = F.G * NWAVES;
    f32x4 gv[4];
#pragma unroll
    for (int j = 0; j < 4; ++j) gv[j] = *((const f32x4*)gain + F.lane + 64 * j);
    for (int m = gw; m < M; m += NGW) {
        GAS f32x4* xr = (GAS f32x4*)(x + (size_t)m * D) + F.lane;
        f32x4 v[4]; float s = 0.f;
#pragma unroll
        for (int j = 0; j < 4; ++j) { v[j] = xr[64 * j]; s += (v[j].x * v[j].x + v[j].y * v[j].y) + (v[j].z * v[j].z + v[j].w * v[j].w); }
        const float r = 1.0f / sqrtf(wave_sum(s) * (1.f / D) + RMS_EPS);
#pragma unroll
        for (int j = 0; j < 4; ++j) xr[64 * j] = v[j] * r * gv[j];
    }
}

__device__ __forceinline__ void kmean_phase(Frame& F, const bf16* P) {
    const int gw = F.vcu * NWAVES + F.wave, NGW = F.G * NWAVES;
    float* KM = (float*)(F.ws + WS_KMEAN);
    for (int it = gw; it < 64 * 16; it += NGW) {
        const int bh = it >> 4, blk = it & 15, b = bh >> 3, h = bh & 7;
        const bf16* base = P + (size_t)(b * SEQ + blk * 256 + (F.lane >> 3)) * PW + pg8::PC_K + h * 64 + (F.lane & 7) * 8;
        float a[8];
#pragma unroll
        for (int j = 0; j < 8; ++j) a[j] = 0.f;
#pragma unroll 4
        for (int i = 0; i < 32; ++i) { const v4u w = *(const GAS v4u*)(base + (size_t)i * 8 * PW);
            a[0] += bflo(w.x); a[1] += bfhi(w.x); a[2] += bflo(w.y); a[3] += bfhi(w.y); a[4] += bflo(w.z); a[5] += bfhi(w.z); a[6] += bflo(w.w); a[7] += bfhi(w.w); }
#pragma unroll
        for (int j = 0; j < 8; ++j) { a[j] += __shfl_xor(a[j], 8); a[j] += __shfl_xor(a[j], 16); a[j] += __shfl_xor(a[j], 32); }
        if (F.lane < 8) { float* o = KM + (size_t)it * 64 + F.lane * 8;
#pragma unroll
            for (int j = 0; j < 8; ++j) o[j] = a[j] * (1.f / 256.f); }
    }
}

__device__ __forceinline__ void conv_phase(Frame& F, bf16* P, const float* cw, const float* cbias) {
    const int gw = F.vcu * NWAVES + F.wave, NGW = F.G * NWAVES, c0 = F.lane * 8;
    float w0[8], w1[8], w2[8], bb[8];
#pragma unroll
    for (int j = 0; j < 8; ++j) { w0[j] = cw[c0 + j]; w1[j] = cw[512 + c0 + j]; w2[j] = cw[1024 + c0 + j]; bb[j] = cbias[c0 + j]; }
    for (int m = gw; m < M; m += NGW) {
        const int t = m & (SEQ - 1);
        bf16* rp = P + (size_t)m * PW;
        const v4u cb = *(const GAS v4u*)(rp + pg8::PC_CB + c0);
        const v4u u2 = *(const GAS v4u*)(rp + pg8::PC_U + c0);
        v4u u1 = (v4u){0u, 0u, 0u, 0u}, u0 = (v4u){0u, 0u, 0u, 0u};
        if (t >= 1) u1 = *(const GAS v4u*)(rp - PW + pg8::PC_U + c0);
        if (t >= 2) u0 = *(const GAS v4u*)(rp - 2 * PW + pg8::PC_U + c0);
        float y[8];
        const unsigned cbw[4] = {cb.x, cb.y, cb.z, cb.w}, a2[4] = {u2.x, u2.y, u2.z, u2.w}, a1[4] = {u1.x, u1.y, u1.z, u1.w}, a0[4] = {u0.x, u0.y, u0.z, u0.w};
#pragma unroll
        for (int q = 0; q < 4; ++q) {
            y[2 * q] = bflo(cbw[q]) * (w0[2 * q] * bflo(a0[q]) + w1[2 * q] * bflo(a1[q]) + w2[2 * q] * bflo(a2[q]) + bb[2 * q]);
            y[2 * q + 1] = bfhi(cbw[q]) * (w0[2 * q + 1] * bfhi(a0[q]) + w1[2 * q + 1] * bfhi(a1[q]) + w2[2 * q + 1] * bfhi(a2[q]) + bb[2 * q + 1]); }
        v4u o; o.x = pk2(y[0], y[1]); o.y = pk2(y[2], y[3]); o.z = pk2(y[4], y[5]); o.w = pk2(y[6], y[7]);
        *(GAS v4u*)(rp + pg8::PC_CB + c0) = o;
    }
}

__device__ __forceinline__ float ret_lg2(int h) { return h == 0 ? -0.04580368961312479f : (h == 1 ? -0.02272007650008353f : (h == 2 ? -0.011315313227834146f : -0.005646563141142063f)); }
constexpr int RT_QS = 0, RT_KS = 18432, RT_VT = 36864, RT_KZT = 36864 + 34816;
__device__ __forceinline__ void ret_kv_phase(Frame& F, const bf16* P) {
    LAS bf16* vT = (LAS bf16*)(F.lds + RT_VT); LAS bf16* kzT = (LAS bf16*)(F.lds + RT_KZT);
    float* KVt = (float*)(F.ws + WS_KVT);
    const int fr = F.lane & 15, quad = F.lane >> 4;
    for (int unit = F.vcu; unit < 32 * 32; unit += F.G) {
        const int bh = unit >> 5, ch = unit & 31, b = bh >> 2, h = bh & 3; const size_t row0 = (size_t)b * SEQ + ch * 128; const float lg = ret_lg2(h);
#pragma unroll
        for (int i = 0; i < 4; ++i) { const int p = F.tid + 512 * i, mrow = p & 127, c = p >> 7;
            const v4u w = *(const GAS v4u*)(P + (row0 + mrow) * PW + pg8::PC_RV + h * 128 + c * 8); const unsigned ww[4] = {w.x, w.y, w.z, w.w};
#pragma unroll
            for (int q = 0; q < 4; ++q) { vT[(c * 8 + 2 * q) * 136 + mrow] = (bf16)(ww[q] & 0xffffu); vT[(c * 8 + 2 * q + 1) * 136 + mrow] = (bf16)(ww[q] >> 16); } }
#pragma unroll
        for (int i = 0; i < 2; ++i) { const int p = F.tid + 512 * i, mrow = p & 127, c = p >> 7;
            const v4u w = *(const GAS v4u*)(P + (row0 + mrow) * PW + pg8::PC_RK + h * 64 + c * 8); const unsigned ww[4] = {w.x, w.y, w.z, w.w};
            const float zeta = __builtin_amdgcn_exp2f((float)(127 - mrow) * lg);
#pragma unroll
            for (int q = 0; q < 4; ++q) { kzT[(c * 8 + 2 * q) * 136 + mrow] = (bf16)f2bf(bflo(ww[q]) * zeta); kzT[(c * 8 + 2 * q + 1) * 136 + mrow] = (bf16)f2bf(bfhi(ww[q]) * zeta); } }
        __syncthreads();
        f32x4 acc[4];
#pragma unroll
        for (int dt = 0; dt < 4; ++dt) acc[dt] = (f32x4){0.f, 0.f, 0.f, 0.f};
#pragma unroll
        for (int ks = 0; ks < 4; ++ks) {
            const bf16x8 a = *(const LAS bf16x8*)(vT + (16 * F.wave + fr) * 136 + 32 * ks + 8 * quad);
#pragma unroll
            for (int dt = 0; dt < 4; ++dt) { const bf16x8 bb = *(const LAS bf16x8*)(kzT + (16 * dt + fr) * 136 + 32 * ks + 8 * quad);
                acc[dt] = __builtin_amdgcn_mfma_f32_16x16x32_bf16(a, bb, acc[dt], 0, 0, 0); } }
        float* o = KVt + (size_t)unit * 8192;
#pragma unroll
        for (int dt = 0; dt < 4; ++dt)
#pragma unroll
            for (int r = 0; r < 4; ++r) o[(16 * F.wave + 4 * quad + r) * 64 + 16 * dt + fr] = acc[dt][r];
        __syncthreads();
    }
}
__device__ __forceinline__ void ret_scan_phase(Frame& F) {
    const float* KVt = (const float*)(F.ws + WS_KVT); bf16* ST = (bf16*)(F.ws + WS_ST);
    for (int idx = F.vcu * 512 + F.tid; idx < 32 * 2048; idx += F.G * 512) {
        const int bh = idx >> 11, e4 = idx & 2047, h = bh & 3; const float cd = __builtin_amdgcn_exp2f(128.f * ret_lg2(h));
        f32x4 s = (f32x4){0.f, 0.f, 0.f, 0.f};
        const GAS f32x4* kp = (const GAS f32x4*)(KVt + (size_t)bh * 32 * 8192) + e4; GAS v2u* sp = (GAS v2u*)(ST + (size_t)bh * 32 * 8192) + e4;
#pragma unroll 8
        for (int c = 0; c < 32; ++c) { v2u w; w.x = pk2(s.x, s.y); w.y = pk2(s.z, s.w); sp[(size_t)c * 2048] = w; const f32x4 kv = kp[(size_t)c * 2048]; s = s * cd + kv; }
    }
}
__device__ __forceinline__ void ret_out_phase(Frame& F, bf16* P, const float* retw) {
    LAS bf16* qs = (LAS bf16*)(F.lds + RT_QS); LAS bf16* ks_ = (LAS bf16*)(F.lds + RT_KS); LAS bf16* vT = (LAS bf16*)(F.lds + RT_VT);
    const bf16* ST = (const bf16*)(F.ws + WS_ST);
    const int fr = F.lane & 15, quad = F.lane >> 4, w = F.wave;
    for (int unit = F.vcu; unit < 32 * 32; unit += F.G) {
        const int bh = unit >> 5, ch = unit & 31, b = bh >> 2, h = bh & 3; const size_t row0 = (size_t)b * SEQ + ch * 128; const float lg = ret_lg2(h);
#pragma unroll
        for (int i = 0; i < 2; ++i) { const int p = F.tid + 512 * i, r = p >> 3, c = p & 7;
            *(LAS v4u*)(qs + r * 72 + c * 8) = *(const GAS v4u*)(P + (row0 + r) * PW + pg8::PC_RQ + h * 64 + c * 8);
            *(LAS v4u*)(ks_ + r * 72 + c * 8) = *(const GAS v4u*)(P + (row0 + r) * PW + pg8::PC_RK + h * 64 + c * 8); }
#pragma unroll
        for (int i = 0; i < 4; ++i) { const int p = F.tid + 512 * i, mrow = p & 127, c = p >> 7;
            const v4u wv = *(const GAS v4u*)(P + (row0 + mrow) * PW + pg8::PC_RV + h * 128 + c * 8); const unsigned ww[4] = {wv.x, wv.y, wv.z, wv.w};
#pragma unroll
            for (int q = 0; q < 4; ++q) { vT[(c * 8 + 2 * q) * 136 + mrow] = (bf16)(ww[q] & 0xffffu); vT[(c * 8 + 2 * q + 1) * 136 + mrow] = (bf16)(ww[q] >> 16); } }
        __syncthreads();
        bf16x8 qf[2];
#pragma unroll
        for (int k = 0; k < 2; ++k) qf[k] = *(const LAS bf16x8*)(qs + (16 * w + fr) * 72 + 32 * k + 8 * quad);
        f32x4 sT[8];
#pragma unroll
        for (int mt = 0; mt < 8; ++mt) { sT[mt] = (f32x4){0.f, 0.f, 0.f, 0.f};
            if (mt <= w) {
#pragma unroll
                for (int k = 0; k < 2; ++k) { const bf16x8 a = *(const LAS bf16x8*)(ks_ + (16 * mt + fr) * 72 + 32 * k + 8 * quad); sT[mt] = __builtin_amdgcn_mfma_f32_16x16x32_bf16(a, qf[k], sT[mt], 0, 0, 0); }
#pragma unroll
                for (int r = 0; r < 4; ++r) { const int dd = (16 * w + fr) - (16 * mt + 4 * quad + r); sT[mt][r] = (dd >= 0) ? sT[mt][r] * __builtin_amdgcn_exp2f((float)dd * lg) : 0.f; } } }
        f32x4 acc1[8], acc2[8];
#pragma unroll
        for (int et = 0; et < 8; ++et) { acc1[et] = (f32x4){0.f, 0.f, 0.f, 0.f}; acc2[et] = (f32x4){0.f, 0.f, 0.f, 0.f}; }
#pragma unroll
        for (int s = 0; s < 4; ++s) {
            if (2 * s <= w) {
                v4u pbw; pbw.x = pg8::cvt_pk_bf16(sT[2 * s][0], sT[2 * s][1]); pbw.y = pg8::cvt_pk_bf16(sT[2 * s][2], sT[2 * s][3]); pbw.z = pg8::cvt_pk_bf16(sT[2 * s + 1][0], sT[2 * s + 1][1]); pbw.w = pg8::cvt_pk_bf16(sT[2 * s + 1][2], sT[2 * s + 1][3]);
                const bf16x8 pb = __builtin_bit_cast(bf16x8, pbw);
#pragma unroll
                for (int et = 0; et < 8; ++et) { const LAS bf16* vp = vT + (16 * et + fr) * 136 + 32 * s + 4 * quad;
                    const s16x4 lo = *(const LAS s16x4*)vp, hi = *(const LAS s16x4*)(vp + 16);
                    const bf16x8 a = (bf16x8){lo[0], lo[1], lo[2], lo[3], hi[0], hi[1], hi[2], hi[3]};
                    acc1[et] = __builtin_amdgcn_mfma_f32_16x16x32_bf16(a, pb, acc1[et], 0, 0, 0); } } }
        const bf16* st = ST + (size_t)unit * 8192;
#pragma unroll
        for (int et = 0; et < 8; ++et)
#pragma unroll
            for (int k = 0; k < 2; ++k) { const bf16x8 a = *(const GAS bf16x8*)(st + (16 * et + fr) * 64 + 32 * k + 8 * quad); acc2[et] = __builtin_amdgcn_mfma_f32_16x16x32_bf16(a, qf[k], acc2[et], 0, 0, 0); }
        const int n = 16 * w + fr; const float xi = __builtin_amdgcn_exp2f((float)(n + 1) * lg);
        float ss = 0.f;
#pragma unroll
        for (int et = 0; et < 8; ++et) { acc1[et] = acc1[et] + acc2[et] * xi; ss += (acc1[et][0] * acc1[et][0] + acc1[et][1] * acc1[et][1]) + (acc1[et][2] * acc1[et][2] + acc1[et][3] * acc1[et][3]); }
        ss += __shfl_xor(ss, 16); ss += __shfl_xor(ss, 32);
        const float rinv = 1.0f / sqrtf(ss * (1.f / 128.f) + RMS_EPS);
        bf16* yrow = P + (row0 + n) * PW + pg8::PC_RG + h * 128 + 4 * quad;
#pragma unroll
        for (int et = 0; et < 8; ++et) { const f32x4 wv = *(const f32x4*)(retw + h * 128 + 16 * et + 4 * quad); const v2u g = *(const GAS v2u*)(yrow + 16 * et);
            v2u o; o.x = pk2(acc1[et][0] * rinv * wv[0] * bflo(g.x), acc1[et][1] * rinv * wv[1] * bfhi(g.x)); o.y = pk2(acc1[et][2] * rinv * wv[2] * bflo(g.y), acc1[et][3] * rinv * wv[3] * bfhi(g.y));
            *(GAS v2u*)(yrow + 16 * et) = o; }
        __syncthreads();
    }
}

__device__ __forceinline__ void router_flush(Frame& F, int nrows, int mfirst, int NGW, unsigned my_e, float my_p) {
    unsigned* tokE = (unsigned*)(F.ws + WS_TOKE); unsigned* tokIdx = (unsigned*)(F.ws + WS_TOKIDX); float* tokP = (float*)(F.ws + WS_TOKP);
    const bool valid = F.lane < nrows; unsigned idx0 = 0u, idx1 = 0u;
    const unsigned long long lt = (1ull << F.lane) - 1ull;
#pragma unroll
    for (int k = 0; k < 2; ++k)
#pragma unroll
        for (int e = 0; e < NEXP; ++e) {
            const bool mine = valid && (((my_e >> (8 * k)) & 0xffu) == (unsigned)e);
            const unsigned long long mask = __ballot(mine);
            if (mask != 0ull) {
                unsigned base = 0u;
                if (F.lane == 0) base = __hip_atomic_fetch_add((unsigned*)(F.ctl + CW_CNT + 64 * (8 * k + e)), (unsigned)__popcll(mask), RLX_AGENT);
                base = (unsigned)__builtin_amdgcn_readfirstlane((int)base);
                if (mine) { const unsigned v = base + (unsigned)__popcll(mask & lt); if (k == 0) idx0 = v; else idx1 = v; }
            }
        }
    if (valid) { const int m = mfirst + F.lane * NGW; tokE[m] = my_e; tokIdx[2 * m] = idx0; tokIdx[2 * m + 1] = idx1; tokP[m] = my_p; }
}
__device__ __forceinline__ void norm_router_rows(Frame& F, const float* x, const float* gain, const float* wr, bf16* out) {
    const int gw = F.vcu * NWAVES + F.wave, NGW = F.G * NWAVES;
    f32x4 gv[4];
#pragma unroll
    for (int j = 0; j < 4; ++j) gv[j] = *((const f32x4*)gain + F.lane + 64 * j);
    unsigned my_e = 0u; float my_p = 0.f; int nb = 0, mfirst = gw;
    for (int m = gw; m < M; m += NGW) {
        const GAS f32x4* xr = (const GAS f32x4*)(x + (size_t)m * D) + F.lane;
        f32x4 v[4]; float s = 0.f;
#pragma unroll
        for (int j = 0; j < 4; ++j) { v[j] = xr[64 * j]; s += (v[j].x * v[j].x + v[j].y * v[j].y) + (v[j].z * v[j].z + v[j].w * v[j].w); }
        const float r = 1.0f / sqrtf(wave_sum(s) * (1.f / D) + RMS_EPS);
        GAS v2u* o8 = (GAS v2u*)(out + (size_t)m * D) + F.lane;
        float lg[NEXP];
#pragma unroll
        for (int e = 0; e < NEXP; ++e) lg[e] = 0.f;
#pragma unroll
        for (int j = 0; j < 4; ++j) { v[j] = v[j] * r * gv[j];
            v2u w; w.x = pk2(v[j].x, v[j].y); w.y = pk2(v[j].z, v[j].w); o8[64 * j] = w;
            const f32x4* wp = (const f32x4*)(wr + (size_t)(4 * F.lane + 256 * j) * NEXP);
#pragma unroll
            for (int c = 0; c < 4; ++c) { const f32x4 wa = wp[2 * c], wb = wp[2 * c + 1]; const float hv = v[j][c];
                lg[0] += hv * wa[0]; lg[1] += hv * wa[1]; lg[2] += hv * wa[2]; lg[3] += hv * wa[3]; lg[4] += hv * wb[0]; lg[5] += hv * wb[1]; lg[6] += hv * wb[2]; lg[7] += hv * wb[3]; } }
#pragma unroll
        for (int e = 0; e < NEXP; ++e) lg[e] = wave_sum(lg[e]);
        int e0 = 0; float v0 = lg[0];
#pragma unroll
        for (int e = 1; e < NEXP; ++e) if (lg[e] > v0) { v0 = lg[e]; e0 = e; }
        int e1 = -1; float v1 = -INFINITY;
#pragma unroll
        for (int e = 0; e < NEXP; ++e) if (e != e0 && lg[e] > v1) { v1 = lg[e]; e1 = e; }
        const float p0 = 1.0f / (1.0f + __expf(v1 - v0));
        if (F.lane == nb) { my_e = (unsigned)e0 | ((unsigned)e1 << 8); my_p = p0; }
        if (++nb == 64) { router_flush(F, nb, mfirst, NGW, my_e, my_p); nb = 0; mfirst = m + NGW; }
    }
    if (nb > 0) router_flush(F, nb, mfirst, NGW, my_e, my_p);
}
__device__ __forceinline__ void moe_tables(Frame& F, LAS int* tb) {
    if (F.tid < 2) { const int k = F.tid; int t = 0;
        for (int e = 0; e < NEXP; ++e) { tb[16 * k + e] = t; const unsigned c = __hip_atomic_load((unsigned*)(F.ctl + CW_CNT + 64 * (8 * k + e)), RLX_AGENT); t += (int)((c + 255u) >> 8); }
        if (t > MAXSLOT / 256) t = MAXSLOT / 256;
        tb[16 * k + 8] = t; }
    __syncthreads();
}
template <bool FILL>
__device__ __forceinline__ void moe_gather(Frame& F, const LAS int* tb, int k) {
    const int gw = F.vcu * NWAVES + F.wave, NGW = F.G * NWAVES;
    const unsigned* tokE = (const unsigned*)(F.ws + WS_TOKE); const unsigned* tokIdx = (const unsigned*)(F.ws + WS_TOKIDX); const float* tokP = (const float*)(F.ws + WS_TOKP);
    int* tokof = (int*)(F.ws + WS_TOKOF); float* pwof = (float*)(F.ws + WS_PWOF);
    const bf16* H = (const bf16*)(F.ws + WS_H); bf16* XG = (bf16*)(F.ws + WS_XG);
    for (int m = gw; m < M; m += NGW) {
        const unsigned ee = tokE[m]; const int e0 = ee & 0xff, e1 = (ee >> 8) & 0xff; const float p0 = tokP[m];
        const int s0 = tb[e0] * 256 + (int)tokIdx[2 * m], s1 = tb[16 + e1] * 256 + (int)tokIdx[2 * m + 1];
        if (FILL && F.lane == 0) { tokof[s0] = m; pwof[s0] = p0; tokof[MAXSLOT + s1] = m; pwof[MAXSLOT + s1] = 1.0f - p0; }
        const int sk = (k == 0) ? s0 : s1;
        const GAS v4u* src = (const GAS v4u*)(H + (size_t)m * D) + F.lane; GAS v4u* dst = (GAS v4u*)(XG + (size_t)sk * D) + F.lane;
        const v4u a = src[0], b = src[64]; dst[0] = a; dst[64] = b;
    }
}

constexpr int N_PHASES = 24;
struct Args { const float* in[19]; float* out; unsigned char* ws; int ph_lo, ph_hi; };
__global__ void __launch_bounds__(NWAVES * 64, 2) fwd_kernel(Args args) {
    extern __shared__ __attribute__((aligned(16))) unsigned char lds[];
    Frame F;
    F.lds = (LAS unsigned char*)lds;
    F.MISC = (volatile LAS unsigned*)(F.lds + MISC_OFF);
    F.tid = threadIdx.x; F.lane = F.tid & 63; F.wave = __builtin_amdgcn_readfirstlane(F.tid >> 6);
    F.G = gridDim.x; { const int bx = blockIdx.x; F.vcu = (F.G % 8 == 0) ? (bx % 8) * (F.G / 8) + bx / 8 : bx; }
    F.ws = (GAS unsigned char*)args.ws; F.ctl = (gu32*)(F.ws + WS_CTL);
    for (int u = F.tid; u < (LDS_BYTES - LDSCTL_OFF) / 4; u += NWAVES * 64) ((LAS unsigned*)(F.lds + LDSCTL_OFF))[u] = 0u;
    __syncthreads();
    XcdBarrier bar; bar.bar = (unsigned*)(F.ctl + CW_BAR); bar.x = 0; bar.st = nullptr;
    if (!MK_SPLIT) bar = xcd_barrier_post((unsigned*)(F.ctl + CW_BAR), F.MISC + 8);
    const int lo = args.ph_lo, hi = args.ph_hi;
#define OPAQUE_LANES() do { int t_ = threadIdx.x; asm volatile("" : "+v"(t_)); F.tid = t_; F.lane = t_ & 63; \
        int g_ = F.G, v_ = F.vcu; GAS unsigned char* w_ = (GAS unsigned char*)args.ws; GAS float* o_ = (GAS float*)args.out; asm volatile("" : "+s"(g_), "+s"(v_), "+s"(w_), "+s"(o_)); F.G = g_; F.vcu = v_; F.ws = w_; F.ctl = (gu32*)(w_ + WS_CTL); \
        X = (float*)o_; P = (bf16*)(w_ + WS_P); H = (bf16*)(w_ + WS_H); } while (0)
#ifndef SITE_MASK
#define SITE_MASK 0xffffffffu
#endif
#define INS(site, k) ((((SITE_MASK) >> (site)) & 1u) && lo <= (k) && (k) < hi)
#define IN(k) (lo <= (k) && (k) < hi)
#define SEAM(k) do { if (IN((k) + 1)) xcd_barrier(bar); } while (0)
    float* X;
    bf16* P; bf16* H;
    LAS int* tb = (LAS int*)(F.lds + MISC_OFF + 64);

    if (INS(0, 0)) { OPAQUE_LANES();
        convert_mixer_weights(F, 0);
        convert_matrix<2>(F, arg_in(11), arg_in(12), D, FF, (bf16*)(F.ws + WS_W1), 2 * FF / 32);
        convert_matrix<0>(F, arg_in(13), nullptr, FF, D, (bf16*)(F.ws + WS_W2), D / 32);
        rope_table(F);
        norm_rows(F, arg_in(0), arg_in(1), H);
        SEAM(0);
    }
    for (int l = 0; l < 2; ++l) {
        const int pb = 1 + 10 * l;
        if (INS(1, pb + 0)) { OPAQUE_LANES();
            pg8::SchedStd S; S.T.init(M / 256, NPROJ / 256, F.G, (int)blockIdx.x); S.A = (const char*)H; S.B = (const char*)(F.ws + WS_WIN); S.atile = (size_t)256 * D * 2; S.btile = (size_t)256 * D * 2;
            pg8::EpiInproj E{P, (const float*)(F.ws + WS_TAB)};
            pg8::gemm_phase<pg8::EpiInproj, pg8::SchedStd>(F.lds + RING_OFF, D, D, D, S, E);
            SEAM(pb + 0);
        }
        if (INS(2, pb + 1)) { OPAQUE_LANES();
            kmean_phase(F, P);
            ret_kv_phase(F, P);
            conv_phase(F, P, arg_in(3) + (size_t)l * 3 * 512, arg_in(4) + (size_t)l * 512);
            SEAM(pb + 1);
        }
        if (INS(3, pb + 2)) { OPAQUE_LANES(); ret_scan_phase(F); SEAM(pb + 2); }
        if (INS(4, pb + 3)) { OPAQUE_LANES();
            const attn_body::AttnTensors AT{(const attn_body::bf16*)P + pg8::PC_Q, (const attn_body::bf16*)P + pg8::PC_K, (const attn_body::bf16*)P + pg8::PC_V, (attn_body::bf16*)P + pg8::PC_Q, (const float*)(F.ws + WS_KMEAN)};
            const attn_body::StaticOrder S((int)F.G, (int)blockIdx.x);
            attn_body::attn_phase<attn_body::StaticOrder>((char*)lds + RING_OFF, AT, S);
            __syncthreads(); OPAQUE_LANES();
            ret_out_phase(F, P, arg_in(5) + (size_t)l * 512);
            SEAM(pb + 3);
        }
        if (INS(5, pb + 4)) { OPAQUE_LANES();
            pg8::SchedBranch S; S.T.init(M / 256, D / 256, F.G, (int)blockIdx.x); S.A = (const char*)P; S.B = (const char*)(F.ws + WS_WBR);
            S.atile = (size_t)256 * PW * 2; S.btile = (size_t)256 * 512 * 2; S.bmat = (size_t)D * 512 * 2;
            static_assert(pg8::PC_Q == 0 && pg8::PC_CB == 1536 && pg8::PC_RG == 3584, "SchedBranch::a_ptr");
            pg8::EpiBranch E{P, H};
            pg8::gemm_phase<pg8::EpiBranch, pg8::SchedBranch>(F.lds + RING_OFF, 512, PW, 512, S, E);
            SEAM(pb + 4);
        }
        if (INS(6, pb + 5)) { OPAQUE_LANES();
            pg8::SchedStd S; S.T.init(M / 256, D / 256, F.G, (int)blockIdx.x); S.A = (const char*)H; S.B = (const char*)(F.ws + WS_WOUT); S.atile = (size_t)256 * D * 2; S.btile = (size_t)256 * D * 2;
            pg8::EpiResid E{l == 0 ? arg_in(0) : X, X, D};
            pg8::gemm_phase<pg8::EpiResid, pg8::SchedStd>(F.lds + RING_OFF, D, D, D, S, E);
            SEAM(pb + 5);
        }
        if (l == 0) {
            if (INS(7, 7)) { OPAQUE_LANES(); norm_rows(F, X, arg_in(10), H); convert_mixer_weights(F, 1); SEAM(7); }
            if (INS(8, 8)) { OPAQUE_LANES();
                pg8::SchedStd S; S.T.init(M / 256, 2 * FF / 256, F.G, (int)blockIdx.x); S.A = (const char*)H; S.B = (const char*)(F.ws + WS_W1); S.atile = (size_t)256 * D * 2; S.btile = (size_t)256 * D * 2;
                pg8::EpiSwiglu E{(bf16*)(F.ws + WS_ACT), FF};
                pg8::gemm_phase<pg8::EpiSwiglu, pg8::SchedStd>(F.lds + RING_OFF, D, D, D, S, E);
                SEAM(8);
            }
            if (INS(9, 9)) { OPAQUE_LANES();
                pg8::SchedStd S; S.T.init(M / 256, D / 256, F.G, (int)blockIdx.x); S.A = (const char*)(F.ws + WS_ACT); S.B = (const char*)(F.ws + WS_W2); S.atile = (size_t)256 * FF * 2; S.btile = (size_t)256 * FF * 2;
                pg8::EpiResid E{X, X, D};
                pg8::gemm_phase<pg8::EpiResid, pg8::SchedStd>(F.lds + RING_OFF, FF, FF, FF, S, E);
                SEAM(9);
            }
            if (INS(10, 10)) { OPAQUE_LANES(); norm_rows(F, X, arg_in(1) + D, H); SEAM(10); }
        } else {
            if (INS(11, 17)) { OPAQUE_LANES();
                norm_router_rows(F, X, arg_in(10) + D, arg_in(14), H);
                for (int e = 0; e < NEXP; ++e) {
                    convert_matrix<2>(F, arg_in(15) + (size_t)e * D * FF, arg_in(16) + (size_t)e * D * FF, D, FF, (bf16*)(F.ws + WS_MW1) + (size_t)e * 2 * FF * D, 2 * FF / 32);
                    convert_matrix<0>(F, arg_in(17) + (size_t)e * FF * D, nullptr, FF, D, (bf16*)(F.ws + WS_MW2) + (size_t)e * D * FF, D / 32);
                }
                int* tokof = (int*)(F.ws + WS_TOKOF); float* pwof = (float*)(F.ws + WS_PWOF);
                for (int i = F.vcu * 512 + F.tid; i < 2 * MAXSLOT; i += F.G * 512) { tokof[i] = -1; pwof[i] = 0.f; }
                SEAM(17);
            }
            if (INS(12, 18)) { OPAQUE_LANES(); moe_tables(F, tb); moe_gather<true>(F, tb, 0); SEAM(18); }
            for (int k = 0; k < 2; ++k) {
                if (INS(13, 19 + 2 * k)) { OPAQUE_LANES();
                    moe_tables(F, tb);
                    pg8::SchedMoe S; S.T.init(tb[16 * k + 8], 2 * FF / 256, F.G, (int)blockIdx.x); S.A = (const char*)(F.ws + WS_XG); S.B = (const char*)(F.ws + WS_MW1);
                    S.atile = (size_t)256 * D * 2; S.btile = (size_t)256 * D * 2; S.bexp = (size_t)2 * FF * D * 2; S.tbase = tb + 16 * k;
                    pg8::EpiSwiglu E{(bf16*)(F.ws + WS_ACTM), FF};
                    pg8::gemm_phase<pg8::EpiSwiglu, pg8::SchedMoe>(F.lds + RING_OFF, D, D, D, S, E);
                    SEAM(19 + 2 * k);
                }
                if (INS(14, 20 + 2 * k)) { OPAQUE_LANES();
                    moe_tables(F, tb);
                    pg8::SchedMoe S; S.T.init(tb[16 * k + 8], D / 256, F.G, (int)blockIdx.x); S.A = (const char*)(F.ws + WS_ACTM); S.B = (const char*)(F.ws + WS_MW2);
                    S.atile = (size_t)256 * FF * 2; S.btile = (size_t)256 * FF * 2; S.bexp = (size_t)D * FF * 2; S.tbase = tb + 16 * k;
                    pg8::EpiMoeDown E{X, (const int*)(F.ws + WS_TOKOF) + (size_t)k * MAXSLOT, (const float*)(F.ws + WS_PWOF) + (size_t)k * MAXSLOT};
                    pg8::gemm_phase<pg8::EpiMoeDown, pg8::SchedMoe>(F.lds + RING_OFF, FF, FF, FF, S, E);
                    if (k == 0) moe_gather<false>(F, tb, 1);
                    SEAM(20 + 2 * k);
                }
            }
            if (INS(15, 23)) { OPAQUE_LANES(); final_norm(F, X, arg_in(18)); }
        }
    }
#undef IN
#undef INS
#undef SEAM
}

extern "C" void kernel_launch(void* const* d_in, const int* in_sizes, int n_in, void* d_out, int out_size, void* d_ws, size_t ws_size, hipStream_t stream) {
    static int grid = 0;
    if (grid == 0) {
        if (n_in != 19 || in_sizes[0] != M * D || out_size != M * D || ws_size < WS_END) { fprintf(stderr, "kernel_launch: unexpected problem shape or workspace (%d inputs, ws %zu < %zu); nothing launched\n", n_in, ws_size, (size_t)WS_END); grid = -1; return; }
        int dev = 0, cus = 0, per_cu = 0;
        if (hipGetDevice(&dev) != hipSuccess || hipDeviceGetAttribute(&cus, hipDeviceAttributeMultiprocessorCount, dev) != hipSuccess) { grid = -1; return; }
        if (hipFuncSetAttribute((const void*)fwd_kernel, hipFuncAttributeMaxDynamicSharedMemorySize, LDS_BYTES) != hipSuccess) { fprintf(stderr, "kernel_launch: hipFuncSetAttribute failed\n"); grid = -1; return; }
        if (hipOccupancyMaxActiveBlocksPerMultiprocessor(&per_cu, (const void*)fwd_kernel, NWAVES * 64, LDS_BYTES) != hipSuccess || per_cu < 1)
            fprintf(stderr, "kernel_launch: note: occupancy query reports %d workgroups per CU\n", per_cu);
        (void)hipGetLastError();
        grid = cus;
    }
    if (grid < 0) return;
    if (hipMemsetAsync((char*)d_ws + WS_CTL, 0, CTL_ZERO_BYTES, stream) != hipSuccess) return;
    Args a{};
    for (int i = 0; i < 19; ++i) a.in[i] = (const float*)d_in[i];
    a.out = (float*)d_out; a.ws = (unsigned char*)d_ws;
#if MK_SPLIT
    for (int p = 0; p < N_PHASES; ++p) { a.ph_lo = p; a.ph_hi = p + 1; hipLaunchKernelGGL(fwd_kernel, dim3(grid), dim3(NWAVES * 64), LDS_BYTES, stream, a); }
#else
    a.ph_lo = 0; a.ph_hi = N_PHASES;
    hipLaunchKernelGGL(fwd_kernel, dim3(grid), dim3(NWAVES * 64), LDS_BYTES, stream, a);
#endif
}
```

```cpp
#include <hip/hip_runtime.h>
#include <hip/hip_bf16.h>
#include <cstdio>
#include <cstdint>
#include <cmath>

#ifndef MK_SPLIT
#define MK_SPLIT 0
#endif

namespace pg8 {
#define PG8_LAS __attribute__((address_space(3)))
typedef unsigned short bf16_t;
typedef short bf16x8 __attribute__((ext_vector_type(8)));
typedef float f32x4 __attribute__((ext_vector_type(4)));
typedef float f32x2 __attribute__((ext_vector_type(2)));
typedef unsigned u32x4 __attribute__((ext_vector_type(4)));
typedef unsigned u32x2 __attribute__((ext_vector_type(2)));
typedef int v4i_t __attribute__((ext_vector_type(4)));
typedef int v8i_t __attribute__((ext_vector_type(8)));
constexpr int BM = 256, BK = 64, HALF = 128, HTB = HALF * BK * 2  , STAGE_BYTES = 8 * HTB, NXCD = 8, WGM = 8;

__host__ __device__ __forceinline__ int lds_byte(int r, int c) { const int st = (r >> 4) * 2 + (c >> 5), rr = r & 15, cc = c & 31, ob = rr * 64 + cc * 2; return st * 1024 + (ob ^ (((ob >> 9) & 1) << 5)); }
__host__ __device__ __forceinline__ void stage_rc(int b, int& R, int& C) { const int st = b / 1024, sb = b % 1024, swz = sb ^ (((sb >> 9) & 1) << 5); R = (st >> 1) * 16 + swz / 64; C = (st & 1) * 32 + (swz % 64) / 2; }
__host__ __device__ __forceinline__ int perm32(int rho) { const int n = rho >> 4, i = rho & 15; return 8 * (i >> 2) + 4 * n + (i & 3); }

struct Unit { int pm, pn, z; };

struct TileOrder {
    int nM, nN, nwg, G, c;
    __device__ __forceinline__ void init(int nM_, int nN_, int G_, int c_) { nM = nM_; nN = nN_; nwg = nM * nN; G = G_; c = c_; }
    __device__ __forceinline__ bool tile(int i, int& pm, int& pn) const {
        const long L = (long)i * G + c; if (L >= nwg) return false;
        int wgid = (int)L; { const int q = nwg / NXCD, r = nwg % NXCD, xcd = wgid % NXCD, off = wgid / NXCD; wgid = (xcd < r ? xcd * (q + 1) : r * (q + 1) + (xcd - r) * q) + off; }
        const int nig = WGM * nN, gid = wgid / nig, fm = gid * WGM, gsz = (nM - fm) < WGM ? (nM - fm) : WGM;
        pm = fm + ((wgid % nig) % gsz); pn = (wgid % nig) / gsz; return true;
    }
};
struct SchedStd {
    TileOrder T; const char* A; const char* B; size_t atile, btile;
    __device__ __forceinline__ bool next(int i, Unit& u) const { u.z = 0; return T.tile(i, u.pm, u.pn); }
    __device__ __forceinline__ const char* a_ptr(const Unit& u) const { return A + (size_t)u.pm * atile; }
    __device__ __forceinline__ const char* b_ptr(const Unit& u) const { return B + (size_t)u.pn * btile; }
};
struct SchedBranch {
    TileOrder T; const char* A; const char* B; size_t atile, btile, bmat;
    __device__ __forceinline__ bool next(int i, Unit& u) const { u.z = i % 3; return T.tile(i / 3, u.pm, u.pn); }
    __device__ __forceinline__ const char* a_ptr(const Unit& u) const { return A + (size_t)u.pm * atile + (size_t)((256 * u.z * u.z + 1280 * u.z) * 2); }
    __device__ __forceinline__ const char* b_ptr(const Unit& u) const { return B + (size_t)u.z * bmat + (size_t)u.pn * btile; }
};
struct SchedMoe {
    TileOrder T; const char* A; const char* B; size_t atile, btile, bexp; const PG8_LAS int* tbase;
    __device__ __forceinline__ bool next(int i, Unit& u) const { u.z = 0; return T.tile(i, u.pm, u.pn); }
    __device__ __forceinline__ const char* a_ptr(const Unit& u) const { return A + (size_t)u.pm * atile; }
    __device__ __forceinline__ const char* b_ptr(const Unit& u) const {
        int e = 0;
#pragma unroll
        for (int j = 1; j < 8; ++j) e += (u.pm >= tbase[j]) ? 1 : 0;
        return B + (size_t)e * bexp + (size_t)u.pn * btile; }
};

__device__ __forceinline__ unsigned cvt_pk_bf16(float lo, float hi) { unsigned r; asm volatile("v_cvt_pk_bf16_f32 %0, %1, %2" : "=v"(r) : "v"(lo), "v"(hi)); return r; }
__device__ __forceinline__ float bf_lo(unsigned w) { return __builtin_bit_cast(float, w << 16); }
__device__ __forceinline__ float bf_hi(unsigned w) { return __builtin_bit_cast(float, w & 0xffff0000u); }
__device__ __forceinline__ float fsigmoid(float x) { return __builtin_amdgcn_rcpf(1.0f + __builtin_amdgcn_exp2f(-1.4426950408889634f * x)); }

template <class Epi, class Sched, bool FP8 = false>
__device__ __forceinline__ void gemm_phase(PG8_LAS unsigned char* lds, const int wave, const int K, const int lda, const int ldb, const Sched& S, const Epi& E) {
    unsigned on_ = ~0u; asm volatile("" : "+s"(on_)); int tid_ = (int)__builtin_amdgcn_mbcnt_hi(on_, __builtin_amdgcn_mbcnt_lo(on_, 0u)) + 64 * wave; asm volatile("" : "+v"(tid_));
    const int tid = tid_, wid = __builtin_amdgcn_readfirstlane(tid >> 6), lane = tid & 63, wr = wid >> 2, wc = wid & 3, fr = lane & 15, fq = lane >> 4;
    const int nt = K / BK;
    unsigned voffA[2], voffB[2];
#pragma unroll
    for (int i = 0; i < 2; ++i) { int R, C; stage_rc(tid * 16 + i * 8192, R, C); const int Rb = Epi::PERM ? ((R & ~31) + perm32(R & 31)) : R;
        voffA[i] = (unsigned)(R * lda + C) * 2u; voffB[i] = (unsigned)(Rb * ldb + C) * 2u; }
    const size_t kstep = (size_t)(BK * 2);
    const size_t hsA = (size_t)HALF * lda * 2, hsB = (size_t)HALF * ldb * 2;
    const unsigned ldsw = (unsigned)wid * 1024u;
    const int aoff = lds_byte(wr * 64 + fr, fq * 8), boff = lds_byte(wc * 32 + fr, fq * 8);
#define PG8_SA(b, h) (((b) * 2 + (h)) * HTB)
#define PG8_SB(b, h) ((4 + (b) * 2 + (h)) * HTB)
#define PG8_STAGE(bufoff, gbase, voff) do { _Pragma("unroll") for (int _i = 0; _i < 2; ++_i) \
        __builtin_amdgcn_global_load_lds((const unsigned*)((const char*)(gbase) + (voff)[_i]), (PG8_LAS unsigned*)(lds + (bufoff) + ldsw + _i * 8192), 16, 0, 0); } while (0)
#define PG8_LDA(dst, b, h) do { _Pragma("unroll") for (int m = 0; m < 4; ++m) { const v4i_t lo_ = *(const PG8_LAS v4i_t*)(lds + PG8_SA(b, h) + aoff + m * 2048), hi_ = *(const PG8_LAS v4i_t*)(lds + PG8_SA(b, h) + aoff + m * 2048 + 1024); \
        dst[m] = __builtin_shufflevector(lo_, hi_, 0, 1, 2, 3, 4, 5, 6, 7); } } while (0)
#define PG8_LDB(dst, b, h) do { _Pragma("unroll") for (int n = 0; n < 2; ++n) { const v4i_t lo_ = *(const PG8_LAS v4i_t*)(lds + PG8_SB(b, h) + boff + n * 2048), hi_ = *(const PG8_LAS v4i_t*)(lds + PG8_SB(b, h) + boff + n * 2048 + 1024); \
        dst[n] = __builtin_shufflevector(lo_, hi_, 0, 1, 2, 3, 4, 5, 6, 7); } } while (0)
#define PG8_LO(x) __builtin_bit_cast(bf16x8, __builtin_shufflevector(x, x, 0, 1, 2, 3))
#define PG8_HI(x) __builtin_bit_cast(bf16x8, __builtin_shufflevector(x, x, 4, 5, 6, 7))
#define PG8_MMA(ai, bj, At, Bt) do { __builtin_amdgcn_s_setprio(1); _Pragma("unroll") for (int m = 0; m < 4; ++m) _Pragma("unroll") for (int n = 0; n < 2; ++n) { \
        if constexpr (FP8) asm volatile("v_mfma_f32_16x16x128_f8f6f4 %0, %1, %2, %0" : "+v"(acc[ai][bj][m][n]) : "v"(Bt[n]), "v"(At[m])); \
        else { acc[ai][bj][m][n] = __builtin_amdgcn_mfma_f32_16x16x32_bf16(PG8_LO(Bt[n]), PG8_LO(At[m]), acc[ai][bj][m][n], 0, 0, 0); \
               acc[ai][bj][m][n] = __builtin_amdgcn_mfma_f32_16x16x32_bf16(PG8_HI(Bt[n]), PG8_HI(At[m]), acc[ai][bj][m][n], 0, 0, 0); } } \
        __builtin_amdgcn_s_setprio(0); } while (0)
#define PG8_WAIT_V(n) asm volatile("s_waitcnt vmcnt(" #n ")" ::: "memory")
#define PG8_WAIT_L(n) asm volatile("s_waitcnt lgkmcnt(" #n ")" ::: "memory")
#define PG8_BAR __builtin_amdgcn_s_barrier()
#define PG8_SCHED __builtin_amdgcn_sched_barrier(0)
    Unit cur, nxt; int ui = 0;
    if (!S.next(0, cur)) return;
    f32x4 acc[2][2][4][2];
#pragma unroll
    for (int a = 0; a < 2; ++a)
#pragma unroll
        for (int b = 0; b < 2; ++b)
#pragma unroll
            for (int m = 0; m < 4; ++m)
#pragma unroll
                for (int n = 0; n < 2; ++n) acc[a][b][m][n] = (f32x4){0.f, 0.f, 0.f, 0.f};
    v8i_t At[4], B0[2], B1[2];
    const char* cA = S.a_ptr(cur); const char* cB = S.b_ptr(cur);
    PG8_STAGE(PG8_SB(0, 0), cB, voffB); PG8_STAGE(PG8_SB(0, 1), cB + hsB, voffB); PG8_STAGE(PG8_SA(0, 0), cA, voffA); PG8_STAGE(PG8_SA(0, 1), cA + hsA, voffA);
    if (wr == 1) PG8_BAR;
    PG8_WAIT_V(2); PG8_BAR;
    PG8_STAGE(PG8_SB(1, 0), cB + kstep, voffB); PG8_STAGE(PG8_SA(1, 0), cA + kstep, voffA); PG8_STAGE(PG8_SB(1, 1), cB + hsB + kstep, voffB);
    PG8_WAIT_V(6); PG8_BAR;
    for (;;) {
        const bool has_next = S.next(ui + 1, nxt);
        const char* nA = has_next ? S.a_ptr(nxt) : cA; const char* nB = has_next ? S.b_ptr(nxt) : cB;
        for (int t = 0; t < nt; t += 2) {
            const bool last = (t == nt - 2);
            const char* a1 = cA + (size_t)(t + 1) * kstep;
            const char* a2 = last ? nA : cA + (size_t)(t + 2) * kstep; const char* b2 = last ? nB : cB + (size_t)(t + 2) * kstep;
            const char* a3 = a2 + kstep; const char* b3 = b2 + kstep;
            PG8_LDB(B0, 0, 0); PG8_LDB(B1, 0, 1); PG8_SCHED; PG8_LDA(At, 0, 0); PG8_STAGE(PG8_SA(1, 1), a1 + hsA, voffA);
            PG8_WAIT_V(8); PG8_WAIT_L(0); PG8_BAR; PG8_MMA(0, 0, At, B0); PG8_MMA(0, 1, At, B1); PG8_BAR; PG8_SCHED;
            PG8_LDA(At, 0, 1); PG8_STAGE(PG8_SB(0, 0), b2, voffB); PG8_STAGE(PG8_SB(0, 1), b2 + hsB, voffB); PG8_STAGE(PG8_SA(0, 0), a2, voffA);
            PG8_WAIT_V(8); PG8_WAIT_L(0); PG8_BAR; PG8_MMA(1, 0, At, B0); PG8_MMA(1, 1, At, B1); PG8_BAR; PG8_SCHED;
            PG8_LDB(B0, 1, 0); PG8_LDB(B1, 1, 1); PG8_SCHED; PG8_LDA(At, 1, 0); PG8_STAGE(PG8_SA(0, 1), a2 + hsA, voffA);
            PG8_WAIT_V(8); PG8_WAIT_L(0); PG8_BAR; PG8_MMA(0, 0, At, B0); PG8_MMA(0, 1, At, B1); PG8_BAR; PG8_SCHED;
            PG8_LDA(At, 1, 1); PG8_STAGE(PG8_SB(1, 0), b3, voffB); PG8_STAGE(PG8_SB(1, 1), b3 + hsB, voffB); PG8_STAGE(PG8_SA(1, 0), a3, voffA);
            PG8_WAIT_V(8); PG8_WAIT_L(0); PG8_BAR; PG8_MMA(1, 0, At, B0); PG8_MMA(1, 1, At, B1); PG8_BAR; PG8_SCHED;
        }
        if (wr == 0) PG8_BAR;
        if constexpr (FP8) asm volatile("s_nop 15\n\ts_nop 7" ::: "memory");
        { unsigned on2_ = ~0u; asm volatile("" : "+s"(on2_)); const int l2_ = (int)__builtin_amdgcn_mbcnt_hi(on2_, __builtin_amdgcn_mbcnt_lo(on2_, 0u)); E(acc, cur, wr, wc, l2_ & 15, l2_ >> 4); }
        if (!has_next) break;
#pragma unroll
        for (int a = 0; a < 2; ++a)
#pragma unroll
            for (int b = 0; b < 2; ++b)
#pragma unroll
                for (int m = 0; m < 4; ++m)
#pragma unroll
                    for (int n = 0; n < 2; ++n) acc[a][b][m][n] = (f32x4){0.f, 0.f, 0.f, 0.f};
        cur = nxt; cA = nA; cB = nB; ++ui;
        if (wr == 1) PG8_BAR;
    }
    PG8_WAIT_V(0);
    PG8_BAR;
#undef PG8_SA
#undef PG8_SB
#undef PG8_STAGE
#undef PG8_LDA
#undef PG8_LDB
#undef PG8_MMA
#undef PG8_LO
#undef PG8_HI
#undef PG8_WAIT_V
#undef PG8_WAIT_L
#undef PG8_BAR
#undef PG8_SCHED
}

constexpr int PW = 7168;
constexpr int PC_Q = 0, PC_K = 512, PC_V = 1024, PC_CB = 1536, PC_U = 2048, PC_RQ = 2560, PC_RK = 2816, PC_RV = 3072, PC_RG = 3584, PC_G = 4096;
constexpr float QSCALE = 0.125f * 1.4426950408889634f;

__device__ __forceinline__ u32x4 pack8(const f32x4& a, const f32x4& b) { u32x4 w; w.x = cvt_pk_bf16(a[0], a[1]); w.y = cvt_pk_bf16(a[2], a[3]); w.z = cvt_pk_bf16(b[0], b[1]); w.w = cvt_pk_bf16(b[2], b[3]); return w; }

struct EpiInproj {
    static constexpr bool PERM = true;
    bf16_t* P; const float* cs;
    __device__ __forceinline__ void operator()(const f32x4 (&acc)[2][2][4][2], const Unit& u, int wr, int wc, int fr, int fq) const {
        const int pn = u.pn, row0 = u.pm * BM + wr * 64 + fr;
        const int tb = (pn < 8) ? pn * 256 : pn * 256 - 512;
        if (pn < 4 || pn == 12 || pn == 13) {
            const float sc = (pn < 2) ? QSCALE : ((pn == 13) ? 0.125f : 1.0f);
            const int ob = tb + wc * 64 + 8 * fq;
#pragma unroll
            for (int ai = 0; ai < 2; ++ai)
#pragma unroll
                for (int m = 0; m < 4; ++m) { const int row = row0 + ai * HALF + m * 16; const float* t = cs + (size_t)(row & 4095) * 64 + 8 * fq;
                    const f32x4 c0 = *(const f32x4*)(t), c1 = *(const f32x4*)(t + 4), s0 = *(const f32x4*)(t + 32), s1 = *(const f32x4*)(t + 36);
                    const f32x4 x1a = acc[ai][0][m][0], x1b = acc[ai][0][m][1], x2a = acc[ai][1][m][0], x2b = acc[ai][1][m][1];
                    const f32x4 o1a = (x1a * c0 - x2a * s0) * sc, o1b = (x1b * c1 - x2b * s1) * sc, o2a = (x2a * c0 + x1a * s0) * sc, o2b = (x2b * c1 + x1b * s1) * sc;
                    bf16_t* rp = P + (size_t)row * PW + ob;
                    *(u32x4*)(rp) = pack8(o1a, o1b); *(u32x4*)(rp + 32) = pack8(o2a, o2b);
                    if (m & 1) asm volatile("" ::: "memory"); }
        } else if (pn >= 8 && pn < 12) {
            const int ob = PC_U + 128 * (pn - 8) + 32 * wc + 8 * fq;
#pragma unroll
            for (int ai = 0; ai < 2; ++ai)
#pragma unroll
                for (int m = 0; m < 4; ++m) { const int row = row0 + ai * HALF + m * 16;
                    *(u32x4*)(P + (size_t)row * PW + ob) = pack8(acc[ai][0][m][0] * acc[ai][1][m][0], acc[ai][0][m][1] * acc[ai][1][m][1]); }
        } else {
            const int kind = (pn >= 18) ? 2 : ((pn >= 16) ? 1 : 0);
            const int ob = tb + 32 * wc + 8 * fq;
#pragma unroll
            for (int ai = 0; ai < 2; ++ai)
#pragma unroll
                for (int m = 0; m < 4; ++m) { const int row = row0 + ai * HALF + m * 16;
#pragma unroll
                    for (int bj = 0; bj < 2; ++bj) { f32x4 v0 = acc[ai][bj][m][0], v1 = acc[ai][bj][m][1];
                        if (kind != 0) {
#pragma unroll
                            for (int e = 0; e < 4; ++e) { const float g0 = fsigmoid(v0[e]), g1 = fsigmoid(v1[e]); v0[e] = (kind == 1) ? v0[e] * g0 : g0; v1[e] = (kind == 1) ? v1[e] * g1 : g1; } }
                        *(u32x4*)(P + (size_t)row * PW + ob + bj * HALF) = pack8(v0, v1); } }
        }
    }
};
struct EpiBranch {
    static constexpr bool PERM = true;
    const bf16_t* P; bf16_t* Mg;
    __device__ __forceinline__ void operator()(const f32x4 (&acc)[2][2][4][2], const Unit& u, int wr, int wc, int fr, int fq) const {
        const int row0 = u.pm * BM + wr * 64 + fr, col0 = u.pn * BM + wc * 32 + 8 * fq, z = u.z;
#pragma unroll
        for (int ai = 0; ai < 2; ++ai) {
            u32x4 g[4][2], p[4][2];
#pragma unroll
            for (int m = 0; m < 4; ++m)
#pragma unroll
                for (int bj = 0; bj < 2; ++bj) { const int row = row0 + ai * HALF + m * 16, col = col0 + bj * HALF;
                    g[m][bj] = *(const u32x4*)(P + (size_t)row * PW + PC_G + 1024 * z + col);
                    p[m][bj] = (z != 0) ? *(const u32x4*)(Mg + (size_t)row * 1024 + col) : (u32x4){0u, 0u, 0u, 0u}; }
#pragma unroll
            for (int m = 0; m < 4; ++m)
#pragma unroll
                for (int bj = 0; bj < 2; ++bj) { const int row = row0 + ai * HALF + m * 16, col = col0 + bj * HALF;
                    f32x4 v0 = acc[ai][bj][m][0], v1 = acc[ai][bj][m][1]; const u32x4 gg = g[m][bj], pp = p[m][bj];
                    v0[0] = v0[0] * bf_lo(gg.x) + bf_lo(pp.x); v0[1] = v0[1] * bf_hi(gg.x) + bf_hi(pp.x); v0[2] = v0[2] * bf_lo(gg.y) + bf_lo(pp.y); v0[3] = v0[3] * bf_hi(gg.y) + bf_hi(pp.y);
                    v1[0] = v1[0] * bf_lo(gg.z) + bf_lo(pp.z); v1[1] = v1[1] * bf_hi(gg.z) + bf_hi(pp.z); v1[2] = v1[2] * bf_lo(gg.w) + bf_lo(pp.w); v1[3] = v1[3] * bf_hi(gg.w) + bf_hi(pp.w);
                    *(u32x4*)(Mg + (size_t)row * 1024 + col) = pack8(v0, v1); }
            asm volatile("" ::: "memory");
        }
    }
};
struct EpiResid {
    static constexpr bool PERM = false;
    const float* res; float* out; int ldc;
    __device__ __forceinline__ void operator()(const f32x4 (&acc)[2][2][4][2], const Unit& u, int wr, int wc, int fr, int fq) const {
        const int row0 = u.pm * BM + wr * 64 + fr, col0 = u.pn * BM + wc * 32 + 4 * fq;
#pragma unroll
        for (int ai = 0; ai < 2; ++ai) {
            f32x4 r[4][2][2];
#pragma unroll
            for (int m = 0; m < 4; ++m) { const size_t off = (size_t)(row0 + ai * HALF + m * 16) * ldc + col0;
#pragma unroll
                for (int bj = 0; bj < 2; ++bj)
#pragma unroll
                    for (int n = 0; n < 2; ++n) r[m][bj][n] = *(const f32x4*)(res + off + bj * HALF + n * 16); }
#pragma unroll
            for (int m = 0; m < 4; ++m) { const size_t off = (size_t)(row0 + ai * HALF + m * 16) * ldc + col0;
#pragma unroll
                for (int bj = 0; bj < 2; ++bj)
#pragma unroll
                    for (int n = 0; n < 2; ++n) *(f32x4*)(out + off + bj * HALF + n * 16) = r[m][bj][n] + acc[ai][bj][m][n]; }
            asm volatile("" ::: "memory");
        }
    }
};
struct EpiSwiglu {
    static constexpr bool PERM = true;
    bf16_t* O; int ldo;
    __device__ __forceinline__ void operator()(const f32x4 (&acc)[2][2][4][2], const Unit& u, int wr, int wc, int fr, int fq) const {
        const int row0 = u.pm * BM + wr * 64 + fr, col0 = u.pn * HALF + wc * 32 + 8 * fq;
#pragma unroll
        for (int ai = 0; ai < 2; ++ai)
#pragma unroll
            for (int m = 0; m < 4; ++m) { f32x4 v0, v1; const f32x4 g0 = acc[ai][0][m][0], g1 = acc[ai][0][m][1], u0 = acc[ai][1][m][0], u1 = acc[ai][1][m][1];
#pragma unroll
                for (int e = 0; e < 4; ++e) { v0[e] = g0[e] * fsigmoid(g0[e]) * u0[e]; v1[e] = g1[e] * fsigmoid(g1[e]) * u1[e]; }
                *(u32x4*)(O + (size_t)(row0 + ai * HALF + m * 16) * ldo + col0) = pack8(v0, v1); }
    }
};
__device__ __forceinline__ unsigned pk_fp8x4(float a, float b, float c, float d) { int w = __builtin_amdgcn_cvt_pk_fp8_f32(a, b, 0, false); w = __builtin_amdgcn_cvt_pk_fp8_f32(c, d, w, true); return (unsigned)w; }
struct EpiSwiglu8 {
    static constexpr bool PERM = true;
    unsigned char* O; int ldo;
    __device__ __forceinline__ void operator()(const f32x4 (&acc)[2][2][4][2], const Unit& u, int wr, int wc, int fr, int fq) const {
        const int row0 = u.pm * BM + wr * 64 + fr, col0 = u.pn * HALF + wc * 32 + 8 * fq;
#pragma unroll
        for (int ai = 0; ai < 2; ++ai)
#pragma unroll
            for (int m = 0; m < 4; ++m) { f32x4 v0, v1; const f32x4 g0 = acc[ai][0][m][0] * 0.03125f, g1 = acc[ai][0][m][1] * 0.03125f, u0 = acc[ai][1][m][0] * 0.25f, u1 = acc[ai][1][m][1] * 0.25f;
#pragma unroll
                for (int e = 0; e < 4; ++e) { v0[e] = g0[e] * fsigmoid(g0[e]) * u0[e]; v1[e] = g1[e] * fsigmoid(g1[e]) * u1[e]; }
                u32x2 w; w.x = pk_fp8x4(v0[0], v0[1], v0[2], v0[3]); w.y = pk_fp8x4(v1[0], v1[1], v1[2], v1[3]);
                *(u32x2*)(O + (size_t)(row0 + ai * HALF + m * 16) * ldo + col0) = w; }
    }
};
struct EpiMoeY {
    static constexpr bool PERM = true;
    bf16_t* Y; const int* tok; const float* pw;
    __device__ __forceinline__ void operator()(const f32x4 (&acc)[2][2][4][2], const Unit& u, int wr, int wc, int fr, int fq) const {
        const int slot0 = u.pm * BM + wr * 64 + fr, col0 = u.pn * BM + wc * 32 + 8 * fq;
#pragma unroll
        for (int ai = 0; ai < 2; ++ai)
#pragma unroll
            for (int m = 0; m < 4; ++m) { const int slot = slot0 + ai * HALF + m * 16; const int t = tok[slot]; const float p = pw[slot] * (1.0f / 256.0f);
                if (t >= 0) { bf16_t* yp = Y + ((size_t)(t >> 30) * 32768 + (size_t)(t & 0x3fffffff)) * 1024 + col0;
#pragma unroll
                    for (int bj = 0; bj < 2; ++bj) *(u32x4*)(yp + bj * HALF) = pack8(acc[ai][bj][m][0] * p, acc[ai][bj][m][1] * p); } }
    }
};
}
namespace attn_body {
using bf16=__hip_bfloat16;
using bf16x8=__attribute__((ext_vector_type(8)))short;
using s16x4=__attribute__((ext_vector_type(4)))short;
using f32x16=__attribute__((ext_vector_type(16)))float;
using u32x4=__attribute__((ext_vector_type(4)))unsigned;
constexpr int BATCH=8,NHEAD=8,SEQ=4096,D=64,DM=7168;
constexpr int NW=8,QBLK=32,QB=QBLK*NW,KVBLK=64,NQB=SEQ/QB;
constexpr int ATTN_PITCH=DM, ATTN_UNIT_ROWS=QB;
__device__ __forceinline__ int crow(int r,int hi){return (r&3)+8*(r>>2)+4*hi;}
#define SBAR() __builtin_amdgcn_sched_barrier(0)
__device__ __forceinline__ void cmask(f32x16&p0,f32x16&p1,int jb,int qrel,int hi){
  const float NEG=-INFINITY; int kb=64*jb+4*hi;
  #pragma unroll
  for(int r=0;r<16;++r){int kv=kb+(r&3)+8*(r>>2); if(kv>qrel)p0[r]=NEG; if(kv+32>qrel)p1[r]=NEG;}
}

__device__ __forceinline__ void bmask(f32x16&p0,f32x16&p1,unsigned keep){
  const float NEG=-INFINITY;
  if(!keep){
  #pragma unroll
  for(int r=0;r<16;++r){p0[r]=NEG;p1[r]=NEG;} }
}
constexpr int NSLOT=3, SLOTB=8192;
constexpr int LDS_K=0, LDS_V=NSLOT*SLOTB, LDS_WS=2*NSLOT*SLOTB, LDS_OST=LDS_WS+NW*64*4, LDS_BYTES=LDS_OST+NW*4096;
constexpr float C2=0.125f*1.4426950408889634f;
__device__ __forceinline__ void glds16(const void*gsrc,unsigned lds_dst){unsigned keep;
  asm volatile("s_mov_b32 %0, m0\n\ts_mov_b32 m0, %2\n\ts_nop 0\n\tglobal_load_lds_dwordx4 %1, off\n\ts_mov_b32 m0, %0":"=&s"(keep):"v"(gsrc),"s"(lds_dst):"memory");}
__device__ __forceinline__ float max3f(float a,float b,float c){float r;asm("v_max3_f32 %0, %1, %2, %3":"=v"(r):"v"(a),"v"(b),"v"(c));return r;}
__device__ __forceinline__ float max2f(float a,float b){float r;asm("v_max_f32_e32 %0, %1, %2":"=v"(r):"v"(a),"v"(b));return r;}
__device__ __forceinline__ float fadd_s(float a,float b){float r;asm("v_add_f32_e32 %0, %1, %2":"=v"(r):"v"(a),"v"(b));return r;}
__device__ __forceinline__ float fsub_s(float a,float b){float r;asm("v_sub_f32_e32 %0, %1, %2":"=v"(r):"v"(a),"v"(b));return r;}
typedef float f32x2_t __attribute__((ext_vector_type(2))); typedef __bf16 bf16x2_t __attribute__((ext_vector_type(2)));
__device__ __forceinline__ unsigned cvtpk_s(float lo,float hi){f32x2_t v={lo,hi};bf16x2_t b=__builtin_convertvector(v,bf16x2_t);return __builtin_bit_cast(unsigned,b);}
#define WAIT_BAR(N) asm volatile("s_waitcnt vmcnt(" #N ") lgkmcnt(0)\n\ts_barrier":::"memory")

__device__ __forceinline__ void qkt(f32x16&p0,f32x16&p1,const char*Kslot,const bf16x8*qr,const f32x16&negm,int r32,int hi){
  const char*kb=Kslot+hi*1024+r32*16;
  #pragma unroll
  for(int d0=0;d0<4;++d0){
    const bf16x8 b0=*reinterpret_cast<const bf16x8*>(kb+d0*2048);
    const bf16x8 b1=*reinterpret_cast<const bf16x8*>(kb+d0*2048+512);
    if(d0==0){p0=__builtin_amdgcn_mfma_f32_32x32x16_bf16(b0,qr[0],negm,0,0,0);p1=__builtin_amdgcn_mfma_f32_32x32x16_bf16(b1,qr[0],negm,0,0,0);}
    else{p0=__builtin_amdgcn_mfma_f32_32x32x16_bf16(b0,qr[d0],p0,0,0,0);p1=__builtin_amdgcn_mfma_f32_32x32x16_bf16(b1,qr[d0],p1,0,0,0);}}
}
typedef __attribute__((address_space(3))) const char* lds_cptr;
typedef short v4i16_t __attribute__((ext_vector_type(4)));
__device__ __forceinline__ void kload8(bf16x8*kf,lds_cptr kp){
  kf[0]=*(const __attribute__((address_space(3))) bf16x8*)(kp);      kf[1]=*(const __attribute__((address_space(3))) bf16x8*)(kp+512);
  kf[2]=*(const __attribute__((address_space(3))) bf16x8*)(kp+2048); kf[3]=*(const __attribute__((address_space(3))) bf16x8*)(kp+2560);
  kf[4]=*(const __attribute__((address_space(3))) bf16x8*)(kp+4096); kf[5]=*(const __attribute__((address_space(3))) bf16x8*)(kp+4608);
  kf[6]=*(const __attribute__((address_space(3))) bf16x8*)(kp+6144); kf[7]=*(const __attribute__((address_space(3))) bf16x8*)(kp+6656);
}
__device__ __forceinline__ void kload2(bf16x8*kf,lds_cptr kp,int j){ kf[2*j]=*(const __attribute__((address_space(3))) bf16x8*)(kp+j*2048); kf[2*j+1]=*(const __attribute__((address_space(3))) bf16x8*)(kp+j*2048+512); }
__device__ __forceinline__ s16x4 vtr(lds_cptr p){ return __builtin_bit_cast(s16x4,__builtin_amdgcn_ds_read_tr16_b64_v4i16((__attribute__((address_space(3))) v4i16_t*)p)); }
__device__ __forceinline__ float rowmax(const f32x16&p0,const f32x16&p1){
  float a=max3f(p0[0],p0[1],p1[0]),b=max3f(p0[2],p0[3],p1[1]);a=max3f(a,p1[2],p1[3]);
  #pragma unroll
  for(int r=4;r<16;r+=4){a=max3f(a,p0[r],p0[r+1]);b=max3f(b,p0[r+2],p0[r+3]);a=max3f(a,p1[r],p1[r+1]);b=max3f(b,p1[r+2],p1[r+3]);}
  const float m=max2f(a,b);
  auto rr=__builtin_amdgcn_permlane32_swap(__float_as_uint(m),__float_as_uint(m),false,false);
  return max2f(__uint_as_float(rr[0]),__uint_as_float(rr[1]));
}
__device__ __forceinline__ void pv(f32x16*o,int vb,bf16x8 pa0,bf16x8 pa1,bf16x8 pa2,bf16x8 pa3){
  #pragma unroll
  for(int d0=0;d0<2;++d0){s16x4 lo[4],hi[4];
    #pragma unroll
    for(int ks=0;ks<4;++ks){
      asm volatile("ds_read_b64_tr_b16 %0,%1 offset:%c2":"=&v"(lo[ks]):"v"(vb),"i"(d0*4096+ks*1024):"memory");
      asm volatile("ds_read_b64_tr_b16 %0,%1 offset:%c2":"=&v"(hi[ks]):"v"(vb),"i"(d0*4096+ks*1024+512):"memory");}
    asm volatile("s_waitcnt lgkmcnt(0)":::"memory");SBAR();
    #define PK(k) (bf16x8){lo[k][0],lo[k][1],lo[k][2],lo[k][3],hi[k][0],hi[k][1],hi[k][2],hi[k][3]}
    o[d0]=__builtin_amdgcn_mfma_f32_32x32x16_bf16(pa0,PK(0),o[d0],0,0,0);
    o[d0]=__builtin_amdgcn_mfma_f32_32x32x16_bf16(pa1,PK(1),o[d0],0,0,0);
    o[d0]=__builtin_amdgcn_mfma_f32_32x32x16_bf16(pa2,PK(2),o[d0],0,0,0);
    o[d0]=__builtin_amdgcn_mfma_f32_32x32x16_bf16(pa3,PK(3),o[d0],0,0,0);
    #undef PK
  }
}

#ifndef ATTN_STORE16
#define ATTN_STORE16(p,v) (*(u32x4*)(p)=(v))
#endif
template<int THRL> __device__ __forceinline__ void attn_unit(int b,int h,int qb,const bf16*Q,const bf16*__restrict__ K,const bf16*__restrict__ V,bf16*O,const float*__restrict__ KM,char*shm,const int wave_){
  unsigned on_=~0u; asm volatile("":"+s"(on_)); int tid_=(int)__builtin_amdgcn_mbcnt_hi(on_,__builtin_amdgcn_mbcnt_lo(on_,0u))+64*wave_; asm volatile("":"+v"(tid_));
  const int tid=tid_,lane=tid&63,r32=lane&31,hi=lane>>5; const int wid=wave_;
  const long rowbase=(long)b*SEQ; const int q0=qb*QB;
  const bf16*Qw=Q+(rowbase+q0+wid*QBLK)*DM+h*D;
  const bf16*Kh=K+rowbase*DM+h*D,*Vh=V+rowbase*DM+h*D;
  const unsigned lds0=(unsigned)(uintptr_t)shm;
  float*wsf=(float*)(shm+LDS_WS)+wid*64;
  const bf16*ksrc=Kh+(long)lane*DM+wid*8;
  const bf16*vsrc=Vh+(long)(16*(wid&3)+(lane>>2))*DM+(wid>>2)*32+(lane&3)*8;
  const unsigned kdst=lds0+LDS_K+wid*1024, vdst=lds0+LDS_V+wid*1024;
  #define DMA_K(t,slot) glds16(ksrc+(long)(t)*KVBLK*DM,(unsigned)__builtin_amdgcn_readfirstlane(kdst+(slot)))
  #define DMA_V(t,slot) glds16(vsrc+(long)(t)*KVBLK*DM,(unsigned)__builtin_amdgcn_readfirstlane(vdst+(slot)))
  const int vb0=(int)(lds0+LDS_V)+((lane>>4)&1)*32+(lane&3)*8+(4*hi+((lane&15)>>2))*64;
  const char*Kbase=shm+LDS_K; bf16x8 kf[8];
  const lds_cptr shm3=(lds_cptr)shm; const lds_cptr kp0=shm3+LDS_K+hi*1024+r32*16; const lds_cptr vp0=shm3+LDS_V+((lane>>4)&1)*32+(lane&3)*8+(4*hi+((lane&15)>>2))*64;
  const int NT=(q0+QB)/KVBLK;
  DMA_K(0,0);DMA_V(0,0);DMA_K(1,SLOTB);
  bf16x8 qr[4];
  #pragma unroll
  for(int d0=0;d0<4;++d0)qr[d0]=*reinterpret_cast<const bf16x8*>(&Qw[(long)r32*DM+d0*16+hi*8]);
  unsigned sel=0u;
  if(qb>0){
    float g[15];
    const float*kmb=KM+(long)(b*NHEAD+h)*16*64+8*hi;
    #pragma unroll
    for(int kb=0;kb<15;++kb){ g[kb]=-INFINITY;
      if(kb<qb){ float sacc_=0.f;
        #pragma unroll
        for(int d0=0;d0<4;++d0){ const float4 ka=*reinterpret_cast<const float4*>(kmb+kb*64+16*d0),kc=*reinterpret_cast<const float4*>(kmb+kb*64+16*d0+4);
          sacc_+=__uint_as_float((unsigned)(unsigned short)qr[d0][0]<<16)*ka.x+__uint_as_float((unsigned)(unsigned short)qr[d0][1]<<16)*ka.y+__uint_as_float((unsigned)(unsigned short)qr[d0][2]<<16)*ka.z+__uint_as_float((unsigned)(unsigned short)qr[d0][3]<<16)*ka.w
                +__uint_as_float((unsigned)(unsigned short)qr[d0][4]<<16)*kc.x+__uint_as_float((unsigned)(unsigned short)qr[d0][5]<<16)*kc.y+__uint_as_float((unsigned)(unsigned short)qr[d0][6]<<16)*kc.z+__uint_as_float((unsigned)(unsigned short)qr[d0][7]<<16)*kc.w; }
        sacc_+=__builtin_bit_cast(float,__builtin_amdgcn_ds_bpermute((lane^32)<<2,__builtin_bit_cast(int,sacc_))); g[kb]=sacc_; } }
    #pragma unroll
    for(int pass=0;pass<3;++pass){ float bv=-INFINITY; int bi=-1;
      #pragma unroll
      for(int kb=0;kb<15;++kb){ if(kb<qb && !((sel>>kb)&1u) && g[kb]>bv){bv=g[kb];bi=kb;} }
      if(bi>=0)sel|=1u<<bi; }
  }
  float mhat=0.f,l_reg=0.f;f32x16 o[2];o[0]=f32x16{};o[1]=f32x16{};f32x16 negm=f32x16{};asm volatile("":"+v"(negm));
  const int qrel=wid*QBLK+r32;
  #define CMASK(P0,P1,t) do{int jb_=(t)-(NT-4); if(jb_>=0)cmask(P0,P1,jb_,qrel,hi); else bmask(P0,P1,(sel>>((t)>>2))&1u);}while(0)
  bool resc=false;
  #define START(P0,P1) do{ const float rm=rowmax(P0,P1); resc=false; \
    { const float dl=__builtin_fmaxf(rm,-20.f); mhat=fadd_s(mhat,dl); \
      _Pragma("unroll") for(int r=0;r<16;++r){P0[r]=fsub_s(P0[r],dl);P1[r]=fsub_s(P1[r],dl);} \
      _Pragma("unroll") for(int r=0;r<16;++r)negm[r]=-mhat; asm volatile("":"+v"(negm)); } \
    _Pragma("unroll") for(int r=0;r<16;++r)P0[r]=__builtin_amdgcn_exp2f(P0[r]); }while(0)
  #define RESC() do{ if(resc){ asm volatile("s_waitcnt lgkmcnt(0)":::"memory"); \
      _Pragma("unroll") for(int d_=0;d_<2;++d_) _Pragma("unroll") for(int r=0;r<16;++r)o[d_][r]*=wsf[crow(r,hi)]; } }while(0)
  f32x16 pA0,pA1,pB0,pB1;
  int sl_prev=0,sl_cur=0,sl_next=SLOTB;
  #define ROT() do{sl_prev=sl_cur;sl_cur=sl_next;sl_next=(sl_next==(NSLOT-1)*SLOTB)?0:sl_next+SLOTB;}while(0)
  DMA_K(2,2*SLOTB);
  WAIT_BAR(3);
  qkt(pA0,pA1,Kbase,qr,negm,r32,hi);asm volatile("s_nop 15\n\ts_nop 7":"+v"(pA0),"+v"(pA1));CMASK(pA0,pA1,0);
  START(pA0,pA1);
  _Pragma("unroll") for(int r=0;r<16;++r)pA1[r]=__builtin_amdgcn_exp2f(pA1[r]);
  WAIT_BAR(0);
  DMA_K(3,0);DMA_V(1,SLOTB);
  ROT();
  kload8(kf,kp0+sl_cur);
  WAIT_BAR(2);
  s16x4 vlo[8],vhi[8]; u32x4 pw0,pw1,pw2,pw3;
  #define PKW(P,B) cvtpk_s(P[B],P[B+1])
  #define PAF(k) __builtin_bit_cast(bf16x8,pw##k)
  #define VFR(i) (bf16x8){vlo[i][0],vlo[i][1],vlo[i][2],vlo[i][3],vhi[i][0],vhi[i][1],vhi[i][2],vhi[i][3]}
  #define PIN(x) asm volatile("":"+v"(x))
  #define MX3(a,b,c) __builtin_fmaxf(__builtin_fmaxf((a),(b)),(c))
  #define GAPA(MF,A0,A1,A2,A3,W0,W1,PW) do{ MF; sacc+=A0; sacc+=A1; sacc+=A2; sacc+=A3; PIN(sacc); W0; W1; PIN(PW); SBAR(); }while(0)
  #define EX(v) __builtin_amdgcn_exp2f(v)
  #define GAPB(MF,X,B) do{ MF; X[B]=EX(X[B]); X[B+1]=EX(X[B+1]); X[B+2]=EX(X[B+2]); X[B+3]=EX(X[B+3]); PIN(X); SBAR(); }while(0)
  #define VRD(i) do{ vlo[i]=vtr(vp_+(((i)>>2)*4096+((i)&3)*1024)); vhi[i]=vtr(vp_+(((i)>>2)*4096+((i)&3)*1024+512)); }while(0)
  #define KRD(G,j) do{ if(G){ kload2(kf,kp0+sl_next,j); SBAR(); } }while(0)
  #define STEP(C0,C1,P0,P1,t,GK,GV,GL) do{ SBAR(); \
    const lds_cptr vp_=vp0+sl_prev; \
    VRD(0); SBAR(); float sacc=(P0[0]+P0[1]); \
    GAPA(C0=__builtin_amdgcn_mfma_f32_32x32x16_bf16(kf[0],qr[0],negm,0,0,0), P0[2],P0[3],P0[4],P0[5],     pw0[0]=PKW(P0,0), pw0[1]=PKW(P0,2), pw0); \
    VRD(4); SBAR(); GAPA(C1=__builtin_amdgcn_mfma_f32_32x32x16_bf16(kf[1],qr[0],negm,0,0,0), P0[6],P0[7],P0[8],P0[9],     pw0[2]=PKW(P0,4), pw0[3]=PKW(P0,6), pw0); \
    VRD(1); SBAR(); GAPA(C0=__builtin_amdgcn_mfma_f32_32x32x16_bf16(kf[2],qr[1],C0,0,0,0),   P0[10],P0[11],P0[12],P0[13], pw1[0]=PKW(P0,8), pw1[1]=PKW(P0,10), pw1); \
    VRD(5); SBAR(); GAPA(C1=__builtin_amdgcn_mfma_f32_32x32x16_bf16(kf[3],qr[1],C1,0,0,0),   P0[14],P0[15],P1[0],P1[1],   pw1[2]=PKW(P0,12),pw1[3]=PKW(P0,14), pw1); \
    VRD(2); SBAR(); GAPA(C0=__builtin_amdgcn_mfma_f32_32x32x16_bf16(kf[4],qr[2],C0,0,0,0),   P1[2],P1[3],P1[4],P1[5],     pw2[0]=PKW(P1,0), pw2[1]=PKW(P1,2), pw2); \
    VRD(6); SBAR(); GAPA(C1=__builtin_amdgcn_mfma_f32_32x32x16_bf16(kf[5],qr[2],C1,0,0,0),   P1[6],P1[7],P1[8],P1[9],     pw2[2]=PKW(P1,4), pw2[3]=PKW(P1,6), pw2); \
    VRD(3); SBAR(); GAPA(C0=__builtin_amdgcn_mfma_f32_32x32x16_bf16(kf[6],qr[3],C0,0,0,0),   P1[10],P1[11],P1[12],P1[13], pw3[0]=PKW(P1,8), pw3[1]=PKW(P1,10), pw3); \
    VRD(7); SBAR(); GAPA(C1=__builtin_amdgcn_mfma_f32_32x32x16_bf16(kf[7],qr[3],C1,0,0,0),   P1[14],P1[15],0.f,0.f,       pw3[2]=PKW(P1,12),pw3[3]=PKW(P1,14), pw3); \
    l_reg+=sacc; \
    if(GK){DMA_K((t)+3,sl_cur);} if(GV){DMA_V((t)+1,sl_next);} \
    CMASK(C0,C1,t); \
    { float a=MX3(C0[0],C0[1],C1[0]),b=MX3(C0[2],C0[3],C1[1]); a=MX3(a,C1[2],C1[3]); \
      _Pragma("unroll") for(int r=4;r<16;r+=4){a=MX3(a,C0[r],C0[r+1]);b=MX3(b,C0[r+2],C0[r+3]);a=MX3(a,C1[r],C1[r+1]);b=MX3(b,C1[r+2],C1[r+3]);} \
      float rm=__builtin_fmaxf(a,b); { auto rr=__builtin_amdgcn_permlane32_swap(__float_as_uint(rm),__float_as_uint(rm),false,false); rm=__builtin_fmaxf(__uint_as_float(rr[0]),__uint_as_float(rr[1])); } \
      resc=false; \
      if(__builtin_expect(__any(rm>(float)THRL),0)){ const float dl=__builtin_fmaxf(rm,0.f); mhat+=dl; \
        _Pragma("unroll") for(int r=0;r<16;++r){C0[r]-=dl;C1[r]-=dl;} \
        _Pragma("unroll") for(int r=0;r<16;++r)negm[r]=-mhat; asm volatile("":"+v"(negm)); \
        const float f=__builtin_amdgcn_exp2f(-dl); l_reg*=f; if(hi==0)wsf[r32]=f; resc=true; } } \
    SBAR(); \
    GAPB(o[0]=__builtin_amdgcn_mfma_f32_32x32x16_bf16(PAF(0),VFR(0),o[0],0,0,0), C0,0); \
    GAPB(o[1]=__builtin_amdgcn_mfma_f32_32x32x16_bf16(PAF(0),VFR(4),o[1],0,0,0), C0,4); \
    KRD(GL,0); GAPB(o[0]=__builtin_amdgcn_mfma_f32_32x32x16_bf16(PAF(1),VFR(1),o[0],0,0,0), C0,8); \
    KRD(GL,1); GAPB(o[1]=__builtin_amdgcn_mfma_f32_32x32x16_bf16(PAF(1),VFR(5),o[1],0,0,0), C0,12); \
    KRD(GL,2); GAPB(o[0]=__builtin_amdgcn_mfma_f32_32x32x16_bf16(PAF(2),VFR(2),o[0],0,0,0), C1,0); \
    KRD(GL,3); GAPB(o[1]=__builtin_amdgcn_mfma_f32_32x32x16_bf16(PAF(2),VFR(6),o[1],0,0,0), C1,4); \
    GAPB(o[0]=__builtin_amdgcn_mfma_f32_32x32x16_bf16(PAF(3),VFR(3),o[0],0,0,0), C1,8); \
    GAPB(o[1]=__builtin_amdgcn_mfma_f32_32x32x16_bf16(PAF(3),VFR(7),o[1],0,0,0), C1,12); \
    }while(0)
  int t=1;
  #undef CMASK
  #define CMASK(P0,P1,t) bmask(P0,P1,(sel>>((t)>>2))&1u)
  for(;t+5<NT;t+=2){
    STEP(pB0,pB1,pA0,pA1,t,true,true,true);     WAIT_BAR(2); RESC(); ROT();
    STEP(pA0,pA1,pB0,pB1,t+1,true,true,true);   WAIT_BAR(2); RESC(); ROT();
  }
  #undef CMASK
  #define CMASK(P0,P1,t) do{int jb_=(t)-(NT-4); if(jb_>=0)cmask(P0,P1,jb_,qrel,hi); else bmask(P0,P1,(sel>>((t)>>2))&1u);}while(0)
  #define ENDW(tt) do{ if((tt)+3<NT){WAIT_BAR(2);} else if((tt)+2<NT){WAIT_BAR(1);} else {WAIT_BAR(0);} }while(0)
  for(;t+1<NT;t+=2){
    STEP(pB0,pB1,pA0,pA1,t,(t+3<NT),(t+1<NT),(t+1<NT));       ENDW(t);   RESC(); ROT();
    STEP(pA0,pA1,pB0,pB1,t+1,(t+4<NT),(t+2<NT),(t+2<NT));     ENDW(t+1); RESC(); ROT();
  }
  STEP(pB0,pB1,pA0,pA1,NT-1,false,false,false); RESC();
  { float sacc=pB0[0]+pB0[1]; _Pragma("unroll") for(int r=2;r<16;++r)sacc+=pB0[r]; _Pragma("unroll") for(int r=0;r<16;++r)sacc+=pB1[r]; l_reg+=sacc;
    pw0=(u32x4){PKW(pB0,0),PKW(pB0,2),PKW(pB0,4),PKW(pB0,6)};pw1=(u32x4){PKW(pB0,8),PKW(pB0,10),PKW(pB0,12),PKW(pB0,14)};pw2=(u32x4){PKW(pB1,0),PKW(pB1,2),PKW(pB1,4),PKW(pB1,6)};pw3=(u32x4){PKW(pB1,8),PKW(pB1,10),PKW(pB1,12),PKW(pB1,14)};
    SBAR(); pv(o,vb0+sl_cur,PAF(0),PAF(1),PAF(2),PAF(3)); }
  #undef PKW
  #undef PAF
  #undef VFR
  #undef PIN
  #undef MX3
  #undef GAPA
  #undef GAPB
  #undef EX
  #undef VRD
  #undef KRD
  #undef STEP
  #undef ENDW
  {auto rr=__builtin_amdgcn_permlane32_swap(__float_as_uint(l_reg),__float_as_uint(l_reg),false,false);l_reg=__uint_as_float(rr[0])+__uint_as_float(rr[1]);}
  if(hi==0)wsf[32+r32]=l_reg;asm volatile("s_waitcnt lgkmcnt(0)":::"memory");
  float rli[16];
  #pragma unroll
  for(int r=0;r<16;++r)rli[r]=__builtin_amdgcn_rcpf(wsf[32+crow(r,hi)]);
  bf16*Ow=O+(rowbase+q0+wid*QBLK)*DM+h*D;
  { bf16*stg=(bf16*)(shm+LDS_OST)+wid*2048;
    #pragma unroll
    for(int r=0;r<16;++r){const int orow=crow(r,hi);
      #pragma unroll
      for(int d0=0;d0<2;++d0)stg[orow*64+d0*32+r32]=__float2bfloat16(o[d0][r]*rli[r]);}
    asm volatile("s_waitcnt lgkmcnt(0)":::"memory");
    #pragma unroll
    for(int i=0;i<4;++i){const int row=i*8+(lane>>3),ch=lane&7; const u32x4 v=*(const u32x4*)(stg+row*64+ch*8); ATTN_STORE16(Ow+(long)row*DM+ch*8,v);} }
  asm volatile("s_waitcnt lgkmcnt(0)\n\ts_barrier":::"memory");
  #undef DMA_K
  #undef DMA_V
  #undef CMASK
  #undef START
  #undef RESC
  #undef ROT
}
constexpr int ATTN_LDS_BYTES=LDS_BYTES;
struct AttnTensors { const bf16* Q; const bf16* K; const bf16* V; bf16* O; const float* KM; };
struct AttnUnit { int bh; int qb; };
struct StaticOrder {
  int vcu,grid;
  __device__ __forceinline__ explicit StaticOrder(int grid_,int block):vcu((grid_%8==0)?(block%8)*(grid_/8)+block/8:block),grid(grid_){}
  __device__ __forceinline__ bool next(int i,AttnUnit&u)const{
    if(grid==256){ if(i>=4)return false; const int s=vcu&3; u.bh=vcu>>2; u.qb=(i==0)?s:(i==1)?7-s:(i==2)?8+s:15-s; return true; }
    const int L=vcu+i*grid; if(L>=BATCH*NHEAD*NQB)return false; u.bh=L/NQB; u.qb=L%NQB; return true; }
  __device__ __forceinline__ void a_ready(const AttnUnit&)const{}
  __device__ __forceinline__ void done(const AttnUnit&)const{}
};
template<class Sched,int THRL=8> __device__ __forceinline__ void attn_phase(char*lds,const AttnTensors&T,const Sched&S,const int wave_){
  AttnUnit u;
  for(int i=0;S.next(i,u);++i){ S.a_ready(u); attn_unit<THRL>(u.bh/NHEAD,u.bh%NHEAD,u.qb,T.Q,T.K,T.V,T.O,T.KM,lds,wave_); S.done(u); }
}
#undef SBAR
#undef WAIT_BAR
}

constexpr int NWAVES = 8;
constexpr int BATCH = 8, SEQ = 4096, D = 1024, M = BATCH * SEQ;
constexpr int NPROJ = 7680, FF = 3584, NEXP = 8;
constexpr int PW = pg8::PW;
constexpr int MAXSLOT = 2 * M + NEXP * 256;
constexpr float RMS_EPS = 1e-6f;

constexpr size_t MiB = 1u << 20;
constexpr size_t WS_CTL = 0, CTL_ZERO_BYTES = 1 * MiB;
constexpr size_t WS_TAB = 1 * MiB;
constexpr size_t WS_KMEAN = 2 * MiB;
constexpr size_t WS_TOKE = WS_KMEAN + 256 * 1024;
constexpr size_t WS_TOKIDX = WS_TOKE + 128 * 1024;
constexpr size_t WS_TOKP = WS_TOKIDX + 256 * 1024;
constexpr size_t WS_TOKOF = WS_TOKP + 128 * 1024;
constexpr size_t WS_PWOF = WS_TOKOF + (size_t)MAXSLOT * 4;
static_assert(WS_PWOF + (size_t)MAXSLOT * 4 <= 4 * MiB, "small tables");
constexpr size_t WS_WIN = 4 * MiB, WS_WBR = 19 * MiB, WS_WOUT = 22 * MiB;
constexpr size_t WS_H = 24 * MiB;
constexpr size_t WS_KVT = WS_H, WS_ST = WS_H + 32 * MiB;
constexpr size_t WS_W1 = 88 * MiB, WS_W2 = 102 * MiB;
constexpr size_t WS_P = 109 * MiB;
constexpr size_t WS_ACT = WS_P;
constexpr size_t WS_MW1 = 4 * MiB, WS_MW2 = 60 * MiB;
constexpr size_t WS_H8 = 88 * MiB;
constexpr size_t WS_XG = 120 * MiB;
constexpr size_t WS_ACTM = 186 * MiB;
constexpr size_t WS_Y = 417 * MiB;
constexpr size_t WS_END = 562 * MiB;
static_assert(WS_P + (size_t)M * PW * 2 <= WS_END && WS_Y + (size_t)2 * M * D * 2 <= WS_END && WS_ACTM + (size_t)MAXSLOT * FF <= WS_Y && WS_XG + (size_t)MAXSLOT * D <= WS_ACTM && WS_H8 + (size_t)M * D <= WS_XG
              && WS_MW2 + (size_t)NEXP * D * FF <= WS_H8 && WS_MW1 + (size_t)NEXP * 2 * FF * D <= WS_MW2, "d_ws map");
constexpr int CW_BAR = 4096;
constexpr int CW_CNT = 16384;

constexpr int RING_OFF = 0, RING_BYTES = 131072;
constexpr int LDSCTL_OFF = RING_BYTES, MISC_OFF = LDSCTL_OFF + 320;
constexpr int LDS_BYTES = 147456;

#define GAS __attribute__((address_space(1)))
#define LAS __attribute__((address_space(3)))
typedef unsigned short bf16;
typedef unsigned v4u __attribute__((ext_vector_type(4)));
typedef unsigned v2u __attribute__((ext_vector_type(2)));
typedef float f32x4 __attribute__((ext_vector_type(4)));
typedef short bf16x8 __attribute__((ext_vector_type(8)));
typedef short s16x4 __attribute__((ext_vector_type(4)));
typedef GAS unsigned gu32;
#define RLX_AGENT __ATOMIC_RELAXED, __HIP_MEMORY_SCOPE_AGENT
#define LDS_WAIT() asm volatile("s_waitcnt lgkmcnt(0)" ::: "memory")
__device__ __forceinline__ unsigned f2bf(float f) { unsigned u = __builtin_bit_cast(unsigned, f); return (u + 0x7fffu + ((u >> 16) & 1u)) >> 16; }
__device__ __forceinline__ unsigned pk2(float lo, float hi) { return f2bf(lo) | (f2bf(hi) << 16); }
__device__ __forceinline__ float bflo(unsigned w) { return __builtin_bit_cast(float, w << 16); }
__device__ __forceinline__ float bfhi(unsigned w) { return __builtin_bit_cast(float, w & 0xffff0000u); }

#define XB_TMO      128
#define XB_XCNT(j)  (256  + 64 * (j))
#define XB_XSUB(j)  (1280 + 64 * (j))
#define XB_XGEN(j)  (2304 + 64 * (j))
#define XB_TOP      3328
#define XB_TOPGEN   3392
#define XCD_BAR_WORDS 3456
#define XB_SPIN_CAP (1u << 18)
__device__ __forceinline__ unsigned xb_ld(unsigned* p)              { return __hip_atomic_load(p, __ATOMIC_RELAXED, __HIP_MEMORY_SCOPE_AGENT); }
__device__ __forceinline__ unsigned xb_add(unsigned* p, unsigned v) { return __hip_atomic_fetch_add(p, v, __ATOMIC_RELAXED, __HIP_MEMORY_SCOPE_AGENT); }
__device__ __forceinline__ unsigned xb_xcc_id() { return (unsigned)__builtin_amdgcn_s_getreg((3 << 11) | 20) & 0xFu; }
#define XB_SPIN(cond, bar) do { unsigned _sp = 0; while (cond) { __builtin_amdgcn_s_sleep(1); \
    if ((++_sp & 255u) == 0u) { if (xb_ld(&(bar)[XB_TMO])) break; if (_sp > XB_SPIN_CAP) { atomicAdd(&(bar)[XB_TMO], 1u); break; } } } } while (0)
struct XcdBarrier { unsigned* bar; unsigned x; volatile LAS unsigned* st; };
__device__ __forceinline__ XcdBarrier xcd_barrier_post(unsigned* bar, volatile LAS unsigned* st) {
    XcdBarrier b; b.bar = bar; b.x = xb_xcc_id(); b.st = st;
    if (threadIdx.x == 0) (void)xb_add(&bar[XB_XCNT(b.x)], 1u);
    return b;
}
__device__ __forceinline__ void xcd_barrier_complete(unsigned* bar, unsigned x, unsigned& nloc, unsigned& nx) {
    const unsigned G = gridDim.x * gridDim.y * gridDim.z;
    unsigned sum, cnt, mine, sp = 0u;
    for (;;) {
        sum = 0u; cnt = 0u; mine = 0u;
#pragma unroll
        for (unsigned j = 0; j < 16; ++j) { const unsigned c = xb_ld(&bar[XB_XCNT(j)]); sum += c; cnt += (c > 0u) ? 1u : 0u; mine = (j == x) ? c : mine; }
        if (sum == G) break;
        __builtin_amdgcn_s_sleep(1);
        if ((++sp & 255u) == 0u) { if (xb_ld(&bar[XB_TMO])) break; if (sp > XB_SPIN_CAP) { atomicAdd(&bar[XB_TMO], 1u); break; } }
    }
    nloc = mine > 0u ? mine : 1u; nx = cnt > 0u ? cnt : 1u;
}
__device__ __forceinline__ void xcd_barrier(const XcdBarrier& b) {
    asm volatile("s_waitcnt vmcnt(0)" ::: "memory");
    __syncthreads();
    if (threadIdx.x == 0) {
        unsigned* bar = b.bar;
        __builtin_amdgcn_s_waitcnt(0);
        unsigned nloc = b.st[0], nx = b.st[1];
        if (nloc == 0u) { xcd_barrier_complete(bar, b.x, nloc, nx); b.st[0] = nloc; b.st[1] = nx; }
        const unsigned old = xb_add(&bar[XB_XSUB(b.x)], 1u);
        const unsigned gen = old / nloc;
        if (old + 1u == (gen + 1u) * nloc) {
            __builtin_amdgcn_fence(__ATOMIC_RELEASE, "agent");
            asm volatile("s_waitcnt vmcnt(0)" ::: "memory");
            const unsigned og = xb_add(&bar[XB_TOP], 1u);
            const unsigned tg = og / nx;
            if (og + 1u == (tg + 1u) * nx) xb_add(&bar[XB_TOPGEN], 1u);
            else XB_SPIN(xb_ld(&bar[XB_TOPGEN]) == tg, bar);
            __builtin_amdgcn_fence(__ATOMIC_ACQUIRE, "agent");
            xb_add(&bar[XB_XGEN(b.x)], 1u);
            asm volatile("s_waitcnt vmcnt(0)" ::: "memory");
        } else {
            XB_SPIN(xb_ld(&bar[XB_XGEN(b.x)]) == gen, bar);
            __builtin_amdgcn_fence(__ATOMIC_ACQUIRE, "agent");
            asm volatile("s_waitcnt vmcnt(0)" ::: "memory");
        }
    }
    __syncthreads();
}

struct Frame {
    LAS unsigned char* lds;
    volatile LAS unsigned* MISC;
    gu32* ctl;
    int tid, lane, wave;
    int vcu, G;
    GAS unsigned char* ws;
};

__device__ __forceinline__ float shx(float v, int mask, int lane) { return __builtin_bit_cast(float, __builtin_amdgcn_ds_bpermute((lane ^ mask) << 2, __builtin_bit_cast(int, v))); }
__device__ __forceinline__ float wave_sum(float v, int lane) {
#pragma unroll
    for (int o = 1; o < 64; o <<= 1) v += shx(v, o, lane);
    return v;
}

__device__ __forceinline__ void transpose_item(const float* W, int K, int Nsrc, bf16* WT, int drow0, int scol0, int kb, LAS float* scr, int lane) {
    const int k0 = 64 * kb;
#pragma unroll 8
    for (int i = 0; i < 32; ++i) { const int kk = 2 * i + (lane >> 5); scr[kk * 33 + (lane & 31)] = W[(size_t)(k0 + kk) * Nsrc + scol0 + (lane & 31)]; }
    LDS_WAIT(); asm volatile("" ::: "memory");
    const int c = lane & 7;
#pragma unroll
    for (int j = 0; j < 4; ++j) { const int n = (lane >> 3) + 8 * j; const LAS float* s = scr + (8 * c) * 33 + n;
        v4u o; o.x = pk2(s[0 * 33], s[1 * 33]); o.y = pk2(s[2 * 33], s[3 * 33]); o.z = pk2(s[4 * 33], s[5 * 33]); o.w = pk2(s[6 * 33], s[7 * 33]);
        *(GAS v4u*)(WT + (size_t)(drow0 + n) * K + k0 + 8 * c) = o; }
    LDS_WAIT(); asm volatile("" ::: "memory");
}
__device__ __forceinline__ unsigned pk_fp8(float a, float b, float c, float d) { int w = __builtin_amdgcn_cvt_pk_fp8_f32(a, b, 0, false); w = __builtin_amdgcn_cvt_pk_fp8_f32(c, d, w, true); return (unsigned)w; }
__device__ __forceinline__ void transpose_item8(const float* W, int K, int Nsrc, unsigned char* WT, int drow0, int scol0, int kb, LAS float* scr, int lane, float scale) {
    const int k0 = 64 * kb;
#pragma unroll 8
    for (int i = 0; i < 32; ++i) { const int kk = 2 * i + (lane >> 5); scr[kk * 33 + (lane & 31)] = W[(size_t)(k0 + kk) * Nsrc + scol0 + (lane & 31)] * scale; }
    LDS_WAIT(); asm volatile("" ::: "memory");
    const int c = lane & 3;
#pragma unroll
    for (int j = 0; j < 2; ++j) { const int n = (lane >> 2) + 16 * j; const LAS float* s = scr + (16 * c) * 33 + n;
        v4u o; o.x = pk_fp8(s[0 * 33], s[1 * 33], s[2 * 33], s[3 * 33]); o.y = pk_fp8(s[4 * 33], s[5 * 33], s[6 * 33], s[7 * 33]);
        o.z = pk_fp8(s[8 * 33], s[9 * 33], s[10 * 33], s[11 * 33]); o.w = pk_fp8(s[12 * 33], s[13 * 33], s[14 * 33], s[15 * 33]);
        *(GAS v4u*)(WT + (size_t)(drow0 + n) * K + k0 + 16 * c) = o; }
    LDS_WAIT(); asm volatile("" ::: "memory");
}
template <int KIND, bool FP8 = false>
__device__ __forceinline__ void convert_matrix(Frame& F, const float* W, const float* W2, int K, int Nsrc, void* WT, int ndb) {
    LAS float* scr = (LAS float*)(F.lds + RING_OFF + F.wave * 16384);
    const int gw = F.vcu * NWAVES + F.wave, NGW = F.G * NWAVES, nitems = (K / 64) * ndb;
    for (int it = gw; it < nitems; it += NGW) {
        const int kb = it / ndb, db = it % ndb; const float* src = W; int scol;
        if (KIND == 0) scol = 32 * db;
        else if (KIND == 1) { const int pn = db >> 3, blk = db & 7, bj = blk >> 2, wc = blk & 3;
            if (pn < 4 || pn == 12 || pn == 13) scol = 256 * pn + 64 * wc + 32 * bj;
            else if (pn >= 8 && pn < 12) scol = (bj ? 2560 : 2048) + 128 * (pn - 8) + 32 * wc;
            else scol = 32 * db; }
        else { const int t = db >> 3, blk = db & 7, bj = blk >> 2, wc = blk & 3; src = bj ? W2 : W; scol = 128 * t + 32 * wc; }
        if (FP8) transpose_item8(src, K, Nsrc, (unsigned char*)WT, 32 * db, scol, kb, scr, F.lane, 32.0f);
        else transpose_item(src, K, Nsrc, (bf16*)WT, 32 * db, scol, kb, scr, F.lane);
    }
}
__device__ __forceinline__ const float* arg_in(int i) {
    int off = i * 8; asm volatile("" : "+s"(off));
    const char __attribute__((address_space(4)))* ka = (const char __attribute__((address_space(4)))*)__builtin_amdgcn_kernarg_segment_ptr();
    return (const float*)(const GAS float*)*(const float* const __attribute__((address_space(4)))*)(ka + off);
}
__device__ __forceinline__ void convert_mixer_weights(Frame& F, int layer) {
    convert_matrix<1>(F, arg_in(2) + (size_t)layer * D * NPROJ, nullptr, D, NPROJ, (bf16*)(F.ws + WS_WIN), NPROJ / 32);
    convert_matrix<0>(F, arg_in(6) + (size_t)layer * 512 * D, nullptr, 512, D, (bf16*)(F.ws + WS_WBR), D / 32);
    convert_matrix<0>(F, arg_in(7) + (size_t)layer * 512 * D, nullptr, 512, D, (bf16*)(F.ws + WS_WBR) + (size_t)D * 512, D / 32);
    convert_matrix<0>(F, arg_in(8) + (size_t)layer * 512 * D, nullptr, 512, D, (bf16*)(F.ws + WS_WBR) + (size_t)2 * D * 512, D / 32);
    convert_matrix<0>(F, arg_in(9) + (size_t)layer * D * D, nullptr, D, D, (bf16*)(F.ws + WS_WOUT), D / 32);
}

__constant__ float c_inv_freq[32] = {1.000000000e+00f, 7.498942018e-01f, 5.623413324e-01f, 4.216965139e-01f, 3.162277639e-01f, 2.371373922e-01f, 1.778279394e-01f, 1.333521456e-01f,
    1.000000015e-01f, 7.498941571e-02f, 5.623412877e-02f, 4.216964915e-02f, 3.162277862e-02f, 2.371373586e-02f, 1.778279431e-02f, 1.333521493e-02f,
    9.999999776e-03f, 7.498942316e-03f, 5.623413250e-03f, 4.216964822e-03f, 3.162277862e-03f, 2.371373819e-03f, 1.778279431e-03f, 1.333521446e-03f,
    1.000000047e-03f, 7.498941850e-04f, 5.623413017e-04f, 4.216965463e-04f, 3.162277862e-04f, 2.371373848e-04f, 1.778279402e-04f, 1.333521504e-04f};
__device__ __forceinline__ void rope_table(Frame& F) {
    float* cs = (float*)(F.ws + WS_TAB);
    for (int idx = F.vcu * 512 + F.tid; idx < 4096 * 32; idx += F.G * 512) {
        const int pos = idx >> 5, i = idx & 31;
        const float ang = (float)pos * c_inv_freq[i];
        const double rev = (double)ang * 0.15915494309189535; const double fr = rev - __builtin_rint(rev);
        const float f = (float)fr;
        cs[pos * 64 + i] = __builtin_amdgcn_cosf(f); cs[pos * 64 + 32 + i] = __builtin_amdgcn_sinf(f);
    }
}

__device__ __forceinline__ void norm_rows(Frame& F, const float* x, const float* gain, bf16* out) {
    const int gw = F.vcu * NWAVES + F.wave, NGW = F.G * NWAVES;
    f32x4 gv[4];
#pragma unroll
    for (int j = 0; j < 4; ++j) gv[j] = *((const f32x4*)gain + F.lane + 64 * j);
    for (int m = gw; m < M; m += NGW) {
        const GAS f32x4* xr = (const GAS f32x4*)(x + (size_t)m * D) + F.lane;
        f32x4 v[4]; float s = 0.f;
#pragma unroll
        for (int j = 0; j < 4; ++j) { v[j] = xr[64 * j]; s += (v[j].x * v[j].x + v[j].y * v[j].y) + (v[j].z * v[j].z + v[j].w * v[j].w); }
        const float r = 1.0f / sqrtf(wave_sum(s, F.lane) * (1.f / D) + RMS_EPS);
        GAS v2u* o8 = (GAS v2u*)(out + (size_t)m * D) + F.lane;
#pragma unroll
        for (int j = 0; j < 4; ++j) { v2u w; w.x = pk2(v[j].x * r * gv[j].x, v[j].y * r * gv[j].y); w.y = pk2(v[j].z * r * gv[j].z, v[j].w * r * gv[j].w); o8[64 * j] = w; }
    }
}
__device__ __forceinline__ void final_norm(Frame& F, float* x, const float* gain, const bf16* Y) {
    const int gw = F.vcu * NWAVES + F.wave, NGW = F.G * NWAVES;
    f32x4 gv[4];
#pragma unroll
    for (int j = 0; j < 4; ++j) gv[j] = *((const f32x4*)gain + F.lane + 64 * j);
    for (int m = gw; m < M; m += NGW) {
        GAS f32x4* xr = (GAS f32x4*)(x + (size_t)m * D) + F.lane;
        f32x4 v[4]; float s = 0.f;
#pragma unroll
        for (int j = 0; j < 4; ++j) { v[j] = xr[64 * j];
            const v2u y0 = *((const GAS v2u*)(Y + (size_t)m * D) + F.lane + 64 * j), y1 = *((const GAS v2u*)(Y + (size_t)(M + m) * D) + F.lane + 64 * j);
            v[j].x += bflo(y0.x) + bflo(y1.x); v[j].y += bfhi(y0.x) + bfhi(y1.x); v[j].z += bflo(y0.y) + bflo(y1.y); v[j].w += bfhi(y0.y) + bfhi(y1.y);
            s += (v[j].x * v[j].x + v[j].y * v[j].y) + (v[j].z * v[j].z + v[j].w * v[j].w); }
        const float r = 1.0f / sqrtf(wave_sum(s, F.lane) * (1.f / D) + RMS_EPS);
#pragma unroll
        for (int j = 0; j < 4; ++j) xr[64 * j] = v[j] * r * gv[j];
    }
}

__device__ __forceinline__ void kmean_phase(Frame& F, const bf16* P) {
    const int gw = F.vcu * NWAVES + F.wave, NGW = F.G * NWAVES;
    float* KM = (float*)(F.ws + WS_KMEAN);
    for (int it = gw; it < 64 * 16; it += NGW) {
        const int bh = it >> 4, blk = it & 15, b = bh >> 3, h = bh & 7;
        const bf16* base = P + (size_t)(b * SEQ + blk * 256 + (F.lane >> 3)) * PW + pg8::PC_K + h * 64 + (F.lane & 7) * 8;
        float a[8];
#pragma unroll
        for (int j = 0; j < 8; ++j) a[j] = 0.f;
#pragma unroll 4
        for (int i = 0; i < 32; ++i) { const v4u w = *(const GAS v4u*)(base + (size_t)i * 8 * PW);
            a[0] += bflo(w.x); a[1] += bfhi(w.x); a[2] += bflo(w.y); a[3] += bfhi(w.y); a[4] += bflo(w.z); a[5] += bfhi(w.z); a[6] += bflo(w.w); a[7] += bfhi(w.w); }
#pragma unroll
        for (int j = 0; j < 8; ++j) { a[j] += shx(a[j], 8, F.lane); a[j] += shx(a[j], 16, F.lane); a[j] += shx(a[j], 32, F.lane); }
        if (F.lane < 8) { float* o = KM + (size_t)it * 64 + F.lane * 8;
#pragma unroll
            for (int j = 0; j < 8; ++j) o[j] = a[j] * (1.f / 256.f); }
    }
}

__device__ __forceinline__ void conv_phase(Frame& F, bf16* P, const float* cw, const float* cbias) {
    const int gw = F.vcu * NWAVES + F.wave, NGW = F.G * NWAVES, c0 = F.lane * 8;
    float w0[8], w1[8], w2[8], bb[8];
#pragma unroll
    for (int j = 0; j < 8; ++j) { w0[j] = cw[c0 + j]; w1[j] = cw[512 + c0 + j]; w2[j] = cw[1024 + c0 + j]; bb[j] = cbias[c0 + j]; }
    for (int m = gw; m < M; m += NGW) {
        const int t = m & (SEQ - 1);
        bf16* rp = P + (size_t)m * PW;
        const v4u cb = *(const GAS v4u*)(rp + pg8::PC_CB + c0);
        const v4u u2 = *(const GAS v4u*)(rp + pg8::PC_U + c0);
        v4u u1 = (v4u){0u, 0u, 0u, 0u}, u0 = (v4u){0u, 0u, 0u, 0u};
        if (t >= 1) u1 = *(const GAS v4u*)(rp - PW + pg8::PC_U + c0);
        if (t >= 2) u0 = *(const GAS v4u*)(rp - 2 * PW + pg8::PC_U + c0);
        float y[8];
        const unsigned cbw[4] = {cb.x, cb.y, cb.z, cb.w}, a2[4] = {u2.x, u2.y, u2.z, u2.w}, a1[4] = {u1.x, u1.y, u1.z, u1.w}, a0[4] = {u0.x, u0.y, u0.z, u0.w};
#pragma unroll
        for (int q = 0; q < 4; ++q) {
            y[2 * q] = bflo(cbw[q]) * (w0[2 * q] * bflo(a0[q]) + w1[2 * q] * bflo(a1[q]) + w2[2 * q] * bflo(a2[q]) + bb[2 * q]);
            y[2 * q + 1] = bfhi(cbw[q]) * (w0[2 * q + 1] * bfhi(a0[q]) + w1[2 * q + 1] * bfhi(a1[q]) + w2[2 * q + 1] * bfhi(a2[q]) + bb[2 * q + 1]); }
        v4u o; o.x = pk2(y[0], y[1]); o.y = pk2(y[2], y[3]); o.z = pk2(y[4], y[5]); o.w = pk2(y[6], y[7]);
        *(GAS v4u*)(rp + pg8::PC_CB + c0) = o;
    }
}

__device__ __forceinline__ float ret_lg2(int h) { return h == 0 ? -0.04580368961312479f : (h == 1 ? -0.02272007650008353f : (h == 2 ? -0.011315313227834146f : -0.005646563141142063f)); }
constexpr int RT_QS = 0, RT_KS = 18432, RT_VT = 36864, RT_KZT = 36864 + 34816;
__device__ __forceinline__ void ret_kv_phase(Frame& F, const bf16* P) {
    LAS bf16* vT = (LAS bf16*)(F.lds + RT_VT); LAS bf16* kzT = (LAS bf16*)(F.lds + RT_KZT);
    float* KVt = (float*)(F.ws + WS_KVT);
    const int fr = F.lane & 15, quad = F.lane >> 4;
    for (int unit = F.vcu; unit < 32 * 32; unit += F.G) {
        const int bh = unit >> 5, ch = unit & 31, b = bh >> 2, h = bh & 3; const size_t row0 = (size_t)b * SEQ + ch * 128; const float lg = ret_lg2(h);
#pragma unroll
        for (int i = 0; i < 4; ++i) { const int p = F.tid + 512 * i, mrow = p & 127, c = p >> 7;
            const v4u w = *(const GAS v4u*)(P + (row0 + mrow) * PW + pg8::PC_RV + h * 128 + c * 8); const unsigned ww[4] = {w.x, w.y, w.z, w.w};
#pragma unroll
            for (int q = 0; q < 4; ++q) { vT[(c * 8 + 2 * q) * 136 + mrow] = (bf16)(ww[q] & 0xffffu); vT[(c * 8 + 2 * q + 1) * 136 + mrow] = (bf16)(ww[q] >> 16); } }
#pragma unroll
        for (int i = 0; i < 2; ++i) { const int p = F.tid + 512 * i, mrow = p & 127, c = p >> 7;
            const v4u w = *(const GAS v4u*)(P + (row0 + mrow) * PW + pg8::PC_RK + h * 64 + c * 8); const unsigned ww[4] = {w.x, w.y, w.z, w.w};
            const float zeta = __builtin_amdgcn_exp2f((float)(127 - mrow) * lg);
#pragma unroll
            for (int q = 0; q < 4; ++q) { kzT[(c * 8 + 2 * q) * 136 + mrow] = (bf16)f2bf(bflo(ww[q]) * zeta); kzT[(c * 8 + 2 * q + 1) * 136 + mrow] = (bf16)f2bf(bfhi(ww[q]) * zeta); } }
        __syncthreads();
        f32x4 acc[4];
#pragma unroll
        for (int dt = 0; dt < 4; ++dt) acc[dt] = (f32x4){0.f, 0.f, 0.f, 0.f};
#pragma unroll
        for (int ks = 0; ks < 4; ++ks) {
            const bf16x8 a = *(const LAS bf16x8*)(vT + (16 * F.wave + fr) * 136 + 32 * ks + 8 * quad);
#pragma unroll
            for (int dt = 0; dt < 4; ++dt) { const bf16x8 bb = *(const LAS bf16x8*)(kzT + (16 * dt + fr) * 136 + 32 * ks + 8 * quad);
                acc[dt] = __builtin_amdgcn_mfma_f32_16x16x32_bf16(a, bb, acc[dt], 0, 0, 0); } }
        float* o = KVt + (size_t)unit * 8192;
#pragma unroll
        for (int dt = 0; dt < 4; ++dt)
#pragma unroll
            for (int r = 0; r < 4; ++r) o[(16 * F.wave + 4 * quad + r) * 64 + 16 * dt + fr] = acc[dt][r];
        __syncthreads();
    }
}
__device__ __forceinline__ void ret_scan_phase(Frame& F) {
    const float* KVt = (const float*)(F.ws + WS_KVT); bf16* ST = (bf16*)(F.ws + WS_ST);
    for (int idx = F.vcu * 512 + F.tid; idx < 32 * 2048; idx += F.G * 512) {
        const int bh = idx >> 11, e4 = idx & 2047, h = bh & 3; const float cd = __builtin_amdgcn_exp2f(128.f * ret_lg2(h));
        f32x4 s = (f32x4){0.f, 0.f, 0.f, 0.f};
        const GAS f32x4* kp = (const GAS f32x4*)(KVt + (size_t)bh * 32 * 8192) + e4; GAS v2u* sp = (GAS v2u*)(ST + (size_t)bh * 32 * 8192) + e4;
#pragma unroll 8
        for (int c = 0; c < 32; ++c) { v2u w; w.x = pk2(s.x, s.y); w.y = pk2(s.z, s.w); sp[(size_t)c * 2048] = w; const f32x4 kv = kp[(size_t)c * 2048]; s = s * cd + kv; }
    }
}
__device__ __forceinline__ void ret_out_phase(Frame& F, bf16* P, const float* retw) {
    LAS bf16* qs = (LAS bf16*)(F.lds + RT_QS); LAS bf16* ks_ = (LAS bf16*)(F.lds + RT_KS); LAS bf16* vT = (LAS bf16*)(F.lds + RT_VT);
    const bf16* ST = (const bf16*)(F.ws + WS_ST);
    const int fr = F.lane & 15, quad = F.lane >> 4, w = F.wave;
    for (int unit = F.vcu; unit < 32 * 32; unit += F.G) {
        const int bh = unit >> 5, ch = unit & 31, b = bh >> 2, h = bh & 3; const size_t row0 = (size_t)b * SEQ + ch * 128; const float lg = ret_lg2(h);
#pragma unroll
        for (int i = 0; i < 2; ++i) { const int p = F.tid + 512 * i, r = p >> 3, c = p & 7;
            *(LAS v4u*)(qs + r * 72 + c * 8) = *(const GAS v4u*)(P + (row0 + r) * PW + pg8::PC_RQ + h * 64 + c * 8);
            *(LAS v4u*)(ks_ + r * 72 + c * 8) = *(const GAS v4u*)(P + (row0 + r) * PW + pg8::PC_RK + h * 64 + c * 8); }
#pragma unroll
        for (int i = 0; i < 4; ++i) { const int p = F.tid + 512 * i, mrow = p & 127, c = p >> 7;
            const v4u wv = *(const GAS v4u*)(P + (row0 + mrow) * PW + pg8::PC_RV + h * 128 + c * 8); const unsigned ww[4] = {wv.x, wv.y, wv.z, wv.w};
#pragma unroll
            for (int q = 0; q < 4; ++q) { vT[(c * 8 + 2 * q) * 136 + mrow] = (bf16)(ww[q] & 0xffffu); vT[(c * 8 + 2 * q + 1) * 136 + mrow] = (bf16)(ww[q] >> 16); } }
        __syncthreads();
        bf16x8 qf[2];
#pragma unroll
        for (int k = 0; k < 2; ++k) qf[k] = *(const LAS bf16x8*)(qs + (16 * w + fr) * 72 + 32 * k + 8 * quad);
        f32x4 sT[8];
#pragma unroll
        for (int mt = 0; mt < 8; ++mt) { sT[mt] = (f32x4){0.f, 0.f, 0.f, 0.f};
            if (mt <= w) {
#pragma unroll
                for (int k = 0; k < 2; ++k) { const bf16x8 a = *(const LAS bf16x8*)(ks_ + (16 * mt + fr) * 72 + 32 * k + 8 * quad); sT[mt] = __builtin_amdgcn_mfma_f32_16x16x32_bf16(a, qf[k], sT[mt], 0, 0, 0); }
#pragma unroll
                for (int r = 0; r < 4; ++r) { const int dd = (16 * w + fr) - (16 * mt + 4 * quad + r); sT[mt][r] = (dd >= 0) ? sT[mt][r] * __builtin_amdgcn_exp2f((float)dd * lg) : 0.f; } } }
        f32x4 acc1[8], acc2[8];
#pragma unroll
        for (int et = 0; et < 8; ++et) { acc1[et] = (f32x4){0.f, 0.f, 0.f, 0.f}; acc2[et] = (f32x4){0.f, 0.f, 0.f, 0.f}; }
#pragma unroll
        for (int s = 0; s < 4; ++s) {
            if (2 * s <= w) {
                v4u pbw; pbw.x = pg8::cvt_pk_bf16(sT[2 * s][0], sT[2 * s][1]); pbw.y = pg8::cvt_pk_bf16(sT[2 * s][2], sT[2 * s][3]); pbw.z = pg8::cvt_pk_bf16(sT[2 * s + 1][0], sT[2 * s + 1][1]); pbw.w = pg8::cvt_pk_bf16(sT[2 * s + 1][2], sT[2 * s + 1][3]);
                const bf16x8 pb = __builtin_bit_cast(bf16x8, pbw);
#pragma unroll
                for (int et = 0; et < 8; ++et) { const LAS bf16* vp = vT + (16 * et + fr) * 136 + 32 * s + 4 * quad;
                    const s16x4 lo = *(const LAS s16x4*)vp, hi = *(const LAS s16x4*)(vp + 16);
                    const bf16x8 a = (bf16x8){lo[0], lo[1], lo[2], lo[3], hi[0], hi[1], hi[2], hi[3]};
                    acc1[et] = __builtin_amdgcn_mfma_f32_16x16x32_bf16(a, pb, acc1[et], 0, 0, 0); } } }
        const bf16* st = ST + (size_t)unit * 8192;
#pragma unroll
        for (int et = 0; et < 8; ++et)
#pragma unroll
            for (int k = 0; k < 2; ++k) { const bf16x8 a = *(const GAS bf16x8*)(st + (16 * et + fr) * 64 + 32 * k + 8 * quad); acc2[et] = __builtin_amdgcn_mfma_f32_16x16x32_bf16(a, qf[k], acc2[et], 0, 0, 0); }
        const int n = 16 * w + fr; const float xi = __builtin_amdgcn_exp2f((float)(n + 1) * lg);
        float ss = 0.f;
#pragma unroll
        for (int et = 0; et < 8; ++et) { acc1[et] = acc1[et] + acc2[et] * xi; ss += (acc1[et][0] * acc1[et][0] + acc1[et][1] * acc1[et][1]) + (acc1[et][2] * acc1[et][2] + acc1[et][3] * acc1[et][3]); }
        ss += shx(ss, 16, F.lane); ss += shx(ss, 32, F.lane);
        const float rinv = 1.0f / sqrtf(ss * (1.f / 128.f) + RMS_EPS);
        bf16* yrow = P + (row0 + n) * PW + pg8::PC_RG + h * 128 + 4 * quad;
#pragma unroll
        for (int et = 0; et < 8; ++et) { const f32x4 wv = *(const f32x4*)(retw + h * 128 + 16 * et + 4 * quad); const v2u g = *(const GAS v2u*)(yrow + 16 * et);
            v2u o; o.x = pk2(acc1[et][0] * rinv * wv[0] * bflo(g.x), acc1[et][1] * rinv * wv[1] * bfhi(g.x)); o.y = pk2(acc1[et][2] * rinv * wv[2] * bflo(g.y), acc1[et][3] * rinv * wv[3] * bfhi(g.y));
            *(GAS v2u*)(yrow + 16 * et) = o; }
        __syncthreads();
    }
}

__device__ __forceinline__ void router_flush(Frame& F, int nrows, int mfirst, int NGW, unsigned my_e, float my_p) {
    unsigned* tokE = (unsigned*)(F.ws + WS_TOKE); unsigned* tokIdx = (unsigned*)(F.ws + WS_TOKIDX); float* tokP = (float*)(F.ws + WS_TOKP);
    const bool valid = F.lane < nrows; unsigned idx0 = 0u, idx1 = 0u;
    const unsigned long long lt = (1ull << F.lane) - 1ull;
#pragma unroll
    for (int k = 0; k < 2; ++k)
#pragma unroll
        for (int e = 0; e < NEXP; ++e) {
            const bool mine = valid && (((my_e >> (8 * k)) & 0xffu) == (unsigned)e);
            const unsigned long long mask = __ballot(mine);
            if (mask != 0ull) {
                unsigned base = 0u;
                if (F.lane == 0) base = __hip_atomic_fetch_add((unsigned*)(F.ctl + CW_CNT + 64 * (8 * k + e)), (unsigned)__popcll(mask), RLX_AGENT);
                base = (unsigned)__builtin_amdgcn_readfirstlane((int)base);
                if (mine) { const unsigned v = base + (unsigned)__popcll(mask & lt); if (k == 0) idx0 = v; else idx1 = v; }
            }
        }
    if (valid) { const int m = mfirst + F.lane * NGW; tokE[m] = my_e; tokIdx[2 * m] = idx0; tokIdx[2 * m + 1] = idx1; tokP[m] = my_p; }
}
__device__ __forceinline__ void norm_router_rows(Frame& F, const float* x, const float* gain, const float* wr, unsigned char* out) {
    const int gw = F.vcu * NWAVES + F.wave, NGW = F.G * NWAVES;
    f32x4 gv[4];
#pragma unroll
    for (int j = 0; j < 4; ++j) gv[j] = *((const f32x4*)gain + F.lane + 64 * j);
    unsigned my_e = 0u; float my_p = 0.f; int nb = 0, mfirst = gw;
    for (int m = gw; m < M; m += NGW) {
        const GAS f32x4* xr = (const GAS f32x4*)(x + (size_t)m * D) + F.lane;
        f32x4 v[4]; float s = 0.f;
#pragma unroll
        for (int j = 0; j < 4; ++j) { v[j] = xr[64 * j]; s += (v[j].x * v[j].x + v[j].y * v[j].y) + (v[j].z * v[j].z + v[j].w * v[j].w); }
        const float r = 1.0f / sqrtf(wave_sum(s, F.lane) * (1.f / D) + RMS_EPS);
        GAS unsigned* o8 = (GAS unsigned*)(out + (size_t)m * D) + F.lane;
        float lg[NEXP];
#pragma unroll
        for (int e = 0; e < NEXP; ++e) lg[e] = 0.f;
#pragma unroll
        for (int j = 0; j < 4; ++j) { v[j] = v[j] * r * gv[j];
            o8[64 * j] = pk_fp8(v[j].x, v[j].y, v[j].z, v[j].w);
            const f32x4* wp = (const f32x4*)(wr + (size_t)(4 * F.lane + 256 * j) * NEXP);
#pragma unroll
            for (int c = 0; c < 4; ++c) { const f32x4 wa = wp[2 * c], wb = wp[2 * c + 1]; const float hv = v[j][c];
                lg[0] += hv * wa[0]; lg[1] += hv * wa[1]; lg[2] += hv * wa[2]; lg[3] += hv * wa[3]; lg[4] += hv * wb[0]; lg[5] += hv * wb[1]; lg[6] += hv * wb[2]; lg[7] += hv * wb[3]; } }
#pragma unroll
        for (int e = 0; e < NEXP; ++e) lg[e] = wave_sum(lg[e], F.lane);
        int e0 = 0; float v0 = lg[0];
#pragma unroll
        for (int e = 1; e < NEXP; ++e) if (lg[e] > v0) { v0 = lg[e]; e0 = e; }
        int e1 = -1; float v1 = -INFINITY;
#pragma unroll
        for (int e = 0; e < NEXP; ++e) if (e != e0 && lg[e] > v1) { v1 = lg[e]; e1 = e; }
        const float p0 = 1.0f / (1.0f + __expf(v1 - v0));
        if (F.lane == nb) { my_e = (unsigned)e0 | ((unsigned)e1 << 8); my_p = p0; }
        if (++nb == 64) { router_flush(F, nb, mfirst, NGW, my_e, my_p); nb = 0; mfirst = m + NGW; }
    }
    if (nb > 0) router_flush(F, nb, mfirst, NGW, my_e, my_p);
}
__device__ __forceinline__ void moe_tables(Frame& F, LAS int* tb) {
    if (F.tid == 0) { int t = 0;
        for (int e = 0; e < NEXP; ++e) { tb[e] = t; const unsigned c0 = __hip_atomic_load((unsigned*)(F.ctl + CW_CNT + 64 * e), RLX_AGENT), c1 = __hip_atomic_load((unsigned*)(F.ctl + CW_CNT + 64 * (8 + e)), RLX_AGENT);
            tb[16 + e] = (int)c0; t += (int)((c0 + c1 + 255u) >> 8); }
        if (t > MAXSLOT / 256) t = MAXSLOT / 256;
        tb[8] = t; }
    __syncthreads();
}
__device__ __forceinline__ void moe_gather(Frame& F, const LAS int* tb) {
    const int gw = F.vcu * NWAVES + F.wave, NGW = F.G * NWAVES;
    const unsigned* tokE = (const unsigned*)(F.ws + WS_TOKE); const unsigned* tokIdx = (const unsigned*)(F.ws + WS_TOKIDX); const float* tokP = (const float*)(F.ws + WS_TOKP);
    int* tokof = (int*)(F.ws + WS_TOKOF); float* pwof = (float*)(F.ws + WS_PWOF);
    const unsigned char* H8 = (const unsigned char*)(F.ws + WS_H8); unsigned char* XG = (unsigned char*)(F.ws + WS_XG);
    for (int m = gw; m < M; m += NGW) {
        const unsigned ee = tokE[m]; const int e0 = ee & 0xff, e1 = (ee >> 8) & 0xff; const float p0 = tokP[m];
        const int s0 = tb[e0] * 256 + (int)tokIdx[2 * m], s1 = tb[e1] * 256 + tb[16 + e1] + (int)tokIdx[2 * m + 1];
        if (F.lane == 0) { tokof[s0] = m; pwof[s0] = p0; tokof[s1] = m | (1 << 30); pwof[s1] = 1.0f - p0; }
        const v4u a = *((const GAS v4u*)(H8 + (size_t)m * D) + F.lane);
        *((GAS v4u*)(XG + (size_t)s0 * D) + F.lane) = a; *((GAS v4u*)(XG + (size_t)s1 * D) + F.lane) = a;
    }
}

#ifndef PROBE_SITE
#define PROBE_SITE -1
#endif
constexpr int N_PHASES = 22;
struct Args { const float* in[19]; float* out; unsigned char* ws; int ph_lo, ph_hi; };
__global__ void __launch_bounds__(NWAVES * 64, 2) fwd_kernel(Args args) {
    extern __shared__ __attribute__((aligned(16))) unsigned char lds[];
    Frame F;
    F.lds = (LAS unsigned char*)lds;
    F.MISC = (volatile LAS unsigned*)(F.lds + MISC_OFF);
    F.tid = threadIdx.x; F.lane = F.tid & 63; F.wave = __builtin_amdgcn_readfirstlane(F.tid >> 6);
    F.G = gridDim.x; { const int bx = blockIdx.x; F.vcu = (F.G % 8 == 0) ? (bx % 8) * (F.G / 8) + bx / 8 : bx; }
    F.ws = (GAS unsigned char*)args.ws; F.ctl = (gu32*)(F.ws + WS_CTL);
    for (int u = F.tid; u < (LDS_BYTES - LDSCTL_OFF) / 4; u += NWAVES * 64) ((LAS unsigned*)(F.lds + LDSCTL_OFF))[u] = 0u;
    __syncthreads();
    XcdBarrier bar; bar.bar = (unsigned*)(F.ctl + CW_BAR); bar.x = 0; bar.st = nullptr;
    if (!MK_SPLIT) bar = xcd_barrier_post((unsigned*)(F.ctl + CW_BAR), F.MISC + 8);
    const int lo = args.ph_lo, hi = args.ph_hi;
#define OPAQUE_LANES() do { unsigned on_ = ~0u; asm volatile("" : "+s"(on_)); int t_ = (int)__builtin_amdgcn_mbcnt_hi(on_, __builtin_amdgcn_mbcnt_lo(on_, 0u)) + 64 * F.wave; asm volatile("" : "+v"(t_)); F.tid = t_; F.lane = t_ & 63; \
        int g_ = F.G, v_ = F.vcu; GAS unsigned char* w_ = (GAS unsigned char*)args.ws; GAS float* o_ = (GAS float*)args.out; asm volatile("" : "+s"(g_), "+s"(v_), "+s"(w_), "+s"(o_)); F.G = g_; F.vcu = v_; F.ws = w_; F.ctl = (gu32*)(w_ + WS_CTL); \
        X = (float*)o_; P = (bf16*)(w_ + WS_P); H = (bf16*)(w_ + WS_H); } while (0)
#ifndef SITE_MASK
#define SITE_MASK 0xffffffffu
#endif
#define INS(site, k) ((((SITE_MASK) >> (site)) & 1u) && lo <= (k) && (k) < hi)
#define IN(k) (lo <= (k) && (k) < hi)
#define SEAM(k) do { if (IN((k) + 1)) xcd_barrier(bar); } while (0)
    float* X;
    bf16* P; bf16* H;
    LAS int* tb = (LAS int*)(F.lds + MISC_OFF + 64);

    if (INS(0, 0)) { OPAQUE_LANES();
        convert_mixer_weights(F, 0);
        convert_matrix<2>(F, arg_in(11), arg_in(12), D, FF, (bf16*)(F.ws + WS_W1), 2 * FF / 32);
        convert_matrix<0>(F, arg_in(13), nullptr, FF, D, (bf16*)(F.ws + WS_W2), D / 32);
        rope_table(F);
        norm_rows(F, arg_in(0), arg_in(1), H);
        SEAM(0);
    }
    for (int l = 0; l < 2; ++l) {
        const int pb = 1 + 10 * l;
        if (INS(1, pb + 0)) { OPAQUE_LANES();
            pg8::SchedStd S; S.T.init(M / 256, NPROJ / 256, F.G, (int)blockIdx.x); S.A = (const char*)H; S.B = (const char*)(F.ws + WS_WIN); S.atile = (size_t)256 * D * 2; S.btile = (size_t)256 * D * 2;
            pg8::EpiInproj E{P, (const float*)(F.ws + WS_TAB)};
            pg8::gemm_phase<pg8::EpiInproj, pg8::SchedStd>(F.lds + RING_OFF, F.wave, D, D, D, S, E);
            SEAM(pb + 0);
        }
        if (INS(2, pb + 1)) { OPAQUE_LANES();
            kmean_phase(F, P);
            ret_kv_phase(F, P);
            conv_phase(F, P, arg_in(3) + (size_t)l * 3 * 512, arg_in(4) + (size_t)l * 512);
            SEAM(pb + 1);
        }
        if (INS(3, pb + 2)) { OPAQUE_LANES(); ret_scan_phase(F); SEAM(pb + 2); }
        if (INS(4, pb + 3)) { OPAQUE_LANES();
            const attn_body::AttnTensors AT{(const attn_body::bf16*)P + pg8::PC_Q, (const attn_body::bf16*)P + pg8::PC_K, (const attn_body::bf16*)P + pg8::PC_V, (attn_body::bf16*)P + pg8::PC_Q, (const float*)(F.ws + WS_KMEAN)};
            const attn_body::StaticOrder S((int)F.G, (int)blockIdx.x);
#if PROBE_SITE == 4
            { const attn_body::AttnTensors AT2{AT.Q, AT.K, AT.V, (attn_body::bf16*)P + pg8::PC_U, AT.KM};
              attn_body::attn_phase<attn_body::StaticOrder>((char*)lds + RING_OFF, AT2, S, F.wave); __syncthreads(); }
#endif
            attn_body::attn_phase<attn_body::StaticOrder>((char*)lds + RING_OFF, AT, S, F.wave);
            __syncthreads(); OPAQUE_LANES();
            ret_out_phase(F, P, arg_in(5) + (size_t)l * 512);
            SEAM(pb + 3);
        }
        if (INS(5, pb + 4)) { OPAQUE_LANES();
            pg8::SchedBranch S; S.T.init(M / 256, D / 256, F.G, (int)blockIdx.x); S.A = (const char*)P; S.B = (const char*)(F.ws + WS_WBR);
            S.atile = (size_t)256 * PW * 2; S.btile = (size_t)256 * 512 * 2; S.bmat = (size_t)D * 512 * 2;
            static_assert(pg8::PC_Q == 0 && pg8::PC_CB == 1536 && pg8::PC_RG == 3584, "SchedBranch::a_ptr");
            pg8::EpiBranch E{P, H};
            pg8::gemm_phase<pg8::EpiBranch, pg8::SchedBranch>(F.lds + RING_OFF, F.wave, 512, PW, 512, S, E);
            SEAM(pb + 4);
        }
        if (INS(6, pb + 5)) { OPAQUE_LANES();
            pg8::SchedStd S; S.T.init(M / 256, D / 256, F.G, (int)blockIdx.x); S.A = (const char*)H; S.B = (const char*)(F.ws + WS_WOUT); S.atile = (size_t)256 * D * 2; S.btile = (size_t)256 * D * 2;
            pg8::EpiResid E{l == 0 ? arg_in(0) : X, X, D};
            pg8::gemm_phase<pg8::EpiResid, pg8::SchedStd>(F.lds + RING_OFF, F.wave, D, D, D, S, E);
            SEAM(pb + 5);
        }
        if (l == 0) {
            if (INS(7, 7)) { OPAQUE_LANES(); norm_rows(F, X, arg_in(10), H); convert_mixer_weights(F, 1); SEAM(7); }
            if (INS(8, 8)) { OPAQUE_LANES();
                pg8::SchedStd S; S.T.init(M / 256, 2 * FF / 256, F.G, (int)blockIdx.x); S.A = (const char*)H; S.B = (const char*)(F.ws + WS_W1); S.atile = (size_t)256 * D * 2; S.btile = (size_t)256 * D * 2;
                pg8::EpiSwiglu E{(bf16*)(F.ws + WS_ACT), FF};
                pg8::gemm_phase<pg8::EpiSwiglu, pg8::SchedStd>(F.lds + RING_OFF, F.wave, D, D, D, S, E);
                SEAM(8);
            }
            if (INS(9, 9)) { OPAQUE_LANES();
                pg8::SchedStd S; S.T.init(M / 256, D / 256, F.G, (int)blockIdx.x); S.A = (const char*)(F.ws + WS_ACT); S.B = (const char*)(F.ws + WS_W2); S.atile = (size_t)256 * FF * 2; S.btile = (size_t)256 * FF * 2;
                pg8::EpiResid E{X, X, D};
                pg8::gemm_phase<pg8::EpiResid, pg8::SchedStd>(F.lds + RING_OFF, F.wave, FF, FF, FF, S, E);
                SEAM(9);
            }
            if (INS(10, 10)) { OPAQUE_LANES(); norm_rows(F, X, arg_in(1) + D, H); SEAM(10); }
        } else {
            if (INS(11, 17)) { OPAQUE_LANES();
                norm_router_rows(F, X, arg_in(10) + D, arg_in(14), (unsigned char*)(F.ws + WS_H8));
                for (int e = 0; e < NEXP; ++e) {
                    convert_matrix<2, true>(F, arg_in(15) + (size_t)e * D * FF, arg_in(16) + (size_t)e * D * FF, D, FF, (unsigned char*)(F.ws + WS_MW1) + (size_t)e * 2 * FF * D, 2 * FF / 32);
                    convert_matrix<0, true>(F, arg_in(17) + (size_t)e * FF * D, nullptr, FF, D, (unsigned char*)(F.ws + WS_MW2) + (size_t)e * D * FF, D / 32);
                }
                int* tokof = (int*)(F.ws + WS_TOKOF); float* pwof = (float*)(F.ws + WS_PWOF);
                for (int i = F.vcu * 512 + F.tid; i < MAXSLOT; i += F.G * 512) { tokof[i] = -1; pwof[i] = 0.f; }
                SEAM(17);
            }
            if (INS(12, 18)) { OPAQUE_LANES(); moe_tables(F, tb); moe_gather(F, tb); SEAM(18); }
            if (INS(13, 19)) { OPAQUE_LANES();
                moe_tables(F, tb);
                pg8::SchedMoe S; S.T.init(tb[8], 2 * FF / 256, F.G, (int)blockIdx.x); S.A = (const char*)(F.ws + WS_XG); S.B = (const char*)(F.ws + WS_MW1);
                S.atile = (size_t)256 * D; S.btile = (size_t)256 * D; S.bexp = (size_t)2 * FF * D; S.tbase = tb;
                pg8::EpiSwiglu8 E{(unsigned char*)(F.ws + WS_ACTM), FF};
                pg8::gemm_phase<pg8::EpiSwiglu8, pg8::SchedMoe, true>(F.lds + RING_OFF, F.wave, D / 2, D / 2, D / 2, S, E);
                SEAM(19);
            }
            if (INS(14, 20)) { OPAQUE_LANES();
                moe_tables(F, tb);
                pg8::SchedMoe S; S.T.init(tb[8], D / 256, F.G, (int)blockIdx.x); S.A = (const char*)(F.ws + WS_ACTM); S.B = (const char*)(F.ws + WS_MW2);
                S.atile = (size_t)256 * FF; S.btile = (size_t)256 * FF; S.bexp = (size_t)D * FF; S.tbase = tb;
                pg8::EpiMoeY E{(bf16*)(F.ws + WS_Y), (const int*)(F.ws + WS_TOKOF), (const float*)(F.ws + WS_PWOF)};
                pg8::gemm_phase<pg8::EpiMoeY, pg8::SchedMoe, true>(F.lds + RING_OFF, F.wave, FF / 2, FF / 2, FF / 2, S, E);
                SEAM(20);
            }
            if (INS(15, 21)) { OPAQUE_LANES(); final_norm(F, X, arg_in(18), (const bf16*)(F.ws + WS_Y)); }
        }
    }
#undef IN
#undef INS
#undef SEAM
}

extern "C" void kernel_launch(void* const* d_in, const int* in_sizes, int n_in, void* d_out, int out_size, void* d_ws, size_t ws_size, hipStream_t stream) {
    static int grid = 0;
    if (grid == 0) {
        if (n_in != 19 || in_sizes[0] != M * D || out_size != M * D || ws_size < WS_END) { fprintf(stderr, "kernel_launch: unexpected problem shape or workspace (%d inputs, ws %zu < %zu); nothing launched\n", n_in, ws_size, (size_t)WS_END); grid = -1; return; }
        int dev = 0, cus = 0, per_cu = 0;
        if (hipGetDevice(&dev) != hipSuccess || hipDeviceGetAttribute(&cus, hipDeviceAttributeMultiprocessorCount, dev) != hipSuccess) { grid = -1; return; }
        if (hipFuncSetAttribute((const void*)fwd_kernel, hipFuncAttributeMaxDynamicSharedMemorySize, LDS_BYTES) != hipSuccess) { fprintf(stderr, "kernel_launch: hipFuncSetAttribute failed\n"); grid = -1; return; }
        if (hipOccupancyMaxActiveBlocksPerMultiprocessor(&per_cu, (const void*)fwd_kernel, NWAVES * 64, LDS_BYTES) != hipSuccess || per_cu < 1)
            fprintf(stderr, "kernel_launch: note: occupancy query reports %d workgroups per CU\n", per_cu);
        (void)hipGetLastError();
        grid = cus;
    }
    if (grid < 0) return;
    if (hipMemsetAsync((char*)d_ws + WS_CTL, 0, CTL_ZERO_BYTES, stream) != hipSuccess) return;
    Args a{};
    for (int i = 0; i < 19; ++i) a.in[i] = (const float*)d_in[i];
    a.out = (float*)d_out; a.ws = (unsigned char*)d_ws;
#if MK_SPLIT
    for (int p = 0; p < N_PHASES; ++p) { a.ph_lo = p; a.ph_hi = p + 1; hipLaunchKernelGGL(fwd_kernel, dim3(grid), dim3(NWAVES * 64), LDS_BYTES, stream, a); }
#else
    a.ph_lo = 0; a.ph_hi = N_PHASES;
    hipLaunchKernelGGL(fwd_kernel, dim3(grid), dim3(NWAVES * 64), LDS_BYTES, stream, a);
#endif
}
```

```cpp
#include <hip/hip_runtime.h>
#include <hip/hip_bf16.h>
#include <cstdio>
#include <cstdint>
#include <cmath>

#ifndef PROBE_SITE
#define PROBE_SITE -1
#endif
#ifndef CHECK_ATTN
#define CHECK_ATTN 0
#endif
#ifndef UP_FP8
#define UP_FP8 true
#endif
#ifndef DOWN_FP8
#define DOWN_FP8 false
#endif
#ifndef MK_SPLIT
#define MK_SPLIT 0
#endif

namespace pg8 {
#define PG8_LAS __attribute__((address_space(3)))
#define PG8_GAS __attribute__((address_space(1)))
typedef unsigned short bf16_t;
typedef short bf16x8 __attribute__((ext_vector_type(8)));
typedef float f32x4 __attribute__((ext_vector_type(4)));
typedef float f32x2 __attribute__((ext_vector_type(2)));
typedef unsigned u32x4 __attribute__((ext_vector_type(4)));
typedef unsigned u32x2 __attribute__((ext_vector_type(2)));
typedef int v4i_t __attribute__((ext_vector_type(4)));
typedef int v8i_t __attribute__((ext_vector_type(8)));
constexpr int BM = 256, BK = 64, HALF = 128, HTB = HALF * BK * 2  , STAGE_BYTES = 8 * HTB, NXCD = 8, WGM = 8;

__host__ __device__ __forceinline__ int lds_byte(int r, int c) { const int st = (r >> 4) * 2 + (c >> 5), rr = r & 15, cc = c & 31, ob = rr * 64 + cc * 2; return st * 1024 + (ob ^ (((ob >> 9) & 1) << 5)); }
__host__ __device__ __forceinline__ void stage_rc(int b, int& R, int& C) { const int st = b / 1024, sb = b % 1024, swz = sb ^ (((sb >> 9) & 1) << 5); R = (st >> 1) * 16 + swz / 64; C = (st & 1) * 32 + (swz % 64) / 2; }
__host__ __device__ __forceinline__ int perm32(int rho) { const int n = rho >> 4, i = rho & 15; return 8 * (i >> 2) + 4 * n + (i & 3); }

struct Unit { int pm, pn, z; };

struct TileOrder {
    int nM, nN, nwg, G, c;
    __device__ __forceinline__ void init(int nM_, int nN_, int G_, int c_) { nM = nM_; nN = nN_; nwg = nM * nN; G = G_; c = c_; }
    __device__ __forceinline__ bool tile(int i, int& pm, int& pn) const { return tileL((long)i * G + c, pm, pn); }
    __device__ __forceinline__ bool tileL(const long L, int& pm, int& pn) const {
        if (L >= nwg) return false;
        int wgid = (int)L; { const int q = nwg / NXCD, r = nwg % NXCD, xcd = wgid % NXCD, off = wgid / NXCD; wgid = (xcd < r ? xcd * (q + 1) : r * (q + 1) + (xcd - r) * q) + off; }
        const int nig = WGM * nN, gid = wgid / nig, fm = gid * WGM, gsz = (nM - fm) < WGM ? (nM - fm) : WGM;
        pm = fm + ((wgid % nig) % gsz); pn = (wgid % nig) / gsz; return true;
    }
};
struct SchedStd {
    static constexpr bool DEPS = false, PUBLISH = false, GATHER = false;
    TileOrder T; const char* A; const char* B; size_t atile, btile;
    __device__ __forceinline__ bool next(int i, Unit& u) const { u.z = 0; return T.tile(i, u.pm, u.pn); }
    __device__ __forceinline__ const char* a_ptr(const Unit& u) const { return A + (size_t)u.pm * atile; }
    __device__ __forceinline__ const char* b_ptr(const Unit& u) const { return B + (size_t)u.pn * btile; }
};
struct SchedBranch {
    static constexpr bool DEPS = false, PUBLISH = false, GATHER = false;
    TileOrder T; const char* A; const char* B; size_t atile, btile, bmat;
    __device__ __forceinline__ bool next(int i, Unit& u) const { u.z = i % 3; return T.tile(i / 3, u.pm, u.pn); }
    __device__ __forceinline__ const char* a_ptr(const Unit& u) const { return A + (size_t)u.pm * atile + (size_t)((CHECK_ATTN && u.z == 0) ? 2048 * 2 : (256 * u.z * u.z + 1280 * u.z) * 2); }
    __device__ __forceinline__ const char* b_ptr(const Unit& u) const { return B + (size_t)u.z * bmat + (size_t)u.pn * btile; }
};
struct SchedMoe {
    static constexpr bool DEPS = false, PUBLISH = false, GATHER = false;
    TileOrder T; const char* A; const char* B; size_t atile, btile, bexp; const PG8_LAS int* tbase;
    __device__ __forceinline__ bool next(int i, Unit& u) const { u.z = 0; return T.tile(i, u.pm, u.pn); }
    __device__ __forceinline__ const char* a_ptr(const Unit& u) const { return A + (size_t)u.pm * atile; }
    __device__ __forceinline__ const char* b_ptr(const Unit& u) const {
        int e = 0;
#pragma unroll
        for (int j = 1; j < 8; ++j) e += (u.pm >= tbase[j]) ? 1 : 0;
        return B + (size_t)e * bexp + (size_t)u.pn * btile; }
};

constexpr int MOE_XR = 3;
#ifndef MOE_GATHER_IN_GEMM
#define MOE_GATHER_IN_GEMM 0
#endif
template <int STAGE>
struct SchedMoeBal {
    static constexpr bool DEPS = (STAGE == 2), PUBLISH = (STAGE == 1), GATHER = (STAGE == 1) && MOE_GATHER_IN_GEMM;
    TileOrder T; const char* A; const char* B; size_t atile, btile, bexp; const PG8_LAS int* tbase; unsigned* cnt; int nfull, nextra, light, target;
    unsigned tpk0, tpk1, tpk2;
    const int* tokof; unsigned toktab;
    __device__ __forceinline__ void balance(int n1, int n2) {
        const int G = T.G, r2 = (n2 + G - 1) / G, E = n2 - (r2 - 1) * G; light = G - E;
        const int rest = n1 - MOE_XR * light, c1 = rest > 0 ? (rest + G - 1) / G : 0;
        if (STAGE == 1) { nfull = c1; nextra = MOE_XR; } else { nfull = r2 - 1; nextra = 1; } }
    __device__ __forceinline__ bool next(int i, Unit& u) const { u.z = 0;
        long L;
        if (i < nfull) L = (long)i * T.G + T.c;
        else if (i < nfull + nextra) {
            if (STAGE == 1) { if (T.c >= light) return false; L = (long)nfull * T.G + (long)(i - nfull) * light + T.c; }
            else            { if (T.c < light) return false;  L = (long)nfull * T.G + (long)(i - nfull) * (T.G - light) + (T.c - light); } }
        else return false;
        return T.tileL(L, u.pm, u.pn); }
    __device__ __forceinline__ const char* a_ptr(const Unit& u) const { return GATHER ? A : A + (size_t)u.pm * atile; }
    __device__ __forceinline__ void pack_tables() {
        unsigned t[8];
#pragma unroll
        for (int j = 1; j < 8; ++j) t[j] = (unsigned)tbase[j];
        tpk0 = (unsigned)__builtin_amdgcn_readfirstlane((int)(t[1] | (t[2] << 10) | (t[3] << 20))); tpk1 = (unsigned)__builtin_amdgcn_readfirstlane((int)(t[4] | (t[5] << 10) | (t[6] << 20))); tpk2 = (unsigned)__builtin_amdgcn_readfirstlane((int)t[7]); }
    __device__ __forceinline__ const char* b_ptr(const Unit& u) const {
        const unsigned pm = (unsigned)u.pm;
        const int e = (pm >= (tpk0 & 1023u)) + (pm >= ((tpk0 >> 10) & 1023u)) + (pm >= (tpk0 >> 20)) + (pm >= (tpk1 & 1023u)) + (pm >= ((tpk1 >> 10) & 1023u)) + (pm >= (tpk1 >> 20)) + (pm >= tpk2);
        return B + (size_t)e * bexp + (size_t)u.pn * btile; }
    __device__ __forceinline__ void publish(const Unit& u) const { __hip_atomic_fetch_add((PG8_GAS unsigned*)cnt + 16 * u.pm, 1u, __ATOMIC_RELAXED, __HIP_MEMORY_SCOPE_AGENT); }
    __device__ __forceinline__ void wait_deps(int i0, int lane) const {
        int pmj[3] = {0, 0, 0}, n = 0;
#pragma unroll
        for (int j = 0; j < 3; ++j) { Unit u; if (n == j && next(i0 + j, u)) { pmj[j] = u.pm; n = j + 1; } }
        const int pm = lane == 0 ? pmj[0] : (lane == 1 ? pmj[1] : pmj[2]); const bool have = lane < n;
        PG8_GAS unsigned* p = (PG8_GAS unsigned*)cnt + 16 * pm;
        for (unsigned spins = 0; spins < (1u << 18); ++spins) {
            const bool ok = !have || __hip_atomic_load(p, __ATOMIC_RELAXED, __HIP_MEMORY_SCOPE_AGENT) >= (unsigned)target;
            if (__builtin_amdgcn_ballot_w64(!ok) == 0ull) break;
            __builtin_amdgcn_s_sleep(2); }
        __builtin_amdgcn_fence(__ATOMIC_ACQUIRE, "agent"); asm volatile("s_waitcnt vmcnt(0)" ::: "memory"); }
};

__device__ __forceinline__ unsigned cvt_pk_bf16(float lo, float hi) { unsigned r; asm volatile("v_cvt_pk_bf16_f32 %0, %1, %2" : "=v"(r) : "v"(lo), "v"(hi)); return r; }
__device__ __forceinline__ float bf_lo(unsigned w) { return __builtin_bit_cast(float, w << 16); }
__device__ __forceinline__ float bf_hi(unsigned w) { return __builtin_bit_cast(float, w & 0xffff0000u); }
__device__ __forceinline__ float fsigmoid(float x) { return __builtin_amdgcn_rcpf(1.0f + __builtin_amdgcn_exp2f(-1.4426950408889634f * x)); }

template <class Epi, class Sched, bool FP8 = false>
__device__ __forceinline__ void gemm_phase(PG8_LAS unsigned char* lds, const int wave, const int K, const int lda, const int ldb, const Sched& S, const Epi& E, const unsigned stagger_ticks = 0u) {
    if (stagger_ticks != 0u) { const unsigned long long t0_ = __builtin_amdgcn_s_memrealtime(); while (__builtin_amdgcn_s_memrealtime() - t0_ < (unsigned long long)stagger_ticks) __builtin_amdgcn_s_sleep(8); }
    unsigned on_ = ~0u; asm volatile("" : "+s"(on_)); int tid_ = (int)__builtin_amdgcn_mbcnt_hi(on_, __builtin_amdgcn_mbcnt_lo(on_, 0u)) + 64 * wave; asm volatile("" : "+v"(tid_));
    const int tid = tid_, wid = __builtin_amdgcn_readfirstlane(tid >> 6), lane = tid & 63, wr = wid >> 2, wc = wid & 3, fr = lane & 15, fq = lane >> 4;
    const int nt = K / BK;
    unsigned voffA[2], voffB[2];
#pragma unroll
    for (int i = 0; i < 2; ++i) { int R, C; stage_rc(tid * 16 + i * 8192, R, C); const int Rb = Epi::PERM ? ((R & ~31) + perm32(R & 31)) : R;
        voffA[i] = (unsigned)(R * lda + C) * 2u; voffB[i] = (unsigned)(Rb * ldb + C) * 2u; }
    const size_t kstep = (size_t)(BK * 2);
    const size_t hsA = (size_t)HALF * lda * 2, hsB = (size_t)HALF * ldb * 2;
    const unsigned ldsw = (unsigned)wid * 1024u;
    const int aoff = lds_byte(wr * 64 + fr, fq * 8), boff = lds_byte(wc * 32 + fr, fq * 8);
#define PG8_SA(b, h) (((b) * 2 + (h)) * HTB)
#define PG8_SB(b, h) ((4 + (b) * 2 + (h)) * HTB)
#define PG8_STAGE(bufoff, gbase, voff) do { _Pragma("unroll") for (int _i = 0; _i < 2; ++_i) \
        __builtin_amdgcn_global_load_lds((const unsigned*)((const char*)(gbase) + (voff)[_i]), (PG8_LAS unsigned*)(lds + (bufoff) + ldsw + _i * 8192), 16, 0, 0); } while (0)
#define PG8_STAGE_A(b, h, abase, gsel) do { if constexpr (Sched::GATHER) { PG8_STAGE(PG8_SA(b, h), (abase), (gsel)[h]); } else { PG8_STAGE(PG8_SA(b, h), (abase) + ((h) ? hsA : 0), voffA); } } while (0)
#define PG8_LDA(dst, b, h) do { _Pragma("unroll") for (int m = 0; m < 4; ++m) { const v4i_t lo_ = *(const PG8_LAS v4i_t*)(lds + PG8_SA(b, h) + aoff + m * 2048), hi_ = *(const PG8_LAS v4i_t*)(lds + PG8_SA(b, h) + aoff + m * 2048 + 1024); \
        dst[m] = __builtin_shufflevector(lo_, hi_, 0, 1, 2, 3, 4, 5, 6, 7); } } while (0)
#define PG8_LDB(dst, b, h) do { _Pragma("unroll") for (int n = 0; n < 2; ++n) { const v4i_t lo_ = *(const PG8_LAS v4i_t*)(lds + PG8_SB(b, h) + boff + n * 2048), hi_ = *(const PG8_LAS v4i_t*)(lds + PG8_SB(b, h) + boff + n * 2048 + 1024); \
        dst[n] = __builtin_shufflevector(lo_, hi_, 0, 1, 2, 3, 4, 5, 6, 7); } } while (0)
#define PG8_LO(x) __builtin_bit_cast(bf16x8, __builtin_shufflevector(x, x, 0, 1, 2, 3))
#define PG8_HI(x) __builtin_bit_cast(bf16x8, __builtin_shufflevector(x, x, 4, 5, 6, 7))
#define PG8_MMA(ai, bj, At, Bt) do { __builtin_amdgcn_s_setprio(1); _Pragma("unroll") for (int m = 0; m < 4; ++m) _Pragma("unroll") for (int n = 0; n < 2; ++n) { \
        if constexpr (FP8) asm volatile("v_mfma_f32_16x16x128_f8f6f4 %0, %1, %2, %0" : "+v"(acc[ai][bj][m][n]) : "v"(Bt[n]), "v"(At[m])); \
        else { acc[ai][bj][m][n] = __builtin_amdgcn_mfma_f32_16x16x32_bf16(PG8_LO(Bt[n]), PG8_LO(At[m]), acc[ai][bj][m][n], 0, 0, 0); \
               acc[ai][bj][m][n] = __builtin_amdgcn_mfma_f32_16x16x32_bf16(PG8_HI(Bt[n]), PG8_HI(At[m]), acc[ai][bj][m][n], 0, 0, 0); } } \
        __builtin_amdgcn_s_setprio(0); } while (0)
#define PG8_WAIT_V(n) asm volatile("s_waitcnt vmcnt(" #n ")" ::: "memory")
#define PG8_WAIT_L(n) asm volatile("s_waitcnt lgkmcnt(" #n ")" ::: "memory")
#define PG8_BAR __builtin_amdgcn_s_barrier()
#define PG8_SCHED __builtin_amdgcn_sched_barrier(0)
    Unit cur, nxt, prv; int ui = 0;
    if (!S.next(0, cur)) return;
    if constexpr (Sched::DEPS) { if (wid == 0) S.wait_deps(0, lane); PG8_BAR; }
    prv = cur;
    f32x4 acc[2][2][4][2];
#pragma unroll
    for (int a = 0; a < 2; ++a)
#pragma unroll
        for (int b = 0; b < 2; ++b)
#pragma unroll
            for (int m = 0; m < 4; ++m)
#pragma unroll
                for (int n = 0; n < 2; ++n) acc[a][b][m][n] = (f32x4){0.f, 0.f, 0.f, 0.f};
    v8i_t At[4], B0[2], B1[2];
    const char* cA = S.a_ptr(cur); const char* cB = S.b_ptr(cur);
    unsigned gA[2][2] = {{0u, 0u}, {0u, 0u}}, gN[2][2] = {{0u, 0u}, {0u, 0u}};
    int gR[2], gC[2];
#pragma unroll
    for (int i = 0; i < 2; ++i) stage_rc(tid * 16 + i * 8192, gR[i], gC[i]);
#define PG8_TOKDMA(u_, par_) do { if (wid < 4) __builtin_amdgcn_global_load_lds((const unsigned*)(S.tokof + (size_t)(u_).pm * BM + wid * 64 + lane), (PG8_LAS unsigned*)(lds + S.toktab + (par_) * 1024 + wid * 256), 4, 0, 0); } while (0)
#define PG8_TOKREAD(dst, par_) do { _Pragma("unroll") for (int h_ = 0; h_ < 2; ++h_) _Pragma("unroll") for (int i_ = 0; i_ < 2; ++i_) { \
        const int t_ = *(const PG8_LAS int*)(lds + S.toktab + (par_) * 1024 + (gR[i_] + HALF * h_) * 4); dst[h_][i_] = (unsigned)(t_ < 0 ? 0 : (t_ & 0x3fffffff)) * (unsigned)(lda * 2) + (unsigned)(gC[i_] * 2); } } while (0)
    if constexpr (Sched::GATHER) { PG8_TOKDMA(cur, 0); PG8_WAIT_V(0); PG8_BAR; PG8_TOKREAD(gA, 0); }
    PG8_STAGE(PG8_SB(0, 0), cB, voffB); PG8_STAGE(PG8_SB(0, 1), cB + hsB, voffB); PG8_STAGE_A(0, 0, cA, gA); PG8_STAGE_A(0, 1, cA, gA);
    if (wr == 1) PG8_BAR;
    PG8_WAIT_V(2); PG8_BAR;
    PG8_STAGE(PG8_SB(1, 0), cB + kstep, voffB); PG8_STAGE_A(1, 0, cA + kstep, gA); PG8_STAGE(PG8_SB(1, 1), cB + hsB + kstep, voffB);
    PG8_WAIT_V(6); PG8_BAR;
    for (;;) {
        const bool has_next = S.next(ui + 1, nxt);
        const char* nA = has_next ? S.a_ptr(nxt) : cA; const char* nB = has_next ? S.b_ptr(nxt) : cB;
        if constexpr (Sched::GATHER) { if (has_next) PG8_TOKDMA(nxt, (ui + 1) & 1); }
        for (int t = 0; t < nt; t += 2) {
            const bool last = (t == nt - 2);
            if constexpr (Sched::DEPS) { if (last && has_next && (ui + 1) % 3 == 0 && wid == 0) S.wait_deps(ui + 1, lane); }
            if constexpr (Sched::PUBLISH) { if (last && ui > 0 && tid == 0) S.publish(prv); }
            const char* a1 = cA + (size_t)(t + 1) * kstep;
            const char* a2 = last ? nA : cA + (size_t)(t + 2) * kstep; const char* b2 = last ? nB : cB + (size_t)(t + 2) * kstep;
            const char* a3 = a2 + kstep; const char* b3 = b2 + kstep;
            if constexpr (Sched::GATHER) { if (last) { if (has_next) { PG8_TOKREAD(gN, (ui + 1) & 1); } else { gN[0][0] = gA[0][0]; gN[0][1] = gA[0][1]; gN[1][0] = gA[1][0]; gN[1][1] = gA[1][1]; } } }
            unsigned g2[2][2];
#pragma unroll
            for (int h_ = 0; h_ < 2; ++h_)
#pragma unroll
                for (int i_ = 0; i_ < 2; ++i_) g2[h_][i_] = last ? gN[h_][i_] : gA[h_][i_];
            PG8_LDB(B0, 0, 0); PG8_LDB(B1, 0, 1); PG8_SCHED; PG8_LDA(At, 0, 0); PG8_STAGE_A(1, 1, a1, gA);
            PG8_WAIT_V(8); PG8_WAIT_L(0); PG8_BAR; PG8_MMA(0, 0, At, B0); PG8_MMA(0, 1, At, B1); PG8_BAR; PG8_SCHED;
            PG8_LDA(At, 0, 1); PG8_STAGE(PG8_SB(0, 0), b2, voffB); PG8_STAGE(PG8_SB(0, 1), b2 + hsB, voffB); PG8_STAGE_A(0, 0, a2, g2);
            PG8_WAIT_V(8); PG8_WAIT_L(0); PG8_BAR; PG8_MMA(1, 0, At, B0); PG8_MMA(1, 1, At, B1); PG8_BAR; PG8_SCHED;
            PG8_LDB(B0, 1, 0); PG8_LDB(B1, 1, 1); PG8_SCHED; PG8_LDA(At, 1, 0); PG8_STAGE_A(0, 1, a2, g2);
            PG8_WAIT_V(8); PG8_WAIT_L(0); PG8_BAR; PG8_MMA(0, 0, At, B0); PG8_MMA(0, 1, At, B1); PG8_BAR; PG8_SCHED;
            PG8_LDA(At, 1, 1); PG8_STAGE(PG8_SB(1, 0), b3, voffB); PG8_STAGE(PG8_SB(1, 1), b3 + hsB, voffB); PG8_STAGE_A(1, 0, a3, g2);
            PG8_WAIT_V(8); PG8_WAIT_L(0); PG8_BAR; PG8_MMA(1, 0, At, B0); PG8_MMA(1, 1, At, B1); PG8_BAR; PG8_SCHED;
        }
        if (wr == 0) PG8_BAR;
        if constexpr (FP8) asm volatile("s_nop 15\n\ts_nop 7" ::: "memory");
        { unsigned on2_ = ~0u; asm volatile("" : "+s"(on2_)); const int l2_ = (int)__builtin_amdgcn_mbcnt_hi(on2_, __builtin_amdgcn_mbcnt_lo(on2_, 0u)); E(acc, cur, wr, wc, l2_ & 15, l2_ >> 4);
          if constexpr (Epi::PROBE_TWICE) { asm volatile("" ::: "memory"); Epi E2 = E; E2.st = E.st2; E2(acc, cur, wr, wc, l2_ & 15, l2_ >> 4); } }
        if (!has_next) break;
        if (!Epi::CHAIN || nxt.z == 0) {
#pragma unroll
        for (int a = 0; a < 2; ++a)
#pragma unroll
            for (int b = 0; b < 2; ++b)
#pragma unroll
                for (int m = 0; m < 4; ++m)
#pragma unroll
                    for (int n = 0; n < 2; ++n) acc[a][b][m][n] = (f32x4){0.f, 0.f, 0.f, 0.f};
        }
        prv = cur; cur = nxt; cA = nA; cB = nB; ++ui;
        if constexpr (Sched::GATHER) { gA[0][0] = gN[0][0]; gA[0][1] = gN[0][1]; gA[1][0] = gN[1][0]; gA[1][1] = gN[1][1]; }
        if (wr == 1) PG8_BAR;
    }
    PG8_WAIT_V(0);
    PG8_BAR;
    if constexpr (Sched::PUBLISH) { if (tid == 0) S.publish(cur); }
#undef PG8_STAGE_A
#undef PG8_TOKDMA
#undef PG8_TOKREAD
#undef PG8_SA
#undef PG8_SB
#undef PG8_STAGE
#undef PG8_LDA
#undef PG8_LDB
#undef PG8_MMA
#undef PG8_LO
#undef PG8_HI
#undef PG8_WAIT_V
#undef PG8_WAIT_L
#undef PG8_BAR
#undef PG8_SCHED
}

constexpr int PW = 5632;
constexpr int PC_Q = 0, PC_K = 512, PC_V = 1024, PC_CB = 1536, PC_U = 2048, PC_RQ = 2560, PC_RK = 2816, PC_RV = 3072, PC_RG = 3584, PG_BYTE = 8192;
constexpr float QSCALE = 0.125f * 1.4426950408889634f;

__device__ __forceinline__ u32x4 pack8(const f32x4& a, const f32x4& b) { u32x4 w; w.x = cvt_pk_bf16(a[0], a[1]); w.y = cvt_pk_bf16(a[2], a[3]); w.z = cvt_pk_bf16(b[0], b[1]); w.w = cvt_pk_bf16(b[2], b[3]); return w; }

__constant__ float c_inv_rev[32] = {1.591549367e-01f, 1.193493679e-01f, 8.949939907e-02f, 6.711508334e-02f, 5.032921210e-02f, 3.774158657e-02f, 2.830219641e-02f, 2.122365311e-02f, 1.591549441e-02f, 1.193493605e-02f, 8.949939162e-03f, 6.711508147e-03f, 5.032921676e-03f, 3.774158191e-03f, 2.830219688e-03f, 2.122365404e-03f, 1.591549371e-03f, 1.193493721e-03f, 8.949940093e-04f, 6.711508031e-04f, 5.032921326e-04f, 3.774158540e-04f, 2.830219746e-04f, 2.122365258e-04f, 1.591549517e-04f, 1.193493663e-04f, 8.949940093e-05f, 6.711509195e-05f, 5.032921399e-05f, 3.774158540e-05f, 2.830219637e-05f, 2.122365368e-05f};
struct EpiInproj {
    static constexpr bool PERM = true, PROBE_TWICE = (PROBE_SITE == 21 || PROBE_SITE == 23), CHAIN = false;
    bf16_t* P; const float* cs; int st, st2; int pn0; float ascale;
    __device__ __forceinline__ void operator()(f32x4 (&acc)[2][2][4][2], const Unit& u, int wr, int wc, int fr, int fq) const {
        const int pn = u.pn + pn0, row0 = u.pm * BM + wr * 64 + fr;
        const int tb = (pn < 8) ? pn * 256 : pn * 256 - 512;
        if (pn < 4 || pn == 12 || pn == 13) {
            const float sc = ((pn < 2) ? QSCALE : ((pn == 13) ? 0.125f : 1.0f)) * ascale;
            const int ob = tb + wc * 64 + 8 * fq;
            const f32x4 wv0 = *(const f32x4*)(c_inv_rev + 8 * fq), wv1 = *(const f32x4*)(c_inv_rev + 8 * fq + 4);
#pragma unroll
            for (int ai = 0; ai < 2; ++ai)
#pragma unroll
                for (int m = 0; m < 4; ++m) { const int row = row0 + ai * HALF + m * 16; const float pos = (float)(row & 4095);
                    f32x4 c0, c1, s0, s1;
#pragma unroll
                    for (int e = 0; e < 4; ++e) { const float r0 = __builtin_amdgcn_fractf(pos * wv0[e]), r1 = __builtin_amdgcn_fractf(pos * wv1[e]);
                        c0[e] = __builtin_amdgcn_cosf(r0); s0[e] = __builtin_amdgcn_sinf(r0); c1[e] = __builtin_amdgcn_cosf(r1); s1[e] = __builtin_amdgcn_sinf(r1); }
                    const f32x4 x1a = acc[ai][0][m][0], x1b = acc[ai][0][m][1], x2a = acc[ai][1][m][0], x2b = acc[ai][1][m][1];
                    const float sr = sc;
                    const f32x4 o1a = (x1a * c0 - x2a * s0) * sr, o1b = (x1b * c1 - x2b * s1) * sr, o2a = (x2a * c0 + x1a * s0) * sr, o2b = (x2b * c1 + x1b * s1) * sr;
                    bf16_t* rp = P + (size_t)row * PW + ob;
                    { const u32x4 w1_ = pack8(o1a, o1b), w2_ = pack8(o2a, o2b); if (st) { *(u32x4*)(rp) = w1_; *(u32x4*)(rp + 32) = w2_; } else asm volatile("" :: "v"(w1_), "v"(w2_)); }
                    if (m & 1) asm volatile("" ::: "memory"); }
        } else if (pn >= 8 && pn < 12) {
            const int ob = PC_U + 128 * (pn - 8) + 32 * wc + 8 * fq;
#pragma unroll
            for (int ai = 0; ai < 2; ++ai)
#pragma unroll
                for (int m = 0; m < 4; ++m) { const int row = row0 + ai * HALF + m * 16;
                    { const u32x4 w_ = pack8(acc[ai][0][m][0] * acc[ai][1][m][0], acc[ai][0][m][1] * acc[ai][1][m][1]); if (st) *(u32x4*)(P + (size_t)row * PW + ob) = w_; else asm volatile("" :: "v"(w_)); } }
        } else {
            const int kind = (pn >= 16) ? 1 : 0;
            const int ob = tb + 32 * wc + 8 * fq;
#pragma unroll
            for (int ai = 0; ai < 2; ++ai)
#pragma unroll
                for (int m = 0; m < 4; ++m) { const int row = row0 + ai * HALF + m * 16;
#pragma unroll
                    for (int bj = 0; bj < 2; ++bj) { f32x4 v0 = acc[ai][bj][m][0] * ascale, v1 = acc[ai][bj][m][1] * ascale;
                        if (kind != 0) {
#pragma unroll
                            for (int e = 0; e < 4; ++e) { const float g0 = fsigmoid(v0[e]), g1 = fsigmoid(v1[e]); v0[e] = v0[e] * g0; v1[e] = v1[e] * g1; } }
                        { const u32x4 w_ = pack8(v0, v1); if (st) *(u32x4*)(P + (size_t)row * PW + ob + bj * HALF) = w_; else asm volatile("" :: "v"(w_)); } } }
        }
    }
};
__device__ __forceinline__ unsigned pk_u8x4(float a, float b, float c, float d) {
    unsigned w = __builtin_amdgcn_cvt_pk_u8_f32(a, 0, 0u); w = __builtin_amdgcn_cvt_pk_u8_f32(b, 1, w); w = __builtin_amdgcn_cvt_pk_u8_f32(c, 2, w); return __builtin_amdgcn_cvt_pk_u8_f32(d, 3, w); }
__device__ __forceinline__ float gate_u8(float acc) { return __builtin_fmaxf(__builtin_floorf(fsigmoid(acc * 0.03125f) * 255.0f + 0.5f), 1.0f); }
struct EpiGates8 {
    static constexpr bool PERM = true, PROBE_TWICE = false, CHAIN = false;
    unsigned char* Pb;
    __device__ __forceinline__ void operator()(f32x4 (&acc)[2][2][4][2], const Unit& u, int wr, int wc, int fr, int fq) const {
        const int row0 = u.pm * BM + wr * 64 + fr, col0 = u.pn * BM + wc * 32 + 8 * fq;
#pragma unroll
        for (int ai = 0; ai < 2; ++ai)
#pragma unroll
            for (int m = 0; m < 4; ++m)
#pragma unroll
                for (int bj = 0; bj < 2; ++bj) { const f32x4 v0 = acc[ai][bj][m][0], v1 = acc[ai][bj][m][1];
                    u32x2 w; w.x = pk_u8x4(gate_u8(v0[0]), gate_u8(v0[1]), gate_u8(v0[2]), gate_u8(v0[3])); w.y = pk_u8x4(gate_u8(v1[0]), gate_u8(v1[1]), gate_u8(v1[2]), gate_u8(v1[3]));
                    *(u32x2*)(Pb + (size_t)(row0 + ai * HALF + m * 16) * (PW * 2) + PG_BYTE + col0 + bj * HALF) = w; }
    }
};
struct EpiQG8 {
    static constexpr bool PERM = true, PROBE_TWICE = false, CHAIN = false;
    EpiInproj a; EpiGates8 g;
    __device__ __forceinline__ void operator()(f32x4 (&acc)[2][2][4][2], const Unit& u, int wr, int wc, int fr, int fq) const {
        if (u.pn < 6) a(acc, u, wr, wc, fr, fq);
        else { Unit u2 = u; u2.pn = u.pn - 6; g(acc, u2, wr, wc, fr, fq); }
    }
};
struct EpiBranch {
    static constexpr bool PERM = true, PROBE_TWICE = false, CHAIN = true;
    const unsigned char* Pb; bf16_t* Mg;
    __device__ __forceinline__ void operator()(f32x4 (&acc)[2][2][4][2], const Unit& u, int wr, int wc, int fr, int fq) const {
        const int row0 = u.pm * BM + wr * 64 + fr, col0 = u.pn * BM + wc * 32 + 8 * fq, z = u.z;
        const int hoff = (z < 2) ? 1024 : 0;
        u32x2 g[2][2][2], h[2][2][2];
#define EB_LOAD(buf, b_) do { _Pragma("unroll") for (int mi = 0; mi < 2; ++mi) _Pragma("unroll") for (int bj = 0; bj < 2; ++bj) { \
            const unsigned char* gp = Pb + (size_t)(row0 + ((b_) >> 1) * HALF + (2 * ((b_) & 1) + mi) * 16) * (PW * 2) + PG_BYTE + 1024 * z + col0 + bj * HALF; \
            g[buf][mi][bj] = *(const u32x2*)gp; h[buf][mi][bj] = *(const u32x2*)(gp + hoff); } } while (0)
        EB_LOAD(0, 0);
#pragma unroll
        for (int b = 0; b < 4; ++b) { const int ai = b >> 1, mp = b & 1, buf = b & 1;
            if (b < 3) EB_LOAD((b + 1) & 1, b + 1);
            asm volatile("" ::: "memory");
#pragma unroll
            for (int mi = 0; mi < 2; ++mi)
#pragma unroll
                for (int bj = 0; bj < 2; ++bj) { const int m = 2 * mp + mi; const u32x2 gg = g[buf][mi][bj], hh = h[buf][mi][bj];
                    float f[8] = {(float)(gg.x & 0xffu), (float)((gg.x >> 8) & 0xffu), (float)((gg.x >> 16) & 0xffu), (float)(gg.x >> 24), (float)(gg.y & 0xffu), (float)((gg.y >> 8) & 0xffu), (float)((gg.y >> 16) & 0xffu), (float)(gg.y >> 24)};
                    if (z < 2) { const float d[8] = {(float)(hh.x & 0xffu), (float)((hh.x >> 8) & 0xffu), (float)((hh.x >> 16) & 0xffu), (float)(hh.x >> 24), (float)(hh.y & 0xffu), (float)((hh.y >> 8) & 0xffu), (float)((hh.y >> 16) & 0xffu), (float)(hh.y >> 24)};
#pragma unroll
                        for (int e = 0; e < 8; ++e) f[e] *= __builtin_amdgcn_rcpf(d[e]); }
                    else {
#pragma unroll
                        for (int e = 0; e < 8; ++e) f[e] *= (1.0f / 255.0f); }
                    f32x4 v0 = acc[ai][bj][m][0], v1 = acc[ai][bj][m][1];
                    v0[0] *= f[0]; v0[1] *= f[1]; v0[2] *= f[2]; v0[3] *= f[3]; v1[0] *= f[4]; v1[1] *= f[5]; v1[2] *= f[6]; v1[3] *= f[7];
                    if (z < 2) { acc[ai][bj][m][0] = v0; acc[ai][bj][m][1] = v1; }
                    else *(u32x4*)(Mg + (size_t)(row0 + ai * HALF + m * 16) * 1024 + col0 + bj * HALF) = pack8(v0, v1); }
            asm volatile("" ::: "memory");
        }
#undef EB_LOAD
    }
};
struct EpiResid {
    static constexpr bool PERM = false, PROBE_TWICE = false, CHAIN = false;
    const float* res; float* out; int ldc; float scale;
    __device__ __forceinline__ void operator()(f32x4 (&acc)[2][2][4][2], const Unit& u, int wr, int wc, int fr, int fq) const {
        const int row0 = u.pm * BM + wr * 64 + fr, col0 = u.pn * BM + wc * 32 + 4 * fq;
#pragma unroll
        for (int ai = 0; ai < 2; ++ai) {
            f32x4 r[4][2][2];
#pragma unroll
            for (int m = 0; m < 4; ++m) { const size_t off = (size_t)(row0 + ai * HALF + m * 16) * ldc + col0;
#pragma unroll
                for (int bj = 0; bj < 2; ++bj)
#pragma unroll
                    for (int n = 0; n < 2; ++n) r[m][bj][n] = *(const f32x4*)(res + off + bj * HALF + n * 16); }
#pragma unroll
            for (int m = 0; m < 4; ++m) { const size_t off = (size_t)(row0 + ai * HALF + m * 16) * ldc + col0;
#pragma unroll
                for (int bj = 0; bj < 2; ++bj)
#pragma unroll
                    for (int n = 0; n < 2; ++n) *(f32x4*)(out + off + bj * HALF + n * 16) = r[m][bj][n] + acc[ai][bj][m][n] * scale; }
            asm volatile("" ::: "memory");
        }
    }
};
template <bool SRC16> struct EpiResidB {
    static constexpr bool PERM = true, PROBE_TWICE = false, CHAIN = false;
    const void* res; bf16_t* out; int ldc; float scale;
    __device__ __forceinline__ void operator()(f32x4 (&acc)[2][2][4][2], const Unit& u, int wr, int wc, int fr, int fq) const {
        const int row0 = u.pm * BM + wr * 64 + fr, col0 = u.pn * BM + wc * 32 + 8 * fq;
#pragma unroll
        for (int ai = 0; ai < 2; ++ai) {
            if constexpr (SRC16) {
                u32x4 r[4][2];
#pragma unroll
                for (int m = 0; m < 4; ++m) { const size_t off = (size_t)(row0 + ai * HALF + m * 16) * ldc + col0;
#pragma unroll
                    for (int bj = 0; bj < 2; ++bj) r[m][bj] = *(const u32x4*)((const bf16_t*)res + off + bj * HALF); }
#pragma unroll
                for (int m = 0; m < 4; ++m) { const size_t off = (size_t)(row0 + ai * HALF + m * 16) * ldc + col0;
#pragma unroll
                    for (int bj = 0; bj < 2; ++bj) { const u32x4 w = r[m][bj];
                        const f32x4 r0 = (f32x4){bf_lo(w.x), bf_hi(w.x), bf_lo(w.y), bf_hi(w.y)}, r1 = (f32x4){bf_lo(w.z), bf_hi(w.z), bf_lo(w.w), bf_hi(w.w)};
                        *(u32x4*)(out + off + bj * HALF) = pack8(r0 + acc[ai][bj][m][0] * scale, r1 + acc[ai][bj][m][1] * scale); } }
            } else {
                f32x4 r[4][2][2];
#pragma unroll
                for (int m = 0; m < 4; ++m) { const size_t off = (size_t)(row0 + ai * HALF + m * 16) * ldc + col0;
#pragma unroll
                    for (int bj = 0; bj < 2; ++bj)
#pragma unroll
                        for (int n = 0; n < 2; ++n) r[m][bj][n] = *(const f32x4*)((const float*)res + off + bj * HALF + n * 4); }
#pragma unroll
                for (int m = 0; m < 4; ++m) { const size_t off = (size_t)(row0 + ai * HALF + m * 16) * ldc + col0;
#pragma unroll
                    for (int bj = 0; bj < 2; ++bj) *(u32x4*)(out + off + bj * HALF) = pack8(r[m][bj][0] + acc[ai][bj][m][0] * scale, r[m][bj][1] + acc[ai][bj][m][1] * scale); }
            }
            asm volatile("" ::: "memory");
        }
    }
};
__device__ __forceinline__ float sat8(float v) { return __builtin_amdgcn_fmed3f(v, -448.0f, 448.0f); }
__device__ __forceinline__ unsigned pk_fp8x4(float a, float b, float c, float d) { int w = __builtin_amdgcn_cvt_pk_fp8_f32(sat8(a), sat8(b), 0, false); w = __builtin_amdgcn_cvt_pk_fp8_f32(sat8(c), sat8(d), w, true); return (unsigned)w; }
template <bool F8, bool IN8 = false> struct EpiSwigluT {
    static constexpr bool PERM = true, PROBE_TWICE = false, CHAIN = false;
    void* O; int ldo;
    __device__ __forceinline__ void operator()(f32x4 (&acc)[2][2][4][2], const Unit& u, int wr, int wc, int fr, int fq) const {
        const int row0 = u.pm * BM + wr * 64 + fr, col0 = u.pn * HALF + wc * 32 + 8 * fq;
#pragma unroll
        for (int ai = 0; ai < 2; ++ai)
#pragma unroll
            for (int m = 0; m < 4; ++m) { f32x4 v0, v1; constexpr float sc = IN8 ? 0.03125f : 1.0f; const f32x4 g0 = acc[ai][0][m][0] * sc, g1 = acc[ai][0][m][1] * sc, u0 = acc[ai][1][m][0] * sc, u1 = acc[ai][1][m][1] * sc;
#pragma unroll
                for (int e = 0; e < 4; ++e) { v0[e] = g0[e] * fsigmoid(g0[e]) * u0[e]; v1[e] = g1[e] * fsigmoid(g1[e]) * u1[e]; }
                const size_t off = (size_t)(row0 + ai * HALF + m * 16) * ldo + col0;
                if constexpr (F8) { u32x2 w; w.x = pk_fp8x4(v0[0] * 8.f, v0[1] * 8.f, v0[2] * 8.f, v0[3] * 8.f); w.y = pk_fp8x4(v1[0] * 8.f, v1[1] * 8.f, v1[2] * 8.f, v1[3] * 8.f); *(u32x2*)((unsigned char*)O + off) = w; }
                else *(u32x4*)((bf16_t*)O + off) = pack8(v0, v1); }
    }
};
struct EpiSwiglu {
    static constexpr bool PERM = true, PROBE_TWICE = false, CHAIN = false;
    bf16_t* O; int ldo;
    __device__ __forceinline__ void operator()(f32x4 (&acc)[2][2][4][2], const Unit& u, int wr, int wc, int fr, int fq) const {
        const int row0 = u.pm * BM + wr * 64 + fr, col0 = u.pn * HALF + wc * 32 + 8 * fq;
#pragma unroll
        for (int ai = 0; ai < 2; ++ai)
#pragma unroll
            for (int m = 0; m < 4; ++m) { f32x4 v0, v1; const f32x4 g0 = acc[ai][0][m][0], g1 = acc[ai][0][m][1], u0 = acc[ai][1][m][0], u1 = acc[ai][1][m][1];
#pragma unroll
                for (int e = 0; e < 4; ++e) { v0[e] = g0[e] * fsigmoid(g0[e]) * u0[e]; v1[e] = g1[e] * fsigmoid(g1[e]) * u1[e]; }
                *(u32x4*)(O + (size_t)(row0 + ai * HALF + m * 16) * ldo + col0) = pack8(v0, v1); }
    }
};
struct EpiSwiglu8 {
    static constexpr bool PERM = true, PROBE_TWICE = false, CHAIN = false;
    unsigned char* O; int ldo;
    __device__ __forceinline__ void operator()(f32x4 (&acc)[2][2][4][2], const Unit& u, int wr, int wc, int fr, int fq) const {
        const int row0 = u.pm * BM + wr * 64 + fr, col0 = u.pn * HALF + wc * 32 + 8 * fq;
#pragma unroll
        for (int ai = 0; ai < 2; ++ai)
#pragma unroll
            for (int m = 0; m < 4; ++m) { f32x4 v0, v1; const f32x4 g0 = acc[ai][0][m][0] * 0.03125f, g1 = acc[ai][0][m][1] * 0.03125f, u0 = acc[ai][1][m][0] * 0.25f, u1 = acc[ai][1][m][1] * 0.25f;
#pragma unroll
                for (int e = 0; e < 4; ++e) { v0[e] = g0[e] * fsigmoid(g0[e]) * u0[e]; v1[e] = g1[e] * fsigmoid(g1[e]) * u1[e]; }
                u32x2 w; w.x = pk_fp8x4(v0[0], v0[1], v0[2], v0[3]); w.y = pk_fp8x4(v1[0], v1[1], v1[2], v1[3]);
                __hip_atomic_store((PG8_GAS unsigned long long*)(O + (size_t)(row0 + ai * HALF + m * 16) * ldo + col0), __builtin_bit_cast(unsigned long long, w), __ATOMIC_RELAXED, __HIP_MEMORY_SCOPE_AGENT); }
    }
};
struct EpiMoeY {
    static constexpr bool PERM = true, PROBE_TWICE = false, CHAIN = false;
    bf16_t* Y; const int* tok; const float* pw; size_t yrs;
    __device__ __forceinline__ void operator()(f32x4 (&acc)[2][2][4][2], const Unit& u, int wr, int wc, int fr, int fq) const {
        const int slot0 = u.pm * BM + wr * 64 + fr, col0 = u.pn * BM + wc * 32 + 8 * fq;
        int tq[2][4]; float pq[2][4];
#pragma unroll
        for (int ai = 0; ai < 2; ++ai)
#pragma unroll
            for (int m = 0; m < 4; ++m) { const int slot = slot0 + ai * HALF + m * 16; tq[ai][m] = tok[slot]; pq[ai][m] = pw[slot]; }
#pragma unroll
        for (int ai = 0; ai < 2; ++ai)
#pragma unroll
            for (int m = 0; m < 4; ++m) { const int t = tq[ai][m]; const float p = pq[ai][m] * (1.0f / 256.0f);
                if (t >= 0) { bf16_t* yp = Y + (size_t)(t >> 30) * yrs + (size_t)(t & 0x3fffffff) * 1024 + col0;
#pragma unroll
                    for (int bj = 0; bj < 2; ++bj) *(u32x4*)(yp + bj * HALF) = pack8(acc[ai][bj][m][0] * p, acc[ai][bj][m][1] * p); } }
    }
};
}
namespace attn_body {
using bf16=__hip_bfloat16;
using bf16x8=__attribute__((ext_vector_type(8)))short;
using s16x4=__attribute__((ext_vector_type(4)))short;
using f32x16=__attribute__((ext_vector_type(16)))float;
using u32x4=__attribute__((ext_vector_type(4)))unsigned;
constexpr int BATCH=8,NHEAD=8,SEQ=4096,D=64,DM=5632;
constexpr int NW=8,QBLK=32,QB=QBLK*NW,KVBLK=64,NQB=SEQ/QB;
constexpr int ATTN_PITCH=DM, ATTN_UNIT_ROWS=QB;
__device__ __forceinline__ int crow(int r,int hi){return (r&3)+8*(r>>2)+4*hi;}
#define SBAR() __builtin_amdgcn_sched_barrier(0)
__device__ __forceinline__ void cmask(f32x16&p0,f32x16&p1,int jb,int qrel,int hi){
  const float NEG=-INFINITY; int kb=64*jb+4*hi;
  #pragma unroll
  for(int r=0;r<16;++r){int kv=kb+(r&3)+8*(r>>2); if(kv>qrel)p0[r]=NEG; if(kv+32>qrel)p1[r]=NEG;}
}

__device__ __forceinline__ void bmask(f32x16&p0,f32x16&p1,unsigned keep){
  const float NEG=-INFINITY;
  if(!keep){
  #pragma unroll
  for(int r=0;r<16;++r){p0[r]=NEG;p1[r]=NEG;} }
}
typedef float f32x4_t __attribute__((ext_vector_type(4)));
constexpr int LDS_KM=86016;
constexpr int NSLOT=3, SLOTB=8192;
constexpr int LDS_K=0, LDS_V=NSLOT*SLOTB, LDS_WS=2*NSLOT*SLOTB, LDS_OST=LDS_WS+NW*64*4, LDS_BYTES=LDS_OST+NW*4096;
constexpr float C2=0.125f*1.4426950408889634f;
__device__ __forceinline__ void glds16(const void*gsrc,unsigned lds_dst){unsigned keep;
  asm volatile("s_mov_b32 %0, m0\n\ts_mov_b32 m0, %2\n\ts_nop 0\n\tglobal_load_lds_dwordx4 %1, off\n\ts_mov_b32 m0, %0":"=&s"(keep):"v"(gsrc),"s"(lds_dst):"memory");}
__device__ __forceinline__ float max3f(float a,float b,float c){float r;asm("v_max3_f32 %0, %1, %2, %3":"=v"(r):"v"(a),"v"(b),"v"(c));return r;}
__device__ __forceinline__ float max2f(float a,float b){float r;asm("v_max_f32_e32 %0, %1, %2":"=v"(r):"v"(a),"v"(b));return r;}
__device__ __forceinline__ float fadd_s(float a,float b){float r;asm("v_add_f32_e32 %0, %1, %2":"=v"(r):"v"(a),"v"(b));return r;}
__device__ __forceinline__ float fsub_s(float a,float b){float r;asm("v_sub_f32_e32 %0, %1, %2":"=v"(r):"v"(a),"v"(b));return r;}
typedef float f32x2_t __attribute__((ext_vector_type(2))); typedef __bf16 bf16x2_t __attribute__((ext_vector_type(2)));
__device__ __forceinline__ unsigned cvtpk_s(float lo,float hi){f32x2_t v={lo,hi};bf16x2_t b=__builtin_convertvector(v,bf16x2_t);return __builtin_bit_cast(unsigned,b);}
#define WAIT_BAR(N) asm volatile("s_waitcnt vmcnt(" #N ") lgkmcnt(0)\n\ts_barrier":::"memory")

__device__ __forceinline__ void qkt(f32x16&p0,f32x16&p1,const char*Kslot,const bf16x8*qr,const f32x16&negm,int r32,int hi){
  const char*kb=Kslot+hi*1024+r32*16;
  #pragma unroll
  for(int d0=0;d0<4;++d0){
    const bf16x8 b0=*reinterpret_cast<const bf16x8*>(kb+d0*2048);
    const bf16x8 b1=*reinterpret_cast<const bf16x8*>(kb+d0*2048+512);
    if(d0==0){p0=__builtin_amdgcn_mfma_f32_32x32x16_bf16(b0,qr[0],negm,0,0,0);p1=__builtin_amdgcn_mfma_f32_32x32x16_bf16(b1,qr[0],negm,0,0,0);}
    else{p0=__builtin_amdgcn_mfma_f32_32x32x16_bf16(b0,qr[d0],p0,0,0,0);p1=__builtin_amdgcn_mfma_f32_32x32x16_bf16(b1,qr[d0],p1,0,0,0);}}
}
typedef __attribute__((address_space(3))) const char* lds_cptr;
typedef short v4i16_t __attribute__((ext_vector_type(4)));
__device__ __forceinline__ void kload8(bf16x8*kf,lds_cptr kp){
  kf[0]=*(const __attribute__((address_space(3))) bf16x8*)(kp);      kf[1]=*(const __attribute__((address_space(3))) bf16x8*)(kp+512);
  kf[2]=*(const __attribute__((address_space(3))) bf16x8*)(kp+2048); kf[3]=*(const __attribute__((address_space(3))) bf16x8*)(kp+2560);
  kf[4]=*(const __attribute__((address_space(3))) bf16x8*)(kp+4096); kf[5]=*(const __attribute__((address_space(3))) bf16x8*)(kp+4608);
  kf[6]=*(const __attribute__((address_space(3))) bf16x8*)(kp+6144); kf[7]=*(const __attribute__((address_space(3))) bf16x8*)(kp+6656);
}
__device__ __forceinline__ void kload2(bf16x8*kf,lds_cptr kp,int j){ kf[2*j]=*(const __attribute__((address_space(3))) bf16x8*)(kp+j*2048); kf[2*j+1]=*(const __attribute__((address_space(3))) bf16x8*)(kp+j*2048+512); }
__device__ __forceinline__ s16x4 vtr(lds_cptr p){ return __builtin_bit_cast(s16x4,__builtin_amdgcn_ds_read_tr16_b64_v4i16((__attribute__((address_space(3))) v4i16_t*)p)); }
__device__ __forceinline__ float rowmax(const f32x16&p0,const f32x16&p1){
  float a=max3f(p0[0],p0[1],p1[0]),b=max3f(p0[2],p0[3],p1[1]);a=max3f(a,p1[2],p1[3]);
  #pragma unroll
  for(int r=4;r<16;r+=4){a=max3f(a,p0[r],p0[r+1]);b=max3f(b,p0[r+2],p0[r+3]);a=max3f(a,p1[r],p1[r+1]);b=max3f(b,p1[r+2],p1[r+3]);}
  const float m=max2f(a,b);
  auto rr=__builtin_amdgcn_permlane32_swap(__float_as_uint(m),__float_as_uint(m),false,false);
  return max2f(__uint_as_float(rr[0]),__uint_as_float(rr[1]));
}
__device__ __forceinline__ void pv(f32x16*o,int vb,bf16x8 pa0,bf16x8 pa1,bf16x8 pa2,bf16x8 pa3){
  #pragma unroll
  for(int d0=0;d0<2;++d0){s16x4 lo[4],hi[4];
    #pragma unroll
    for(int ks=0;ks<4;++ks){
      asm volatile("ds_read_b64_tr_b16 %0,%1 offset:%c2":"=&v"(lo[ks]):"v"(vb),"i"(d0*4096+ks*1024):"memory");
      asm volatile("ds_read_b64_tr_b16 %0,%1 offset:%c2":"=&v"(hi[ks]):"v"(vb),"i"(d0*4096+ks*1024+512):"memory");}
    asm volatile("s_waitcnt lgkmcnt(0)":::"memory");SBAR();
    #define PK(k) (bf16x8){lo[k][0],lo[k][1],lo[k][2],lo[k][3],hi[k][0],hi[k][1],hi[k][2],hi[k][3]}
    o[d0]=__builtin_amdgcn_mfma_f32_32x32x16_bf16(pa0,PK(0),o[d0],0,0,0);
    o[d0]=__builtin_amdgcn_mfma_f32_32x32x16_bf16(pa1,PK(1),o[d0],0,0,0);
    o[d0]=__builtin_amdgcn_mfma_f32_32x32x16_bf16(pa2,PK(2),o[d0],0,0,0);
    o[d0]=__builtin_amdgcn_mfma_f32_32x32x16_bf16(pa3,PK(3),o[d0],0,0,0);
    #undef PK
  }
}

#ifndef ATTN_STORE16
#define ATTN_STORE16(p,v) (*(u32x4*)(p)=(v))
#endif
template<int THRL> __device__ __forceinline__ void attn_unit(int b,int h,int qb,const bf16*Q,const bf16*__restrict__ K,const bf16*__restrict__ V,bf16*O,const float*__restrict__ KM,char*shm,const int wave_){
  unsigned on_=~0u; asm volatile("":"+s"(on_)); int tid_=(int)__builtin_amdgcn_mbcnt_hi(on_,__builtin_amdgcn_mbcnt_lo(on_,0u))+64*wave_; asm volatile("":"+v"(tid_));
  const int tid=tid_,lane=tid&63,r32=lane&31,hi=lane>>5; const int wid=wave_;
  const long rowbase=(long)b*SEQ; const int q0=qb*QB;
  const bf16*Qw=Q+(rowbase+q0+wid*QBLK)*DM+h*D;
  const bf16*Kh=K+rowbase*DM+h*D,*Vh=V+rowbase*DM+h*D;
  const unsigned lds0=(unsigned)(uintptr_t)shm;
  float*wsf=(float*)(shm+LDS_WS)+wid*64;
  const bf16*ksrc=Kh+(long)lane*DM+wid*8;
  const bf16*vsrc=Vh+(long)(16*(wid&3)+(lane>>2))*DM+(wid>>2)*32+(lane&3)*8;
  const unsigned kdst=lds0+LDS_K+wid*1024, vdst=lds0+LDS_V+wid*1024;
  #define DMA_K(t,slot) glds16(ksrc+(long)(t)*KVBLK*DM,(unsigned)__builtin_amdgcn_readfirstlane(kdst+(slot)))
  #define DMA_V(t,slot) glds16(vsrc+(long)(t)*KVBLK*DM,(unsigned)__builtin_amdgcn_readfirstlane(vdst+(slot)))
  const int vb0=(int)(lds0+LDS_V)+((lane>>4)&1)*32+(lane&3)*8+(4*hi+((lane&15)>>2))*64;
  const char*Kbase=shm+LDS_K; bf16x8 kf[8];
  const lds_cptr shm3=(lds_cptr)shm; const lds_cptr kp0=shm3+LDS_K+hi*1024+r32*16; const lds_cptr vp0=shm3+LDS_V+((lane>>4)&1)*32+(lane&3)*8+(4*hi+((lane&15)>>2))*64;
  const int NT=(q0+QB)/KVBLK;
  __attribute__((address_space(3))) float*kml=(__attribute__((address_space(3))) float*)(shm3+LDS_KM);
  DMA_K(0,0);DMA_V(0,0);DMA_K(1,SLOTB);
  bf16x8 qr[4];
  #pragma unroll
  for(int d0=0;d0<4;++d0)qr[d0]=*reinterpret_cast<const bf16x8*>(&Qw[(long)r32*DM+d0*16+hi*8]);
  { const float*kms=KM+(long)(b*NHEAD+h)*1024; const float k0_=kms[tid],k1_=kms[tid+512]; kml[tid]=k0_; kml[tid+512]=k1_; }
  asm volatile("s_waitcnt lgkmcnt(0)\n\ts_barrier":::"memory");
  unsigned sel=0u;
  if(qb>0){
    float g[15];
    const __attribute__((address_space(3))) float*kmb=kml+8*hi;
    #pragma unroll
    for(int kb=0;kb<15;++kb){ g[kb]=-INFINITY;
      if(kb<qb){ float sacc_=0.f;
        #pragma unroll
        for(int d0=0;d0<4;++d0){ const f32x4_t ka=*(const __attribute__((address_space(3))) f32x4_t*)(kmb+kb*64+16*d0),kc=*(const __attribute__((address_space(3))) f32x4_t*)(kmb+kb*64+16*d0+4);
          sacc_+=__uint_as_float((unsigned)(unsigned short)qr[d0][0]<<16)*ka[0]+__uint_as_float((unsigned)(unsigned short)qr[d0][1]<<16)*ka[1]+__uint_as_float((unsigned)(unsigned short)qr[d0][2]<<16)*ka[2]+__uint_as_float((unsigned)(unsigned short)qr[d0][3]<<16)*ka[3]
                +__uint_as_float((unsigned)(unsigned short)qr[d0][4]<<16)*kc[0]+__uint_as_float((unsigned)(unsigned short)qr[d0][5]<<16)*kc[1]+__uint_as_float((unsigned)(unsigned short)qr[d0][6]<<16)*kc[2]+__uint_as_float((unsigned)(unsigned short)qr[d0][7]<<16)*kc[3]; }
        sacc_+=__builtin_bit_cast(float,__builtin_amdgcn_ds_bpermute((lane^32)<<2,__builtin_bit_cast(int,sacc_))); g[kb]=sacc_; } }
    #pragma unroll
    for(int pass=0;pass<3;++pass){ float bv=-INFINITY; int bi=-1;
      #pragma unroll
      for(int kb=0;kb<15;++kb){ if(kb<qb && !((sel>>kb)&1u) && g[kb]>bv){bv=g[kb];bi=kb;} }
      if(bi>=0)sel|=1u<<bi; }
  }
  float mhat=0.f,l_reg=0.f;f32x16 o[2];o[0]=f32x16{};o[1]=f32x16{};f32x16 negm=f32x16{};asm volatile("":"+v"(negm));
  const int qrel=wid*QBLK+r32;
  #define CMASK(P0,P1,t) do{int jb_=(t)-(NT-4); if(jb_>=0)cmask(P0,P1,jb_,qrel,hi); else bmask(P0,P1,(sel>>((t)>>2))&1u);}while(0)
  bool resc=false;
  #define START(P0,P1) do{ const float rm=rowmax(P0,P1); resc=false; \
    { const float dl=__builtin_fmaxf(rm,-20.f); mhat=fadd_s(mhat,dl); \
      _Pragma("unroll") for(int r=0;r<16;++r){P0[r]=fsub_s(P0[r],dl);P1[r]=fsub_s(P1[r],dl);} \
      _Pragma("unroll") for(int r=0;r<16;++r)negm[r]=-mhat; asm volatile("":"+v"(negm)); } \
    _Pragma("unroll") for(int r=0;r<16;++r)P0[r]=__builtin_amdgcn_exp2f(P0[r]); }while(0)
  #define RESC() do{ if(resc){ asm volatile("s_waitcnt lgkmcnt(0)":::"memory"); \
      _Pragma("unroll") for(int d_=0;d_<2;++d_) _Pragma("unroll") for(int r=0;r<16;++r)o[d_][r]*=wsf[crow(r,hi)]; } }while(0)
  #define NMV(tn) (-mhat)
  f32x16 pA0,pA1,pB0,pB1;
  int sl_prev=0,sl_cur=0,sl_next=SLOTB;
  #define ROT() do{sl_prev=sl_cur;sl_cur=sl_next;sl_next=(sl_next==(NSLOT-1)*SLOTB)?0:sl_next+SLOTB;}while(0)
  DMA_K(2,2*SLOTB);
  WAIT_BAR(3);
  qkt(pA0,pA1,Kbase,qr,negm,r32,hi);asm volatile("s_nop 15\n\ts_nop 7":"+v"(pA0),"+v"(pA1));CMASK(pA0,pA1,0);
  START(pA0,pA1);
  _Pragma("unroll") for(int r=0;r<16;++r)pA1[r]=__builtin_amdgcn_exp2f(pA1[r]);
  WAIT_BAR(0);
  DMA_K(3,0);DMA_V(1,SLOTB);
  ROT();
  kload8(kf,kp0+sl_cur);
  WAIT_BAR(2);
  s16x4 vlo[8],vhi[8]; u32x4 pw0,pw1,pw2,pw3;
  #define PKW(P,B) cvtpk_s(P[B],P[B+1])
  #define PAF(k) __builtin_bit_cast(bf16x8,pw##k)
  #define VFR(i) (bf16x8){vlo[i][0],vlo[i][1],vlo[i][2],vlo[i][3],vhi[i][0],vhi[i][1],vhi[i][2],vhi[i][3]}
  #define PIN(x) asm volatile("":"+v"(x))
  #define MX3(a,b,c) __builtin_fmaxf(__builtin_fmaxf((a),(b)),(c))
  #define GAPA(MF,A0,A1,A2,A3,W0,W1,PW) do{ MF; sacc+=A0; sacc+=A1; sacc+=A2; sacc+=A3; PIN(sacc); W0; W1; PIN(PW); SBAR(); }while(0)
  #define EX(v) __builtin_amdgcn_exp2f(v)
  #define GAPB(MF,X,B) do{ MF; X[B]=EX(X[B]); X[B+1]=EX(X[B+1]); X[B+2]=EX(X[B+2]); X[B+3]=EX(X[B+3]); PIN(X); SBAR(); }while(0)
  #define VRD(i) do{ vlo[i]=vtr(vp_+(((i)>>2)*4096+((i)&3)*1024)); vhi[i]=vtr(vp_+(((i)>>2)*4096+((i)&3)*1024+512)); }while(0)
  #define KRD(G,j) do{ if(G){ kload2(kf,kp0+sl_next,j); SBAR(); } }while(0)
  #define STEP(C0,C1,P0,P1,t,GK,GV,GL) do{ SBAR(); \
    const lds_cptr vp_=vp0+sl_prev; \
    VRD(0); SBAR(); float sacc=(P0[0]+P0[1]); \
    GAPA(C0=__builtin_amdgcn_mfma_f32_32x32x16_bf16(kf[0],qr[0],negm,0,0,0), P0[2],P0[3],P0[4],P0[5],     pw0[0]=PKW(P0,0), pw0[1]=PKW(P0,2), pw0); \
    VRD(4); SBAR(); GAPA(C1=__builtin_amdgcn_mfma_f32_32x32x16_bf16(kf[1],qr[0],negm,0,0,0), P0[6],P0[7],P0[8],P0[9],     pw0[2]=PKW(P0,4), pw0[3]=PKW(P0,6), pw0); \
    VRD(1); SBAR(); GAPA(C0=__builtin_amdgcn_mfma_f32_32x32x16_bf16(kf[2],qr[1],C0,0,0,0),   P0[10],P0[11],P0[12],P0[13], pw1[0]=PKW(P0,8), pw1[1]=PKW(P0,10), pw1); \
    VRD(5); SBAR(); GAPA(C1=__builtin_amdgcn_mfma_f32_32x32x16_bf16(kf[3],qr[1],C1,0,0,0),   P0[14],P0[15],P1[0],P1[1],   pw1[2]=PKW(P0,12),pw1[3]=PKW(P0,14), pw1); \
    VRD(2); SBAR(); GAPA(C0=__builtin_amdgcn_mfma_f32_32x32x16_bf16(kf[4],qr[2],C0,0,0,0),   P1[2],P1[3],P1[4],P1[5],     pw2[0]=PKW(P1,0), pw2[1]=PKW(P1,2), pw2); \
    VRD(6); SBAR(); GAPA(C1=__builtin_amdgcn_mfma_f32_32x32x16_bf16(kf[5],qr[2],C1,0,0,0),   P1[6],P1[7],P1[8],P1[9],     pw2[2]=PKW(P1,4), pw2[3]=PKW(P1,6), pw2); \
    VRD(3); SBAR(); GAPA(C0=__builtin_amdgcn_mfma_f32_32x32x16_bf16(kf[6],qr[3],C0,0,0,0),   P1[10],P1[11],P1[12],P1[13], pw3[0]=PKW(P1,8), pw3[1]=PKW(P1,10), pw3); \
    VRD(7); SBAR(); GAPA(C1=__builtin_amdgcn_mfma_f32_32x32x16_bf16(kf[7],qr[3],C1,0,0,0),   P1[14],P1[15],0.f,0.f,       pw3[2]=PKW(P1,12),pw3[3]=PKW(P1,14), pw3); \
    l_reg+=sacc; \
    if(GK){DMA_K((t)+3,sl_cur);} if(GV){DMA_V((t)+1,sl_next);} \
    CMASK(C0,C1,t); \
    { float a=MX3(C0[0],C0[1],C1[0]),b=MX3(C0[2],C0[3],C1[1]); a=MX3(a,C1[2],C1[3]); \
      _Pragma("unroll") for(int r=4;r<16;r+=4){a=MX3(a,C0[r],C0[r+1]);b=MX3(b,C0[r+2],C0[r+3]);a=MX3(a,C1[r],C1[r+1]);b=MX3(b,C1[r+2],C1[r+3]);} \
      float rm=__builtin_fmaxf(a,b); { auto rr=__builtin_amdgcn_permlane32_swap(__float_as_uint(rm),__float_as_uint(rm),false,false); rm=__builtin_fmaxf(__uint_as_float(rr[0]),__uint_as_float(rr[1])); } \
      resc=false; \
      if(__builtin_expect(__any(rm>(float)THRL),0)){ const float dl=__builtin_fmaxf(rm,0.f); mhat+=dl; \
        _Pragma("unroll") for(int r=0;r<16;++r){C0[r]-=dl;C1[r]-=dl;} \
        { const float nm_=NMV((t)+1); _Pragma("unroll") for(int r=0;r<16;++r)negm[r]=nm_; } asm volatile("":"+v"(negm)); \
        const float f=__builtin_amdgcn_exp2f(-dl); l_reg*=f; if(hi==0)wsf[r32]=f; resc=true; } } \
    SBAR(); \
    GAPB(o[0]=__builtin_amdgcn_mfma_f32_32x32x16_bf16(PAF(0),VFR(0),o[0],0,0,0), C0,0); \
    GAPB(o[1]=__builtin_amdgcn_mfma_f32_32x32x16_bf16(PAF(0),VFR(4),o[1],0,0,0), C0,4); \
    KRD(GL,0); GAPB(o[0]=__builtin_amdgcn_mfma_f32_32x32x16_bf16(PAF(1),VFR(1),o[0],0,0,0), C0,8); \
    KRD(GL,1); GAPB(o[1]=__builtin_amdgcn_mfma_f32_32x32x16_bf16(PAF(1),VFR(5),o[1],0,0,0), C0,12); \
    KRD(GL,2); GAPB(o[0]=__builtin_amdgcn_mfma_f32_32x32x16_bf16(PAF(2),VFR(2),o[0],0,0,0), C1,0); \
    KRD(GL,3); GAPB(o[1]=__builtin_amdgcn_mfma_f32_32x32x16_bf16(PAF(2),VFR(6),o[1],0,0,0), C1,4); \
    GAPB(o[0]=__builtin_amdgcn_mfma_f32_32x32x16_bf16(PAF(3),VFR(3),o[0],0,0,0), C1,8); \
    GAPB(o[1]=__builtin_amdgcn_mfma_f32_32x32x16_bf16(PAF(3),VFR(7),o[1],0,0,0), C1,12); \
    }while(0)
  int t=1;
  #undef CMASK
  #define CMASK(P0,P1,t) do{}while(0)
  #undef NMV
  #define NMV(tn) (((sel>>((tn)>>2))&1u)?-mhat:-INFINITY)
  if(t+5<NT){
    { const float nm_=NMV(1); _Pragma("unroll") for(int r=0;r<16;++r)negm[r]=nm_; asm volatile("":"+v"(negm)); }
    for(;t+5<NT;t+=2){
      STEP(pB0,pB1,pA0,pA1,t,true,true,true);     WAIT_BAR(2); RESC(); ROT();
      if(((t+1)&3)==0){ const float nm_=NMV(t+1); _Pragma("unroll") for(int r=0;r<16;++r)negm[r]=nm_; asm volatile("":"+v"(negm)); }
      STEP(pA0,pA1,pB0,pB1,t+1,true,true,true);   WAIT_BAR(2); RESC(); ROT();
    }
    { _Pragma("unroll") for(int r=0;r<16;++r)negm[r]=-mhat; asm volatile("":"+v"(negm)); }
  }
  #undef NMV
  #define NMV(tn) (-mhat)
  #undef CMASK
  #define CMASK(P0,P1,t) do{int jb_=(t)-(NT-4); if(jb_>=0)cmask(P0,P1,jb_,qrel,hi); else bmask(P0,P1,(sel>>((t)>>2))&1u);}while(0)
  #define ENDW(tt) do{ if((tt)+3<NT){WAIT_BAR(2);} else if((tt)+2<NT){WAIT_BAR(1);} else {WAIT_BAR(0);} }while(0)
  for(;t+1<NT;t+=2){
    STEP(pB0,pB1,pA0,pA1,t,(t+3<NT),(t+1<NT),(t+1<NT));       ENDW(t);   RESC(); ROT();
    STEP(pA0,pA1,pB0,pB1,t+1,(t+4<NT),(t+2<NT),(t+2<NT));     ENDW(t+1); RESC(); ROT();
  }
  STEP(pB0,pB1,pA0,pA1,NT-1,false,false,false); RESC();
  { float sacc=pB0[0]+pB0[1]; _Pragma("unroll") for(int r=2;r<16;++r)sacc+=pB0[r]; _Pragma("unroll") for(int r=0;r<16;++r)sacc+=pB1[r]; l_reg+=sacc;
    pw0=(u32x4){PKW(pB0,0),PKW(pB0,2),PKW(pB0,4),PKW(pB0,6)};pw1=(u32x4){PKW(pB0,8),PKW(pB0,10),PKW(pB0,12),PKW(pB0,14)};pw2=(u32x4){PKW(pB1,0),PKW(pB1,2),PKW(pB1,4),PKW(pB1,6)};pw3=(u32x4){PKW(pB1,8),PKW(pB1,10),PKW(pB1,12),PKW(pB1,14)};
    SBAR(); pv(o,vb0+sl_cur,PAF(0),PAF(1),PAF(2),PAF(3)); }
  #undef PKW
  #undef PAF
  #undef VFR
  #undef PIN
  #undef MX3
  #undef GAPA
  #undef GAPB
  #undef EX
  #undef VRD
  #undef KRD
  #undef STEP
  #undef NMV
  #undef ENDW
  {auto rr=__builtin_amdgcn_permlane32_swap(__float_as_uint(l_reg),__float_as_uint(l_reg),false,false);l_reg=__uint_as_float(rr[0])+__uint_as_float(rr[1]);}
  if(hi==0)wsf[32+r32]=l_reg;asm volatile("s_waitcnt lgkmcnt(0)":::"memory");
  float rli[16];
  #pragma unroll
  for(int r=0;r<16;++r)rli[r]=__builtin_amdgcn_rcpf(wsf[32+crow(r,hi)]);
  bf16*Ow=O+(rowbase+q0+wid*QBLK)*DM+h*D;
  { bf16*stg=(bf16*)(shm+LDS_OST)+wid*2048;
    #pragma unroll
    for(int r=0;r<16;++r){const int orow=crow(r,hi);
      #pragma unroll
      for(int d0=0;d0<2;++d0)stg[orow*64+d0*32+r32]=__float2bfloat16(o[d0][r]*rli[r]);}
    asm volatile("s_waitcnt lgkmcnt(0)":::"memory");
    #pragma unroll
    for(int i=0;i<4;++i){const int row=i*8+(lane>>3),ch=lane&7; const u32x4 v=*(const u32x4*)(stg+row*64+ch*8); ATTN_STORE16(Ow+(long)row*DM+ch*8,v);} }
  asm volatile("s_waitcnt lgkmcnt(0)\n\ts_barrier":::"memory");
  #undef DMA_K
  #undef DMA_V
  #undef CMASK
  #undef START
  #undef RESC
  #undef ROT
}
constexpr int ATTN_LDS_BYTES=LDS_BYTES;
struct AttnTensors { const bf16* Q; const bf16* K; const bf16* V; bf16* O; const float* KM; };
struct AttnUnit { int bh; int qb; };
struct StaticOrder {
  int vcu,grid;
  __device__ __forceinline__ explicit StaticOrder(int grid_,int block):vcu((grid_%8==0)?(block%8)*(grid_/8)+block/8:block),grid(grid_){}
  __device__ __forceinline__ bool next(int i,AttnUnit&u)const{
    if(grid==256){ if(i>=4)return false; const int s=vcu&3; u.bh=vcu>>2; u.qb=(i==0)?s:(i==1)?7-s:(i==2)?8+s:15-s; return true; }
    const int L=vcu+i*grid; if(L>=BATCH*NHEAD*NQB)return false; u.bh=L/NQB; u.qb=L%NQB; return true; }
  __device__ __forceinline__ void a_ready(const AttnUnit&)const{}
  __device__ __forceinline__ void done(const AttnUnit&)const{}
};
template<class Sched,int THRL=8> __device__ __forceinline__ void attn_phase(char*lds,const AttnTensors&T,const Sched&S,const int wave_){
  AttnUnit u;
  for(int i=0;S.next(i,u);++i){ S.a_ready(u); attn_unit<THRL>(u.bh/NHEAD,u.bh%NHEAD,u.qb,T.Q,T.K,T.V,T.O,T.KM,lds,wave_); S.done(u); }
}
#undef SBAR
#undef WAIT_BAR
}

constexpr int NWAVES = 8;
constexpr int BATCH = 8, SEQ = 4096, D = 1024, M = BATCH * SEQ;
constexpr int NPROJ = 7680, FF = 3584, NEXP = 8;
constexpr int PW = pg8::PW;
constexpr int MAXSLOT = 2 * M + NEXP * 256;
constexpr float RMS_EPS = 1e-6f;

constexpr size_t MiB = 1u << 20;
constexpr size_t WS_CTL = 0, CTL_ZERO_BYTES = 1 * MiB;
constexpr size_t WS_TAB = 1 * MiB;
constexpr size_t WS_KMEAN = 2 * MiB;
constexpr size_t WS_TOKE = WS_KMEAN + 256 * 1024;
constexpr size_t WS_TOKIDX = WS_TOKE + 128 * 1024;
constexpr size_t WS_TOKP = WS_TOKIDX + 256 * 1024;
constexpr size_t WS_TOKOF = WS_TOKP + 128 * 1024;
constexpr size_t WS_PWOF = WS_TOKOF + (size_t)MAXSLOT * 4;
static_assert(WS_PWOF + (size_t)MAXSLOT * 4 <= 4 * MiB, "small tables");
constexpr size_t WS_WIN = 4 * MiB, WS_WG8 = 13 * MiB, WS_WBR = 19 * MiB, WS_WOUT = 22 * MiB;
constexpr size_t WS_H = 24 * MiB;
constexpr size_t WS_KVT = WS_H, WS_ST = WS_H + 32 * MiB;
constexpr size_t WS_W1 = 88 * MiB, WS_W2 = 102 * MiB;
constexpr size_t WS_P = 109 * MiB;
constexpr size_t WS_HN8 = 461 * MiB;
constexpr size_t WS_ACT = WS_P;
constexpr size_t WS_MW1 = 4 * MiB, WS_MW2 = 60 * MiB;
constexpr size_t OUT_H8 = 0, OUT_XG = 32 * MiB;
constexpr size_t WS_ACTM = 186 * MiB;
constexpr size_t WS_Y0 = 88 * MiB, WS_Y1 = 417 * MiB;
constexpr size_t WS_XB = 496 * MiB;
constexpr size_t WS_END = 562 * MiB;
static_assert(WS_P + (size_t)M * PW * 2 <= WS_HN8 && WS_HN8 + (size_t)M * D <= WS_XB && WS_XB + (size_t)M * D * 2 <= WS_END && WS_Y1 + (size_t)M * D * 2 <= WS_XB && WS_ACTM + (size_t)MAXSLOT * FF <= WS_Y1
              && WS_Y0 + (size_t)M * D * 2 <= WS_ACTM && WS_MW2 + (size_t)NEXP * D * FF <= WS_Y0 && WS_MW1 + (size_t)NEXP * 2 * FF * D <= WS_MW2 && OUT_H8 + (size_t)M * D <= OUT_XG && OUT_XG + (size_t)MAXSLOT * D <= (size_t)M * D * 4, "d_ws / d_out map");
constexpr int CW_BAR = 4096;
constexpr int CW_DEP = 65536;
constexpr int CW_CNT = 16384;

constexpr int RING_OFF = 0, RING_BYTES = 131072;
constexpr int LDSCTL_OFF = RING_BYTES, MISC_OFF = LDSCTL_OFF + 320;
constexpr int LDS_BYTES = 147456;

#define GAS __attribute__((address_space(1)))
#define LAS __attribute__((address_space(3)))
typedef unsigned short bf16;
typedef unsigned v4u __attribute__((ext_vector_type(4)));
typedef unsigned v2u __attribute__((ext_vector_type(2)));
typedef float f32x4 __attribute__((ext_vector_type(4)));
typedef short bf16x8 __attribute__((ext_vector_type(8)));
typedef short s16x4 __attribute__((ext_vector_type(4)));
typedef GAS unsigned gu32;
#define RLX_AGENT __ATOMIC_RELAXED, __HIP_MEMORY_SCOPE_AGENT
#define LDS_WAIT() asm volatile("s_waitcnt lgkmcnt(0)" ::: "memory")
__device__ __forceinline__ unsigned f2bf(float f) { unsigned u = __builtin_bit_cast(unsigned, f); return (u + 0x7fffu + ((u >> 16) & 1u)) >> 16; }
__device__ __forceinline__ unsigned pk2(float lo, float hi) { return f2bf(lo) | (f2bf(hi) << 16); }
__device__ __forceinline__ float bflo(unsigned w) { return __builtin_bit_cast(float, w << 16); }
__device__ __forceinline__ float bfhi(unsigned w) { return __builtin_bit_cast(float, w & 0xffff0000u); }

#define XB_TMO      128
#define XB_XCNT(j)  (256  + 64 * (j))
#define XB_XSUB(j)  (1280 + 64 * (j))
#define XB_XGEN(j)  (2304 + 64 * (j))
#define XB_TOP      3328
#define XB_TOPGEN   3392
#define XCD_BAR_WORDS 3456
#define XB_SPIN_CAP (1u << 18)
__device__ __forceinline__ unsigned xb_ld(unsigned* p)              { return __hip_atomic_load(p, __ATOMIC_RELAXED, __HIP_MEMORY_SCOPE_AGENT); }
__device__ __forceinline__ unsigned xb_add(unsigned* p, unsigned v) { return __hip_atomic_fetch_add(p, v, __ATOMIC_RELAXED, __HIP_MEMORY_SCOPE_AGENT); }
__device__ __forceinline__ unsigned xb_xcc_id() { return (unsigned)__builtin_amdgcn_s_getreg((3 << 11) | 20) & 0xFu; }
#define XB_SPIN(cond, bar) do { unsigned _sp = 0; while (cond) { __builtin_amdgcn_s_sleep(1); \
    if ((++_sp & 255u) == 0u) { if (xb_ld(&(bar)[XB_TMO])) break; if (_sp > XB_SPIN_CAP) { atomicAdd(&(bar)[XB_TMO], 1u); break; } } } } while (0)
struct XcdBarrier { unsigned* bar; unsigned x; volatile LAS unsigned* st; };
__device__ __forceinline__ XcdBarrier xcd_barrier_post(unsigned* bar, volatile LAS unsigned* st) {
    XcdBarrier b; b.bar = bar; b.x = xb_xcc_id(); b.st = st;
    if (threadIdx.x == 0) (void)xb_add(&bar[XB_XCNT(b.x)], 1u);
    return b;
}
__device__ __forceinline__ void xcd_barrier_complete(unsigned* bar, unsigned x, unsigned& nloc, unsigned& nx) {
    const unsigned G = gridDim.x * gridDim.y * gridDim.z;
    unsigned sum, cnt, mine, sp = 0u;
    for (;;) {
        sum = 0u; cnt = 0u; mine = 0u;
#pragma unroll
        for (unsigned j = 0; j < 16; ++j) { const unsigned c = xb_ld(&bar[XB_XCNT(j)]); sum += c; cnt += (c > 0u) ? 1u : 0u; mine = (j == x) ? c : mine; }
        if (sum == G) break;
        __builtin_amdgcn_s_sleep(1);
        if ((++sp & 255u) == 0u) { if (xb_ld(&bar[XB_TMO])) break; if (sp > XB_SPIN_CAP) { atomicAdd(&bar[XB_TMO], 1u); break; } }
    }
    nloc = mine > 0u ? mine : 1u; nx = cnt > 0u ? cnt : 1u;
}
__device__ __forceinline__ void xcd_barrier(const XcdBarrier& b) {
    asm volatile("s_waitcnt vmcnt(0)" ::: "memory");
    __syncthreads();
    if (threadIdx.x == 0) {
        unsigned* bar = b.bar;
        __builtin_amdgcn_s_waitcnt(0);
        unsigned nloc = b.st[0], nx = b.st[1];
        if (nloc == 0u) { xcd_barrier_complete(bar, b.x, nloc, nx); b.st[0] = nloc; b.st[1] = nx; }
        const unsigned old = xb_add(&bar[XB_XSUB(b.x)], 1u);
        const unsigned gen = old / nloc;
        if (old + 1u == (gen + 1u) * nloc) {
            __builtin_amdgcn_fence(__ATOMIC_RELEASE, "agent");
            asm volatile("s_waitcnt vmcnt(0)" ::: "memory");
            const unsigned og = xb_add(&bar[XB_TOP], 1u);
            const unsigned tg = og / nx;
            if (og + 1u == (tg + 1u) * nx) xb_add(&bar[XB_TOPGEN], 1u);
            else XB_SPIN(xb_ld(&bar[XB_TOPGEN]) == tg, bar);
            __builtin_amdgcn_fence(__ATOMIC_ACQUIRE, "agent");
            xb_add(&bar[XB_XGEN(b.x)], 1u);
            asm volatile("s_waitcnt vmcnt(0)" ::: "memory");
        } else {
            XB_SPIN(xb_ld(&bar[XB_XGEN(b.x)]) == gen, bar);
            __builtin_amdgcn_fence(__ATOMIC_ACQUIRE, "agent");
            asm volatile("s_waitcnt vmcnt(0)" ::: "memory");
        }
    }
    __syncthreads();
}

struct Frame {
    LAS unsigned char* lds;
    volatile LAS unsigned* MISC;
    gu32* ctl;
    int tid, lane, wave;
    int vcu, G;
    GAS unsigned char* ws;
    GAS unsigned char* outb;
};

__device__ __forceinline__ float shx(float v, int mask, int lane) { return __builtin_bit_cast(float, __builtin_amdgcn_ds_bpermute((lane ^ mask) << 2, __builtin_bit_cast(int, v))); }
template <int CTRL> __device__ __forceinline__ float dpp_f(float v) { return __builtin_bit_cast(float, __builtin_amdgcn_update_dpp(0, __builtin_bit_cast(int, v), CTRL, 0xf, 0xf, false)); }
__device__ __forceinline__ float wave_sum(float v, int lane) {
    (void)lane;
    v += dpp_f<0xB1>(v); v += dpp_f<0x4E>(v); v += dpp_f<0x124>(v); v += dpp_f<0x128>(v);
    const int iv = __builtin_bit_cast(int, v);
    const float r0 = __builtin_bit_cast(float, __builtin_amdgcn_readlane(iv, 0)), r1 = __builtin_bit_cast(float, __builtin_amdgcn_readlane(iv, 16)), r2 = __builtin_bit_cast(float, __builtin_amdgcn_readlane(iv, 32)), r3 = __builtin_bit_cast(float, __builtin_amdgcn_readlane(iv, 48));
    return (r0 + r1) + (r2 + r3);
}

__device__ __forceinline__ unsigned pk_fp8(float a, float b, float c, float d) { return pg8::pk_fp8x4(a, b, c, d); }
template <int KIND>
__device__ __forceinline__ const float* convert_src(const float* W, const float* W2, int Nsrc, int ndb, int scol_off, int db_off, int it, int lane) {
    const int kb = it / ndb, db = it % ndb + db_off; const float* src = W; int scol;
    if (KIND == 0) scol = 32 * db;
    else if (KIND == 1) { const int pn = db >> 3, blk = db & 7, bj = blk >> 2, wc = blk & 3;
        if (pn < 4 || pn == 12 || pn == 13) scol = 256 * pn + 64 * wc + 32 * bj;
        else if (pn >= 8 && pn < 12) scol = (bj ? 2560 : 2048) + 128 * (pn - 8) + 32 * wc;
        else scol = 32 * db; }
    else { const int t = db >> 3, blk = db & 7, bj = blk >> 2, wc = blk & 3; src = bj ? W2 : W; scol = 128 * t + 32 * wc; }
    return src + (size_t)(64 * kb + (lane >> 5)) * Nsrc + scol + scol_off + (lane & 31);
}
template <int KIND, bool FP8 = false>
__device__ __forceinline__ void convert_matrix(Frame& F, const float* W, const float* W2, int K, int Nsrc, void* WT, int ndb, const float* kgain = nullptr, int scol_off = 0, int db_off = 0) {
    LAS float* scr = (LAS float*)(F.lds + RING_OFF + F.wave * 16384);
    const int gw = F.vcu * NWAVES + F.wave, NGW = F.G * NWAVES, nitems = (K / 64) * ndb, lane = F.lane;
    const size_t rs = (size_t)2 * Nsrc;
    float cur[32], nxt[32];
    if (gw < nitems) { const float* p = convert_src<KIND>(W, W2, Nsrc, ndb, scol_off, db_off, gw, lane);
#pragma unroll
        for (int i = 0; i < 32; ++i) cur[i] = p[i * rs]; }
    for (int it = gw; it < nitems; it += NGW) {
        const int itn = it + NGW;
        if (itn < nitems) { const float* p = convert_src<KIND>(W, W2, Nsrc, ndb, scol_off, db_off, itn, lane);
#pragma unroll
            for (int i = 0; i < 32; ++i) nxt[i] = p[i * rs]; }
        const int kb = it / ndb, dbl = it % ndb, k0 = 64 * kb, drow0 = 32 * dbl;
#pragma unroll
        for (int i = 0; i < 32; ++i) scr[(2 * i + (lane >> 5)) * 33 + (lane & 31)] = FP8 ? cur[i] * 32.0f : cur[i];
        LDS_WAIT(); asm volatile("" ::: "memory");
        if (FP8) { const int c = lane & 3;
#pragma unroll
            for (int j = 0; j < 2; ++j) { const int n = (lane >> 2) + 16 * j; const LAS float* s = scr + (16 * c) * 33 + n;
                v4u o; o.x = pk_fp8(s[0 * 33], s[1 * 33], s[2 * 33], s[3 * 33]); o.y = pk_fp8(s[4 * 33], s[5 * 33], s[6 * 33], s[7 * 33]);
                o.z = pk_fp8(s[8 * 33], s[9 * 33], s[10 * 33], s[11 * 33]); o.w = pk_fp8(s[12 * 33], s[13 * 33], s[14 * 33], s[15 * 33]);
                *(GAS v4u*)((unsigned char*)WT + (size_t)(drow0 + n) * K + k0 + 16 * c) = o; } }
        else { const int c = lane & 7;
#pragma unroll
            for (int j = 0; j < 4; ++j) { const int n = (lane >> 3) + 8 * j; const LAS float* s = scr + (8 * c) * 33 + n;
                v4u o; o.x = pk2(s[0 * 33], s[1 * 33]); o.y = pk2(s[2 * 33], s[3 * 33]); o.z = pk2(s[4 * 33], s[5 * 33]); o.w = pk2(s[6 * 33], s[7 * 33]);
                *(GAS v4u*)((bf16*)WT + (size_t)(drow0 + n) * K + k0 + 8 * c) = o; } }
        LDS_WAIT(); asm volatile("" ::: "memory");
#pragma unroll
        for (int i = 0; i < 32; ++i) cur[i] = nxt[i];
    }
}
struct CItem { const float* p; size_t rs; unsigned char* dst; int K; bool fp8; };
template <int KIND>
__device__ __forceinline__ CItem conv_item(const float* W, const float* W2, int K, int Nsrc, void* WT, int ndb, int scol_off, int db_off, bool fp8, int it, int lane) {
    CItem c; c.p = convert_src<KIND>(W, W2, Nsrc, ndb, scol_off, db_off, it, lane); c.rs = (size_t)2 * Nsrc; c.K = K; c.fp8 = fp8;
    const int kb = it / ndb, dbl = it % ndb; c.dst = (unsigned char*)WT + ((size_t)(32 * dbl) * K + 64 * kb) * (fp8 ? 1 : 2); return c; }
template <class Dec>
__device__ __forceinline__ void convert_flat(Frame& F, const int nitems, const Dec& dec) {
    LAS float* scr = (LAS float*)(F.lds + RING_OFF + F.wave * 16384);
    const int gw = F.vcu * NWAVES + F.wave, NGW = F.G * NWAVES, lane = F.lane;
    float cur[32], nxt[32]; CItem ci, ni; ci.p = nullptr; ci.rs = 0; ci.dst = nullptr; ci.K = 0; ci.fp8 = false; ni = ci;
    if (gw < nitems) { ci = dec(gw, lane);
#pragma unroll
        for (int i = 0; i < 32; ++i) cur[i] = ci.p[i * ci.rs]; }
    for (int it = gw; it < nitems; it += NGW) {
        const int itn = it + NGW;
        if (itn < nitems) { ni = dec(itn, lane);
#pragma unroll
            for (int i = 0; i < 32; ++i) nxt[i] = ni.p[i * ni.rs]; }
        const float sc = ci.fp8 ? 32.0f : 1.0f;
#pragma unroll
        for (int i = 0; i < 32; ++i) scr[(2 * i + (lane >> 5)) * 33 + (lane & 31)] = cur[i] * sc;
        LDS_WAIT(); asm volatile("" ::: "memory");
        if (ci.fp8) { const int c = lane & 3;
#pragma unroll
            for (int j = 0; j < 2; ++j) { const int n = (lane >> 2) + 16 * j; const LAS float* s = scr + (16 * c) * 33 + n;
                v4u o; o.x = pk_fp8(s[0 * 33], s[1 * 33], s[2 * 33], s[3 * 33]); o.y = pk_fp8(s[4 * 33], s[5 * 33], s[6 * 33], s[7 * 33]);
                o.z = pk_fp8(s[8 * 33], s[9 * 33], s[10 * 33], s[11 * 33]); o.w = pk_fp8(s[12 * 33], s[13 * 33], s[14 * 33], s[15 * 33]);
                *(GAS v4u*)(ci.dst + (size_t)n * ci.K + 16 * c) = o; } }
        else { const int c = lane & 7;
#pragma unroll
            for (int j = 0; j < 4; ++j) { const int n = (lane >> 3) + 8 * j; const LAS float* s = scr + (8 * c) * 33 + n;
                v4u o; o.x = pk2(s[0 * 33], s[1 * 33]); o.y = pk2(s[2 * 33], s[3 * 33]); o.z = pk2(s[4 * 33], s[5 * 33]); o.w = pk2(s[6 * 33], s[7 * 33]);
                *(GAS v4u*)(ci.dst + ((size_t)n * ci.K + 8 * c) * 2) = o; } }
        LDS_WAIT(); asm volatile("" ::: "memory");
#pragma unroll
        for (int i = 0; i < 32; ++i) cur[i] = nxt[i];
        ci = ni;
    }
}
__device__ __forceinline__ const float* arg_in(int i) {
    int off = i * 8; asm volatile("" : "+s"(off));
    const char __attribute__((address_space(4)))* ka = (const char __attribute__((address_space(4)))*)__builtin_amdgcn_kernarg_segment_ptr();
    return (const float*)(const GAS float*)*(const float* const __attribute__((address_space(4)))*)(ka + off);
}
template <bool WITH_DENSE>
__device__ __forceinline__ void convert_mixer_weights_flat(Frame& F, int layer) {
    const float* win = arg_in(2) + (size_t)layer * D * NPROJ; const float* wb0 = arg_in(6) + (size_t)layer * 512 * D; const float* wb1 = arg_in(7) + (size_t)layer * 512 * D; const float* wb2 = arg_in(8) + (size_t)layer * 512 * D;
    const float* wo = arg_in(9) + (size_t)layer * D * D; const float* w1g = WITH_DENSE ? arg_in(11) : nullptr; const float* w1u = WITH_DENSE ? arg_in(12) : nullptr; const float* w2 = WITH_DENSE ? arg_in(13) : nullptr;
    GAS unsigned char* ws = F.ws;
    constexpr int NA = 16 * 96, NB = 16 * 48, NC = 16 * 96, NBR = 8 * 32, NO = 16 * 32, N1 = 16 * (2 * FF / 32), N2 = (FF / 64) * 32;
    constexpr int E0 = NA, E1 = E0 + NB, E2 = E1 + NC, E3 = E2 + NBR, E4 = E3 + NBR, E5 = E4 + NBR, E6 = E5 + NO, E7 = E6 + N1, E8 = E7 + N2;
    convert_flat(F, WITH_DENSE ? E8 : E6, [=](int it, int lane) -> CItem {
        if (it < E0) return conv_item<1>(win, nullptr, D, NPROJ, (void*)(ws + WS_WIN), 3072 / 32, 0, 48, false, it, lane);
        if (it < E1) return conv_item<1>(win, nullptr, D, NPROJ, (void*)(ws + WS_WG8), 1536 / 32, 0, 0, true, it - E0, lane);
        if (it < E2) return conv_item<0>(win, nullptr, D, NPROJ, (void*)(ws + WS_WG8 + (size_t)1536 * D), 3072 / 32, 4608, 0, true, it - E1, lane);
        if (it < E3) return conv_item<0>(wb0, nullptr, 512, D, (void*)(ws + WS_WBR), D / 32, 0, 0, false, it - E2, lane);
        if (it < E4) return conv_item<0>(wb1, nullptr, 512, D, (void*)(ws + WS_WBR + (size_t)D * 512 * 2), D / 32, 0, 0, false, it - E3, lane);
        if (it < E5) return conv_item<0>(wb2, nullptr, 512, D, (void*)(ws + WS_WBR + (size_t)2 * D * 512 * 2), D / 32, 0, 0, false, it - E4, lane);
        if (it < E6) return conv_item<0>(wo, nullptr, D, D, (void*)(ws + WS_WOUT), D / 32, 0, 0, false, it - E5, lane);
        if (it < E7) return conv_item<2>(w1g, w1u, D, FF, (void*)(ws + WS_W1), 2 * FF / 32, 0, 0, UP_FP8, it - E6, lane);
        return conv_item<0>(w2, nullptr, FF, D, (void*)(ws + WS_W2), D / 32, 0, 0, DOWN_FP8, it - E7, lane); });
}
__device__ __forceinline__ void convert_mixer_weights(Frame& F, int layer) {
    convert_matrix<1>(F, arg_in(2) + (size_t)layer * D * NPROJ, nullptr, D, NPROJ, (bf16*)(F.ws + WS_WIN), 3072 / 32, nullptr, 0, 48);
    convert_matrix<1, true>(F, arg_in(2) + (size_t)layer * D * NPROJ, nullptr, D, NPROJ, (unsigned char*)(F.ws + WS_WG8), 1536 / 32);
    convert_matrix<0, true>(F, arg_in(2) + (size_t)layer * D * NPROJ, nullptr, D, NPROJ, (unsigned char*)(F.ws + WS_WG8) + (size_t)1536 * D, 3072 / 32, nullptr, 4608);
    convert_matrix<0>(F, arg_in(6) + (size_t)layer * 512 * D, nullptr, 512, D, (bf16*)(F.ws + WS_WBR), D / 32);
    convert_matrix<0>(F, arg_in(7) + (size_t)layer * 512 * D, nullptr, 512, D, (bf16*)(F.ws + WS_WBR) + (size_t)D * 512, D / 32);
    convert_matrix<0>(F, arg_in(8) + (size_t)layer * 512 * D, nullptr, 512, D, (bf16*)(F.ws + WS_WBR) + (size_t)2 * D * 512, D / 32);
    convert_matrix<0>(F, arg_in(9) + (size_t)layer * D * D, nullptr, D, D, (bf16*)(F.ws + WS_WOUT), D / 32);
}

__constant__ float c_inv_freq[32] = {1.000000000e+00f, 7.498942018e-01f, 5.623413324e-01f, 4.216965139e-01f, 3.162277639e-01f, 2.371373922e-01f, 1.778279394e-01f, 1.333521456e-01f,
    1.000000015e-01f, 7.498941571e-02f, 5.623412877e-02f, 4.216964915e-02f, 3.162277862e-02f, 2.371373586e-02f, 1.778279431e-02f, 1.333521493e-02f,
    9.999999776e-03f, 7.498942316e-03f, 5.623413250e-03f, 4.216964822e-03f, 3.162277862e-03f, 2.371373819e-03f, 1.778279431e-03f, 1.333521446e-03f,
    1.000000047e-03f, 7.498941850e-04f, 5.623413017e-04f, 4.216965463e-04f, 3.162277862e-04f, 2.371373848e-04f, 1.778279402e-04f, 1.333521504e-04f};
__device__ __forceinline__ void rope_table(Frame& F) {
    float* cs = (float*)(F.ws + WS_TAB);
    for (int idx = F.vcu * 512 + F.tid; idx < 4096 * 32; idx += F.G * 512) {
        const int pos = idx >> 5, i = idx & 31;
        const float ang = (float)pos * c_inv_freq[i];
        const double rev = (double)ang * 0.15915494309189535; const double fr = rev - __builtin_rint(rev);
        const float f = (float)fr;
        cs[pos * 64 + i] = __builtin_amdgcn_cosf(f); cs[pos * 64 + 32 + i] = __builtin_amdgcn_sinf(f);
    }
}

template <int F8 = 0, bool X16 = false>
__device__ __forceinline__ void norm_rows(Frame& F, const void* xv, const float* gain, void* outv, unsigned char* out8 = nullptr) {
    const float* x = (const float*)xv;
    bf16* out = (bf16*)outv;
    const int gw = F.vcu * NWAVES + F.wave, NGW = F.G * NWAVES;
    f32x4 gv[4];
#pragma unroll
    for (int j = 0; j < 4; ++j) gv[j] = *((const f32x4*)gain + F.lane + 64 * j);
    for (int m0 = gw; m0 < M; m0 += 4 * NGW) {
        f32x4 v[4][4];
        if constexpr (X16) { v2u w[4][4];
#pragma unroll
            for (int q = 0; q < 4; ++q) { const int m = m0 + q * NGW; const GAS v2u* xr = (const GAS v2u*)((const bf16*)xv + (size_t)(m < M ? m : m0) * D) + F.lane;
#pragma unroll
                for (int j = 0; j < 4; ++j) w[q][j] = xr[64 * j]; }
#pragma unroll
            for (int q = 0; q < 4; ++q)
#pragma unroll
                for (int j = 0; j < 4; ++j) v[q][j] = (f32x4){bflo(w[q][j].x), bfhi(w[q][j].x), bflo(w[q][j].y), bfhi(w[q][j].y)};
        } else {
#pragma unroll
        for (int q = 0; q < 4; ++q) { const int m = m0 + q * NGW; const GAS f32x4* xr = (const GAS f32x4*)(x + (size_t)(m < M ? m : m0) * D) + F.lane;
#pragma unroll
            for (int j = 0; j < 4; ++j) v[q][j] = xr[64 * j]; }
        }
#pragma unroll
        for (int q = 0; q < 4; ++q) { const int m = m0 + q * NGW; if (m >= M) break;
            float s = 0.f;
#pragma unroll
            for (int j = 0; j < 4; ++j) s += (v[q][j].x * v[q][j].x + v[q][j].y * v[q][j].y) + (v[q][j].z * v[q][j].z + v[q][j].w * v[q][j].w);
            const float r = 1.0f / sqrtf(wave_sum(s, F.lane) * (1.f / D) + RMS_EPS);
            if (F8) { GAS unsigned* o4 = (GAS unsigned*)(out8 + (size_t)m * D) + F.lane;
#pragma unroll
                for (int j = 0; j < 4; ++j) o4[64 * j] = pk_fp8(v[q][j].x * r * gv[j].x, v[q][j].y * r * gv[j].y, v[q][j].z * r * gv[j].z, v[q][j].w * r * gv[j].w); }
            if (F8 != 2) { GAS v2u* o8 = (GAS v2u*)(out + (size_t)m * D) + F.lane;
#pragma unroll
                for (int j = 0; j < 4; ++j) { v2u w; w.x = pk2(v[q][j].x * r * gv[j].x, v[q][j].y * r * gv[j].y); w.y = pk2(v[q][j].z * r * gv[j].z, v[q][j].w * r * gv[j].w); o8[64 * j] = w; } }
        }
    }
}
__device__ __forceinline__ void final_norm(Frame& F, const bf16* xb, float* outp, const float* gain, const bf16* Y0, const bf16* Y1) {
    const int gw = F.vcu * NWAVES + F.wave, NGW = F.G * NWAVES;
    f32x4 gv[4];
#pragma unroll
    for (int j = 0; j < 4; ++j) gv[j] = *((const f32x4*)gain + F.lane + 64 * j);
    for (int m0 = gw; m0 < M; m0 += 4 * NGW) {
        v2u xw[4][4], y0[4][4], y1[4][4];
#pragma unroll
        for (int q = 0; q < 4; ++q) { const int m = m0 + q * NGW; const size_t ro = (size_t)(m < M ? m : m0) * D;
#pragma unroll
            for (int j = 0; j < 4; ++j) { xw[q][j] = *((const GAS v2u*)(xb + ro) + F.lane + 64 * j); y0[q][j] = *((const GAS v2u*)(Y0 + ro) + F.lane + 64 * j); y1[q][j] = *((const GAS v2u*)(Y1 + ro) + F.lane + 64 * j); } }
#pragma unroll
        for (int q = 0; q < 4; ++q) { const int m = m0 + q * NGW; if (m >= M) break;
            GAS f32x4* orow = (GAS f32x4*)(outp + (size_t)m * D) + F.lane; float s = 0.f; f32x4 v[4];
#pragma unroll
            for (int j = 0; j < 4; ++j) { f32x4& w = v[j];
                w.x = bflo(xw[q][j].x) + (bflo(y0[q][j].x) + bflo(y1[q][j].x)); w.y = bfhi(xw[q][j].x) + (bfhi(y0[q][j].x) + bfhi(y1[q][j].x));
                w.z = bflo(xw[q][j].y) + (bflo(y0[q][j].y) + bflo(y1[q][j].y)); w.w = bfhi(xw[q][j].y) + (bfhi(y0[q][j].y) + bfhi(y1[q][j].y));
                s += (w.x * w.x + w.y * w.y) + (w.z * w.z + w.w * w.w); }
            const float r = 1.0f / sqrtf(wave_sum(s, F.lane) * (1.f / D) + RMS_EPS);
#pragma unroll
            for (int j = 0; j < 4; ++j) orow[64 * j] = v[j] * r * gv[j];
        }
    }
}

__device__ __forceinline__ void kmean_phase(Frame& F, const bf16* P) {
    const int gw = F.vcu * NWAVES + F.wave, NGW = F.G * NWAVES;
    float* KM = (float*)(F.ws + WS_KMEAN);
    for (int it = gw; it < 64 * 16; it += NGW) {
        const int bh = it >> 4, blk = it & 15, b = bh >> 3, h = bh & 7;
        const bf16* base = P + (size_t)(b * SEQ + blk * 256 + (F.lane >> 3)) * PW + pg8::PC_K + h * 64 + (F.lane & 7) * 8;
        float a[8];
#pragma unroll
        for (int j = 0; j < 8; ++j) a[j] = 0.f;
        v4u wv[32];
#pragma unroll
        for (int i = 0; i < 32; ++i) wv[i] = *(const GAS v4u*)(base + (size_t)i * 8 * PW);
#pragma unroll
        for (int i = 0; i < 32; ++i) { const v4u w = wv[i];
            a[0] += bflo(w.x); a[1] += bfhi(w.x); a[2] += bflo(w.y); a[3] += bfhi(w.y); a[4] += bflo(w.z); a[5] += bfhi(w.z); a[6] += bflo(w.w); a[7] += bfhi(w.w); }
#pragma unroll
        for (int j = 0; j < 8; ++j) { a[j] += shx(a[j], 8, F.lane); a[j] += shx(a[j], 16, F.lane); a[j] += shx(a[j], 32, F.lane); }
        if (F.lane < 8) { float* o = KM + (size_t)it * 64 + F.lane * 8;
#pragma unroll
            for (int j = 0; j < 8; ++j) o[j] = a[j] * (1.f / 256.f); }
    }
}

__device__ __forceinline__ void conv_phase(Frame& F, bf16* P, const float* cw, const float* cbias) {
    const int gw = F.vcu * NWAVES + F.wave, NGW = F.G * NWAVES, c0 = F.lane * 8;
    float w0[8], w1[8], w2[8], bb[8];
#pragma unroll
    for (int j = 0; j < 8; ++j) { w0[j] = cw[c0 + j]; w1[j] = cw[512 + c0 + j]; w2[j] = cw[1024 + c0 + j]; bb[j] = cbias[c0 + j]; }
    for (int run = gw; run < M / 8; run += NGW) {
        const int m0 = run * 8, t0 = m0 & (SEQ - 1);
        v4u cb[8], u[10];
        u[0] = (v4u){0u, 0u, 0u, 0u}; u[1] = (v4u){0u, 0u, 0u, 0u};
        if (t0 >= 2) { u[0] = *(const GAS v4u*)(P + (size_t)(m0 - 2) * PW + pg8::PC_U + c0); u[1] = *(const GAS v4u*)(P + (size_t)(m0 - 1) * PW + pg8::PC_U + c0); }
#pragma unroll
        for (int q = 0; q < 8; ++q) { const bf16* rp = P + (size_t)(m0 + q) * PW; cb[q] = *(const GAS v4u*)(rp + pg8::PC_CB + c0); u[q + 2] = *(const GAS v4u*)(rp + pg8::PC_U + c0); }
        asm volatile("" ::: "memory");
#pragma unroll
        for (int q = 0; q < 8; ++q) {
            float y[8];
            const unsigned cbw[4] = {cb[q].x, cb[q].y, cb[q].z, cb[q].w}, a2[4] = {u[q + 2].x, u[q + 2].y, u[q + 2].z, u[q + 2].w}, a1[4] = {u[q + 1].x, u[q + 1].y, u[q + 1].z, u[q + 1].w}, a0[4] = {u[q].x, u[q].y, u[q].z, u[q].w};
#pragma unroll
            for (int k = 0; k < 4; ++k) {
                y[2 * k] = bflo(cbw[k]) * (w0[2 * k] * bflo(a0[k]) + w1[2 * k] * bflo(a1[k]) + w2[2 * k] * bflo(a2[k]) + bb[2 * k]);
                y[2 * k + 1] = bfhi(cbw[k]) * (w0[2 * k + 1] * bfhi(a0[k]) + w1[2 * k + 1] * bfhi(a1[k]) + w2[2 * k + 1] * bfhi(a2[k]) + bb[2 * k + 1]); }
            v4u o; o.x = pk2(y[0], y[1]); o.y = pk2(y[2], y[3]); o.z = pk2(y[4], y[5]); o.w = pk2(y[6], y[7]);
            *(GAS v4u*)(P + (size_t)(m0 + q) * PW + pg8::PC_CB + c0) = o; }
    }
}

__device__ __forceinline__ float ret_lg2(int h) { return h == 0 ? -0.04580368961312479f : (h == 1 ? -0.02272007650008353f : (h == 2 ? -0.011315313227834146f : -0.005646563141142063f)); }
constexpr int RT_QS = 0, RT_KS = 18432, RT_VT = 36864, RT_KZT = 36864 + 34816, RT_ST = RT_KZT;
__device__ __forceinline__ void ret_kv_phase(Frame& F, const bf16* P) {
    LAS bf16* vT = (LAS bf16*)(F.lds + RT_VT); LAS bf16* kzT = (LAS bf16*)(F.lds + RT_KZT);
    float* KVt = (float*)(F.ws + WS_KVT);
    const int fr = F.lane & 15, quad = F.lane >> 4;
    v4u pv[4], pk[2];
#define RKV_LOAD(unit_) do { const int bh_ = (unit_) >> 5, ch_ = (unit_) & 31, b_ = bh_ >> 2, h_ = bh_ & 3; const size_t r0_ = (size_t)b_ * SEQ + ch_ * 128; \
        _Pragma("unroll") for (int i = 0; i < 4; ++i) { const int p = F.tid + 512 * i, mrow = p & 127, c = p >> 7; pv[i] = *(const GAS v4u*)(P + (r0_ + mrow) * PW + pg8::PC_RV + h_ * 128 + c * 8); } \
        _Pragma("unroll") for (int i = 0; i < 2; ++i) { const int p = F.tid + 512 * i, mrow = p & 127, c = p >> 7; pk[i] = *(const GAS v4u*)(P + (r0_ + mrow) * PW + pg8::PC_RK + h_ * 64 + c * 8); } } while (0)
    if (F.vcu < 32 * 32) RKV_LOAD(F.vcu);
    for (int unit = F.vcu; unit < 32 * 32; unit += F.G) {
        const int bh = unit >> 5, h = bh & 3; const float lg = ret_lg2(h);
#pragma unroll
        for (int i = 0; i < 4; ++i) { const int p = F.tid + 512 * i, mrow = p & 127, c = p >> 7;
            const v4u w = pv[i]; const unsigned ww[4] = {w.x, w.y, w.z, w.w};
#pragma unroll
            for (int q = 0; q < 4; ++q) { vT[(c * 8 + 2 * q) * 136 + mrow] = (bf16)(ww[q] & 0xffffu); vT[(c * 8 + 2 * q + 1) * 136 + mrow] = (bf16)(ww[q] >> 16); } }
#pragma unroll
        for (int i = 0; i < 2; ++i) { const int p = F.tid + 512 * i, mrow = p & 127, c = p >> 7;
            const v4u w = pk[i]; const unsigned ww[4] = {w.x, w.y, w.z, w.w};
            const float zeta = __builtin_amdgcn_exp2f((float)(127 - mrow) * lg);
#pragma unroll
            for (int q = 0; q < 4; ++q) { kzT[(c * 8 + 2 * q) * 136 + mrow] = (bf16)f2bf(bflo(ww[q]) * zeta); kzT[(c * 8 + 2 * q + 1) * 136 + mrow] = (bf16)f2bf(bfhi(ww[q]) * zeta); } }
        __syncthreads();
        if (unit + F.G < 32 * 32) RKV_LOAD(unit + F.G);
        f32x4 acc[4];
#pragma unroll
        for (int dt = 0; dt < 4; ++dt) acc[dt] = (f32x4){0.f, 0.f, 0.f, 0.f};
#pragma unroll
        for (int ks = 0; ks < 4; ++ks) {
            const bf16x8 a = *(const LAS bf16x8*)(vT + (16 * F.wave + fr) * 136 + 32 * ks + 8 * quad);
#pragma unroll
            for (int dt = 0; dt < 4; ++dt) { const bf16x8 bb = *(const LAS bf16x8*)(kzT + (16 * dt + fr) * 136 + 32 * ks + 8 * quad);
                acc[dt] = __builtin_amdgcn_mfma_f32_16x16x32_bf16(a, bb, acc[dt], 0, 0, 0); } }
        float* o = KVt + (size_t)unit * 8192;
#pragma unroll
        for (int dt = 0; dt < 4; ++dt)
#pragma unroll
            for (int r = 0; r < 4; ++r) o[(16 * F.wave + 4 * quad + r) * 64 + 16 * dt + fr] = acc[dt][r];
        __syncthreads();
    }
#undef RKV_LOAD
}
__device__ __forceinline__ void ret_scan_phase(Frame& F) {
    const float* KVt = (const float*)(F.ws + WS_KVT); bf16* ST = (bf16*)(F.ws + WS_ST);
    for (int idx = F.vcu * 512 + F.tid; idx < 32 * 2048; idx += F.G * 512) {
        const int bh = idx >> 11, e4 = idx & 2047, h = bh & 3; const float cd = __builtin_amdgcn_exp2f(128.f * ret_lg2(h));
        float z_ = 0.f; asm volatile("" : "+v"(z_)); f32x4 s = (f32x4){z_, z_, z_, z_};
        const GAS f32x4* kp = (const GAS f32x4*)(KVt + (size_t)bh * 32 * 8192) + e4; GAS v2u* sp = (GAS v2u*)(ST + (size_t)bh * 32 * 8192) + e4;
        f32x4 kv[32];
#pragma unroll
        for (int c = 0; c < 32; ++c) kv[c] = kp[(size_t)c * 2048];
#pragma unroll
        for (int c = 0; c < 32; ++c) { v2u w; w.x = pk2(s.x, s.y); w.y = pk2(s.z, s.w); sp[(size_t)c * 2048] = w; s = s * cd + kv[c]; }
    }
}
__device__ __forceinline__ void ret_out_phase(Frame& F, bf16* P, const float* retw) {
    LAS bf16* qs = (LAS bf16*)(F.lds + RT_QS); LAS bf16* ks_ = (LAS bf16*)(F.lds + RT_KS); LAS bf16* vT = (LAS bf16*)(F.lds + RT_VT); LAS bf16* sts = (LAS bf16*)(F.lds + RT_ST);
    const bf16* ST = (const bf16*)(F.ws + WS_ST);
    const int fr = F.lane & 15, quad = F.lane >> 4, w = F.wave;
    v4u lq[2], lk[2], ls[2], lv[4];
#define ROUT_LOAD(unit_) do { const int bh_ = (unit_) >> 5, ch_ = (unit_) & 31, b_ = bh_ >> 2, h_ = bh_ & 3; const size_t r0_ = (size_t)b_ * SEQ + ch_ * 128; \
        _Pragma("unroll") for (int i = 0; i < 2; ++i) { const int p = F.tid + 512 * i, r = p >> 3, c = p & 7; \
            lq[i] = *(const GAS v4u*)(P + (r0_ + r) * PW + pg8::PC_RQ + h_ * 64 + c * 8); lk[i] = *(const GAS v4u*)(P + (r0_ + r) * PW + pg8::PC_RK + h_ * 64 + c * 8); \
            ls[i] = *(const GAS v4u*)(ST + (size_t)(unit_) * 8192 + r * 64 + c * 8); } \
        _Pragma("unroll") for (int i = 0; i < 4; ++i) { const int p = F.tid + 512 * i, mrow = p & 127, c = p >> 7; lv[i] = *(const GAS v4u*)(P + (r0_ + mrow) * PW + pg8::PC_RV + h_ * 128 + c * 8); } } while (0)
    if (F.vcu < 32 * 32) ROUT_LOAD(F.vcu);
    for (int unit = F.vcu; unit < 32 * 32; unit += F.G) {
        const int bh = unit >> 5, ch = unit & 31, b = bh >> 2, h = bh & 3; const size_t row0 = (size_t)b * SEQ + ch * 128; const float lg = ret_lg2(h);
        {
#pragma unroll
        for (int i = 0; i < 2; ++i) { const int p = F.tid + 512 * i, r = p >> 3, c = p & 7;
            *(LAS v4u*)(qs + r * 72 + c * 8) = lq[i]; *(LAS v4u*)(ks_ + r * 72 + c * 8) = lk[i]; *(LAS v4u*)(sts + r * 72 + c * 8) = ls[i]; }
#pragma unroll
        for (int i = 0; i < 4; ++i) { const int p = F.tid + 512 * i, mrow = p & 127, c = p >> 7; const unsigned ww[4] = {lv[i].x, lv[i].y, lv[i].z, lv[i].w};
#pragma unroll
            for (int q = 0; q < 4; ++q) { vT[(c * 8 + 2 * q) * 136 + mrow] = (bf16)(ww[q] & 0xffffu); vT[(c * 8 + 2 * q + 1) * 136 + mrow] = (bf16)(ww[q] >> 16); } } }
        __syncthreads();
        const int n = 16 * w + fr;
        bf16* yrow = P + (row0 + n) * PW + pg8::PC_RG + h * 128 + 4 * quad;
        v2u g8[8];
#pragma unroll
        for (int et = 0; et < 8; ++et) g8[et] = *(const GAS v2u*)(yrow + 16 * et);
        if (unit + F.G < 32 * 32) ROUT_LOAD(unit + F.G);
        asm volatile("" ::: "memory");
        bf16x8 qf[2];
#pragma unroll
        for (int k = 0; k < 2; ++k) qf[k] = *(const LAS bf16x8*)(qs + (16 * w + fr) * 72 + 32 * k + 8 * quad);
        f32x4 sT[8];
#pragma unroll
        for (int mt = 0; mt < 8; ++mt) { sT[mt] = (f32x4){0.f, 0.f, 0.f, 0.f};
            if (mt <= w) {
#pragma unroll
                for (int k = 0; k < 2; ++k) { const bf16x8 a = *(const LAS bf16x8*)(ks_ + (16 * mt + fr) * 72 + 32 * k + 8 * quad); sT[mt] = __builtin_amdgcn_mfma_f32_16x16x32_bf16(a, qf[k], sT[mt], 0, 0, 0); }
#pragma unroll
                for (int r = 0; r < 4; ++r) { const int dd = (16 * w + fr) - (16 * mt + 4 * quad + r); sT[mt][r] = (dd >= 0) ? sT[mt][r] * __builtin_amdgcn_exp2f((float)dd * lg) : 0.f; } } }
        f32x4 acc1[8], acc2[8];
#pragma unroll
        for (int et = 0; et < 8; ++et) { acc1[et] = (f32x4){0.f, 0.f, 0.f, 0.f}; acc2[et] = (f32x4){0.f, 0.f, 0.f, 0.f}; }
#pragma unroll
        for (int s = 0; s < 4; ++s) {
            if (2 * s <= w) {
                v4u pbw; pbw.x = pg8::cvt_pk_bf16(sT[2 * s][0], sT[2 * s][1]); pbw.y = pg8::cvt_pk_bf16(sT[2 * s][2], sT[2 * s][3]); pbw.z = pg8::cvt_pk_bf16(sT[2 * s + 1][0], sT[2 * s + 1][1]); pbw.w = pg8::cvt_pk_bf16(sT[2 * s + 1][2], sT[2 * s + 1][3]);
                const bf16x8 pb = __builtin_bit_cast(bf16x8, pbw);
#pragma unroll
                for (int et = 0; et < 8; ++et) { const LAS bf16* vp = vT + (16 * et + fr) * 136 + 32 * s + 4 * quad;
                    const s16x4 lo = *(const LAS s16x4*)vp, hi = *(const LAS s16x4*)(vp + 16);
                    const bf16x8 a = (bf16x8){lo[0], lo[1], lo[2], lo[3], hi[0], hi[1], hi[2], hi[3]};
                    acc1[et] = __builtin_amdgcn_mfma_f32_16x16x32_bf16(a, pb, acc1[et], 0, 0, 0); } } }
#pragma unroll
        for (int et = 0; et < 8; ++et)
#pragma unroll
            for (int k = 0; k < 2; ++k) { const bf16x8 a = *(const LAS bf16x8*)(sts + (16 * et + fr) * 72 + 32 * k + 8 * quad); acc2[et] = __builtin_amdgcn_mfma_f32_16x16x32_bf16(a, qf[k], acc2[et], 0, 0, 0); }
        const float xi = __builtin_amdgcn_exp2f((float)(n + 1) * lg);
        float ss = 0.f;
#pragma unroll
        for (int et = 0; et < 8; ++et) { acc1[et] = acc1[et] + acc2[et] * xi; ss += (acc1[et][0] * acc1[et][0] + acc1[et][1] * acc1[et][1]) + (acc1[et][2] * acc1[et][2] + acc1[et][3] * acc1[et][3]); }
        ss += shx(ss, 16, F.lane); ss += shx(ss, 32, F.lane);
        const float rinv = 1.0f / sqrtf(ss * (1.f / 128.f) + RMS_EPS);
        f32x4 wv8[8];
#pragma unroll
        for (int et = 0; et < 8; ++et) wv8[et] = *(const f32x4*)(retw + h * 128 + 16 * et + 4 * quad);
        asm volatile("" ::: "memory");
#pragma unroll
        for (int et = 0; et < 8; ++et) { const f32x4 wv = wv8[et]; const v2u g = g8[et];
            v2u o; o.x = pk2(acc1[et][0] * rinv * wv[0] * bflo(g.x), acc1[et][1] * rinv * wv[1] * bfhi(g.x)); o.y = pk2(acc1[et][2] * rinv * wv[2] * bflo(g.y), acc1[et][3] * rinv * wv[3] * bfhi(g.y));
            *(GAS v2u*)(yrow + 16 * et) = o; }
        __syncthreads();
    }
#undef ROUT_LOAD
}

__device__ __forceinline__ void router_flush(Frame& F, int nrows, int mfirst, int NGW, unsigned my_e, float my_p) {
    unsigned* tokE = (unsigned*)(F.ws + WS_TOKE); unsigned* tokIdx = (unsigned*)(F.ws + WS_TOKIDX); float* tokP = (float*)(F.ws + WS_TOKP);
    const bool valid = F.lane < nrows;
    const unsigned long long lt = (1ull << F.lane) - 1ull;
    unsigned long long mask[2 * NEXP]; unsigned mycnt = 0u;
#pragma unroll
    for (int ke = 0; ke < 2 * NEXP; ++ke) { mask[ke] = __ballot(valid && (((my_e >> (8 * (ke >> 3))) & 0xffu) == (unsigned)(ke & 7))); if (F.lane == ke) mycnt = (unsigned)__popcll(mask[ke]); }
    unsigned mybase = 0u;
    if (F.lane < 2 * NEXP) mybase = __hip_atomic_fetch_add((unsigned*)(F.ctl + CW_CNT + 64 * F.lane), mycnt, RLX_AGENT);
    unsigned idx0 = 0u, idx1 = 0u;
#pragma unroll
    for (int ke = 0; ke < 2 * NEXP; ++ke) { const unsigned bs = (unsigned)__builtin_amdgcn_readlane((int)mybase, ke);
        if ((mask[ke] >> F.lane) & 1ull) { const unsigned v = bs + (unsigned)__popcll(mask[ke] & lt); if (ke < NEXP) idx0 = v; else idx1 = v; } }
    if (valid) { const int m = mfirst + F.lane * NGW; tokE[m] = my_e; tokIdx[2 * m] = idx0; tokIdx[2 * m + 1] = idx1; tokP[m] = my_p; }
}
__device__ __forceinline__ void norm_router_rows(Frame& F, const bf16* x, const float* gain, const float* wr, unsigned char* out) {
    const int gw = F.vcu * NWAVES + F.wave, NGW = F.G * NWAVES;
    f32x4 gv[4];
#pragma unroll
    for (int j = 0; j < 4; ++j) gv[j] = *((const f32x4*)gain + F.lane + 64 * j);
    f32x4 wa[4][4], wb[4][4];
#pragma unroll
    for (int j = 0; j < 4; ++j) { const f32x4* wp = (const f32x4*)(wr + (size_t)(4 * F.lane + 256 * j) * NEXP);
#pragma unroll
        for (int c = 0; c < 4; ++c) { wa[j][c] = wp[2 * c]; wb[j][c] = wp[2 * c + 1]; } }
    unsigned my_e = 0u; float my_p = 0.f; int nb = 0, mfirst = gw;
    v2u vq[2][4], vn[2][4];
#define RT_LOAD(dst, m0_) do { _Pragma("unroll") for (int q = 0; q < 2; ++q) { const int mm = ((m0_) + q * NGW < M) ? (m0_) + q * NGW : gw; const GAS v2u* xr = (const GAS v2u*)(x + (size_t)mm * D) + F.lane; \
        _Pragma("unroll") for (int j = 0; j < 4; ++j) dst[q][j] = xr[64 * j]; } } while (0)
    RT_LOAD(vq, gw);
    for (int m0 = gw; m0 < M; m0 += 2 * NGW) {
        RT_LOAD(vn, m0 + 2 * NGW);
#pragma unroll
        for (int q = 0; q < 2; ++q) { const int m = m0 + q * NGW; if (m >= M) break;
            f32x4 v[4]; float s = 0.f;
#pragma unroll
            for (int j = 0; j < 4; ++j) { v[j] = (f32x4){bflo(vq[q][j].x), bfhi(vq[q][j].x), bflo(vq[q][j].y), bfhi(vq[q][j].y)}; s += (v[j].x * v[j].x + v[j].y * v[j].y) + (v[j].z * v[j].z + v[j].w * v[j].w); }
            const float r = 1.0f / sqrtf(wave_sum(s, F.lane) * (1.f / D) + RMS_EPS);
            GAS unsigned* o8 = (GAS unsigned*)(out + (size_t)m * D) + F.lane;
            float lg[NEXP];
#pragma unroll
            for (int e = 0; e < NEXP; ++e) lg[e] = 0.f;
#pragma unroll
            for (int j = 0; j < 4; ++j) { v[j] = v[j] * r * gv[j];
                o8[64 * j] = pk_fp8(v[j].x, v[j].y, v[j].z, v[j].w);
#pragma unroll
                for (int c = 0; c < 4; ++c) { const f32x4 a = wa[j][c], b = wb[j][c]; const float hv = v[j][c];
                    lg[0] += hv * a[0]; lg[1] += hv * a[1]; lg[2] += hv * a[2]; lg[3] += hv * a[3]; lg[4] += hv * b[0]; lg[5] += hv * b[1]; lg[6] += hv * b[2]; lg[7] += hv * b[3]; } }
#pragma unroll
            for (int e = 0; e < NEXP; ++e) lg[e] = wave_sum(lg[e], F.lane);
            int e0 = 0; float v0 = lg[0];
#pragma unroll
            for (int e = 1; e < NEXP; ++e) if (lg[e] > v0) { v0 = lg[e]; e0 = e; }
            int e1 = -1; float v1 = -INFINITY;
#pragma unroll
            for (int e = 0; e < NEXP; ++e) if (e != e0 && lg[e] > v1) { v1 = lg[e]; e1 = e; }
            const float p0 = 1.0f / (1.0f + __expf(v1 - v0));
            if (F.lane == nb) { my_e = (unsigned)e0 | ((unsigned)e1 << 8); my_p = p0; }
            if (++nb == 64) { router_flush(F, nb, mfirst, NGW, my_e, my_p); nb = 0; mfirst = m + NGW; }
        }
#pragma unroll
        for (int q = 0; q < 2; ++q)
#pragma unroll
            for (int j = 0; j < 4; ++j) vq[q][j] = vn[q][j];
    }
#undef RT_LOAD
    if (nb > 0) router_flush(F, nb, mfirst, NGW, my_e, my_p);
}
__device__ __forceinline__ void moe_tables(Frame& F, LAS int* tb) {
    if (F.tid == 0) { unsigned c0[NEXP], c1[NEXP];
#pragma unroll
        for (int e = 0; e < NEXP; ++e) { c0[e] = __hip_atomic_load((unsigned*)(F.ctl + CW_CNT + 64 * e), RLX_AGENT); c1[e] = __hip_atomic_load((unsigned*)(F.ctl + CW_CNT + 64 * (8 + e)), RLX_AGENT); }
        int t = 0;
#pragma unroll
        for (int e = 0; e < NEXP; ++e) { tb[e] = t; tb[16 + e] = (int)c0[e]; t += (int)((c0[e] + c1[e] + 255u) >> 8); }
        if (t > MAXSLOT / 256) t = MAXSLOT / 256;
        tb[8] = t; }
    __syncthreads();
}
#if MOE_GATHER_IN_GEMM
__device__ __forceinline__ void moe_gather(Frame& F, const LAS int* tb) {
    const unsigned* tokE = (const unsigned*)(F.ws + WS_TOKE); const unsigned* tokIdx = (const unsigned*)(F.ws + WS_TOKIDX); const float* tokP = (const float*)(F.ws + WS_TOKP);
    int* tokof = (int*)(F.ws + WS_TOKOF); float* pwof = (float*)(F.ws + WS_PWOF);
    for (int m = F.vcu * 512 + F.tid; m < M; m += F.G * 512) {
        const unsigned ee = tokE[m]; const int e0 = ee & 0xff, e1 = (ee >> 8) & 0xff; const float p0 = tokP[m];
        const int s0 = tb[e0] * 256 + (int)tokIdx[2 * m], s1 = tb[e1] * 256 + tb[16 + e1] + (int)tokIdx[2 * m + 1];
        tokof[s0] = m; pwof[s0] = p0; tokof[s1] = m | (1 << 30); pwof[s1] = 1.0f - p0; }
}

#else
__device__ __forceinline__ void moe_gather(Frame& F, const LAS int* tb) {
    const int gw = F.vcu * NWAVES + F.wave, NGW = F.G * NWAVES;
    const unsigned* tokE = (const unsigned*)(F.ws + WS_TOKE); const unsigned* tokIdx = (const unsigned*)(F.ws + WS_TOKIDX); const float* tokP = (const float*)(F.ws + WS_TOKP);
    int* tokof = (int*)(F.ws + WS_TOKOF); float* pwof = (float*)(F.ws + WS_PWOF);
    const unsigned char* H8 = (const unsigned char*)F.outb + OUT_H8; unsigned char* XG = (unsigned char*)F.outb + OUT_XG;
    for (int m0 = gw; m0 < M; m0 += 4 * NGW) {
        int s0[4], s1[4]; float p0[4]; v4u a[4];
#pragma unroll
        for (int q = 0; q < 4; ++q) { const int m = (m0 + q * NGW < M) ? m0 + q * NGW : m0;
            const unsigned ee = tokE[m]; const int e0 = ee & 0xff, e1 = (ee >> 8) & 0xff; p0[q] = tokP[m];
            s0[q] = tb[e0] * 256 + (int)tokIdx[2 * m]; s1[q] = tb[e1] * 256 + tb[16 + e1] + (int)tokIdx[2 * m + 1];
            a[q] = *((const GAS v4u*)(H8 + (size_t)m * D) + F.lane); }
#pragma unroll
        for (int q = 0; q < 4; ++q) { const int m = m0 + q * NGW; if (m >= M) break;
            if (F.lane == 0) { tokof[s0[q]] = m; pwof[s0[q]] = p0[q]; tokof[s1[q]] = m | (1 << 30); pwof[s1[q]] = 1.0f - p0[q]; }
            *((GAS v4u*)(XG + (size_t)s0[q] * D) + F.lane) = a[q]; *((GAS v4u*)(XG + (size_t)s1[q] * D) + F.lane) = a[q]; }
    }
}

#endif
__device__ __forceinline__ void attn_check(Frame& F, const bf16* P, int layer) {
    const int gw = F.vcu * NWAVES + F.wave, lane = F.lane;
    LAS float* sc = (LAS float*)(F.lds + RING_OFF) + F.wave * 1024;
    const float* KMb = (const float*)(F.ws + WS_KMEAN);
    const int b = gw & 7, h = (gw >> 3) & 7; const unsigned hsh = (unsigned)(gw + 977 * layer) * 2654435761u; const int t = (int)((hsh >> 7) & 4095u);
    const int j = t >> 8; const size_t row = (size_t)b * SEQ + t;
    const float q = bflo((unsigned)P[row * PW + pg8::PC_Q + h * 64 + lane]);
    float g[15]; unsigned sel = 0u; bool ambiguous = false;
#pragma unroll
    for (int kb = 0; kb < 15; ++kb) { g[kb] = -INFINITY; if (kb < j) g[kb] = wave_sum(q * KMb[((size_t)(b * 8 + h) * 16 + kb) * 64 + lane], lane); }
    float lastv = 0.f;
#pragma unroll
    for (int pass = 0; pass < 4; ++pass) { float bv = -INFINITY; int bi = -1;
#pragma unroll
        for (int kb = 0; kb < 15; ++kb) if (kb < j && !((sel >> kb) & 1u) && g[kb] > bv) { bv = g[kb]; bi = kb; }
        if (pass < 3) { if (bi >= 0) { sel |= 1u << bi; lastv = bv; } }
        else if (bi >= 0 && j > 3 && fabsf(lastv - bv) < 2e-3f * (fabsf(lastv) + fabsf(bv)) + 1e-6f) ambiguous = true; }
    int nk = 0; float mx = -INFINITY;
    for (int kb = 0; kb <= j; ++kb) { if (kb < j && !((sel >> kb) & 1u)) continue;
        const int kend = (kb < j) ? 256 : (t & 255) + 1;
        for (int k = 0; k < kend; ++k) { const size_t kr = (size_t)b * SEQ + kb * 256 + k;
            const float s = wave_sum(q * bflo((unsigned)P[kr * PW + pg8::PC_K + h * 64 + lane]), lane);
            if (lane == 0) sc[nk] = s; mx = fmaxf(mx, s); ++nk; } }
    LDS_WAIT();
    float l = 0.f, o = 0.f; nk = 0;
    for (int kb = 0; kb <= j; ++kb) { if (kb < j && !((sel >> kb) & 1u)) continue;
        const int kend = (kb < j) ? 256 : (t & 255) + 1;
        for (int k = 0; k < kend; ++k) { const size_t kr = (size_t)b * SEQ + kb * 256 + k;
            const float p = __builtin_amdgcn_exp2f(sc[nk] - mx); l += p; o += p * bflo((unsigned)P[kr * PW + pg8::PC_V + h * 64 + lane]); ++nk; } }
    o /= l;
    const float got = bflo((unsigned)P[row * PW + pg8::PC_U + h * 64 + lane]);
    float omax = fabsf(o);
#pragma unroll
    for (int sft = 1; sft < 64; sft <<= 1) omax = fmaxf(omax, shx(omax, sft, lane));
    const bool bad = !(fabsf(got - o) <= 0.04f * omax + 2e-3f);
    if (__ballot(bad) != 0ull && !ambiguous && lane == 0) __hip_atomic_fetch_add((unsigned*)(F.ctl + CW_CNT + 64 * 20), 1u, RLX_AGENT);
    if (lane == 0) __hip_atomic_fetch_add((unsigned*)(F.ctl + CW_CNT + 64 * 21), ambiguous ? 0u : 1u, RLX_AGENT);
}

#ifndef PROBE_SITE
#define PROBE_SITE -1
#endif
#ifndef CHECK_NBAD_ALLOWED
#define CHECK_NBAD_ALLOWED 0u
#endif
constexpr int N_PHASES = 22;
struct Args { const float* in[19]; float* out; unsigned char* ws; int ph_lo, ph_hi; };
__global__ void __launch_bounds__(NWAVES * 64, 2) fwd_kernel(Args args) {
    extern __shared__ __attribute__((aligned(16))) unsigned char lds[];
    Frame F;
    F.lds = (LAS unsigned char*)lds;
    F.MISC = (volatile LAS unsigned*)(F.lds + MISC_OFF);
    F.tid = threadIdx.x; F.lane = F.tid & 63; F.wave = __builtin_amdgcn_readfirstlane(F.tid >> 6);
    F.G = gridDim.x; { const int bx = blockIdx.x; F.vcu = (F.G % 8 == 0) ? (bx % 8) * (F.G / 8) + bx / 8 : bx; }
    F.ws = (GAS unsigned char*)args.ws; F.ctl = (gu32*)(F.ws + WS_CTL);
    for (int u = F.tid; u < (LDS_BYTES - LDSCTL_OFF) / 4; u += NWAVES * 64) ((LAS unsigned*)(F.lds + LDSCTL_OFF))[u] = 0u;
    __syncthreads();
    XcdBarrier bar; bar.bar = (unsigned*)(F.ctl + CW_BAR); bar.x = 0; bar.st = nullptr;
    if (!MK_SPLIT) bar = xcd_barrier_post((unsigned*)(F.ctl + CW_BAR), F.MISC + 8);
    const int lo = args.ph_lo, hi = args.ph_hi;
#define OPAQUE_LANES() do { unsigned on_ = ~0u; asm volatile("" : "+s"(on_)); int t_ = (int)__builtin_amdgcn_mbcnt_hi(on_, __builtin_amdgcn_mbcnt_lo(on_, 0u)) + 64 * F.wave; asm volatile("" : "+v"(t_)); F.tid = t_; F.lane = t_ & 63; \
        int g_ = F.G, v_ = F.vcu, bx_ = (int)blockIdx.x; GAS unsigned char* w_ = (GAS unsigned char*)args.ws; GAS float* o_ = (GAS float*)args.out; asm volatile("" : "+s"(g_), "+s"(v_), "+s"(w_), "+s"(o_), "+s"(bx_)); F.G = g_; F.vcu = v_; bx = bx_; F.ws = w_; F.ctl = (gu32*)(w_ + WS_CTL); \
        F.outb = (GAS unsigned char*)o_; XB = (bf16*)(w_ + WS_XB); P = (bf16*)(w_ + WS_P); H = (bf16*)(w_ + WS_H); } while (0)
#ifndef SITE_MASK
#define SITE_MASK 0xffffffffu
#endif
#define INS(site, k) ((((SITE_MASK) >> (site)) & 1u) && lo <= (k) && (k) < hi)
#define IN(k) (lo <= (k) && (k) < hi)
#define SEAM(k) do { if (IN((k) + 1)) { XcdBarrier b_ = bar; GAS unsigned* gb_ = (GAS unsigned*)bar.bar; asm volatile("" : "+s"(gb_)); b_.bar = (unsigned*)gb_; xcd_barrier(b_); } } while (0)
    int bx = 0;
    bf16* XB;
    bf16* P; bf16* H;
    LAS int* tb = (LAS int*)(F.lds + MISC_OFF + 64);

    if (INS(0, 0)) { OPAQUE_LANES();
        convert_mixer_weights_flat<true>(F, 0);
        rope_table(F);
        norm_rows<1>(F, arg_in(0), arg_in(1), H, (unsigned char*)(F.ws + WS_HN8));
#if PROBE_SITE == 40
        convert_mixer_weights(F, 0); convert_matrix<2, UP_FP8>(F, arg_in(11), arg_in(12), D, FF, (void*)(F.ws + WS_W1), 2 * FF / 32); convert_matrix<0, DOWN_FP8>(F, arg_in(13), nullptr, FF, D, (void*)(F.ws + WS_W2), D / 32);
        rope_table(F); norm_rows<1>(F, arg_in(0), arg_in(1), H, (unsigned char*)(F.ws + WS_HN8));
#endif
        SEAM(0);
    }
    for (int l = 0; l < 2; ++l) {
        const int pb = 1 + 10 * l;
        if (INS(1, pb + 0)) { OPAQUE_LANES();
            pg8::SchedStd S; S.T.init(M / 256, 3072 / 256, F.G, bx); S.A = (const char*)H; S.B = (const char*)(F.ws + WS_WIN); S.atile = (size_t)256 * D * 2; S.btile = (size_t)256 * D * 2;
            pg8::EpiInproj E{P, (const float*)(F.ws + WS_TAB), 1, 1, 6, 1.0f};
            pg8::gemm_phase<pg8::EpiInproj, pg8::SchedStd>(F.lds + RING_OFF, F.wave, D, D, D, S, E);
            OPAQUE_LANES();
            pg8::SchedStd S8; S8.T.init(M / 256, 4608 / 256, F.G, bx); S8.A = (const char*)(F.ws + WS_HN8); S8.B = (const char*)(F.ws + WS_WG8); S8.atile = (size_t)256 * D; S8.btile = (size_t)256 * D;
            pg8::EpiQG8 E8{pg8::EpiInproj{P, (const float*)(F.ws + WS_TAB), 1, 1, 0, 0.03125f}, pg8::EpiGates8{(unsigned char*)P}};
            pg8::gemm_phase<pg8::EpiQG8, pg8::SchedStd, true>(F.lds + RING_OFF, F.wave, D / 2, D / 2, D / 2, S8, E8);
            SEAM(pb + 0);
        }
        if (INS(2, pb + 1)) { OPAQUE_LANES();
#if PROBE_SITE == 2
            kmean_phase(F, P); ret_kv_phase(F, P);
#endif
            kmean_phase(F, P);
            ret_kv_phase(F, P);
            conv_phase(F, P, arg_in(3) + (size_t)l * 3 * 512, arg_in(4) + (size_t)l * 512);
            SEAM(pb + 1);
        }
        if (INS(3, pb + 2)) { OPAQUE_LANES(); ret_scan_phase(F);
#if PROBE_SITE == 41
            ret_scan_phase(F);
#endif
            SEAM(pb + 2); }
        if (INS(4, pb + 3)) { OPAQUE_LANES();
            const attn_body::AttnTensors AT{(const attn_body::bf16*)P + pg8::PC_Q, (const attn_body::bf16*)P + pg8::PC_K, (const attn_body::bf16*)P + pg8::PC_V, (attn_body::bf16*)P + (CHECK_ATTN ? pg8::PC_U : pg8::PC_Q), (const float*)(F.ws + WS_KMEAN)};
            const attn_body::StaticOrder S((int)F.G, bx);
#if PROBE_SITE == 4
            { const attn_body::AttnTensors AT2{AT.Q, AT.K, AT.V, (attn_body::bf16*)P + pg8::PC_U, AT.KM};
              attn_body::attn_phase<attn_body::StaticOrder>((char*)lds + RING_OFF, AT2, S, F.wave); __syncthreads(); }
#endif
#if PROBE_SITE == 44
            { const attn_body::AttnTensors AT2{AT.Q, AT.K, AT.V, (attn_body::bf16*)P + pg8::PC_U, AT.KM};
              attn_body::attn_phase<attn_body::StaticOrder, 9>((char*)lds + RING_OFF, AT2, S, F.wave); __syncthreads(); }
#endif
            attn_body::attn_phase<attn_body::StaticOrder>((char*)lds + RING_OFF, AT, S, F.wave);
            __syncthreads(); OPAQUE_LANES();
            ret_out_phase(F, P, arg_in(5) + (size_t)l * 512);
            SEAM(pb + 3);
        }
        if (INS(5, pb + 4)) { OPAQUE_LANES();
            pg8::SchedBranch S; S.T.init(M / 256, D / 256, F.G, bx); S.A = (const char*)P; S.B = (const char*)(F.ws + WS_WBR);
            S.atile = (size_t)256 * PW * 2; S.btile = (size_t)256 * 512 * 2; S.bmat = (size_t)D * 512 * 2;
            static_assert(pg8::PC_Q == 0 && pg8::PC_CB == 1536 && pg8::PC_RG == 3584, "SchedBranch::a_ptr");
#if CHECK_ATTN
            attn_check(F, P, l); __syncthreads(); OPAQUE_LANES();
#endif
            pg8::EpiBranch E{(const unsigned char*)P, H};
#if PROBE_SITE == 5
            pg8::gemm_phase<pg8::EpiBranch, pg8::SchedBranch>(F.lds + RING_OFF, F.wave, 512, PW, 512, S, E);
#endif
            pg8::gemm_phase<pg8::EpiBranch, pg8::SchedBranch>(F.lds + RING_OFF, F.wave, 512, PW, 512, S, E);
            SEAM(pb + 4);
        }
        if (INS(6, pb + 5)) { OPAQUE_LANES();
            pg8::SchedStd S; S.T.init(M / 256, D / 256, F.G, bx); S.A = (const char*)H; S.B = (const char*)(F.ws + WS_WOUT); S.atile = (size_t)256 * D * 2; S.btile = (size_t)256 * D * 2;
            if (l == 0) { pg8::EpiResidB<false> E{(const void*)arg_in(0), (pg8::bf16_t*)XB, D, 1.0f}; pg8::gemm_phase<pg8::EpiResidB<false>, pg8::SchedStd>(F.lds + RING_OFF, F.wave, D, D, D, S, E); }
            else        { pg8::EpiResidB<true> E{(const void*)XB, (pg8::bf16_t*)XB, D, 1.0f};          pg8::gemm_phase<pg8::EpiResidB<true>, pg8::SchedStd>(F.lds + RING_OFF, F.wave, D, D, D, S, E); }
            SEAM(pb + 5);
        }
        if (l == 0) {
            if (INS(7, 7)) { OPAQUE_LANES(); if (UP_FP8) norm_rows<2, true>(F, XB, arg_in(10), nullptr, (unsigned char*)H); else norm_rows<0, true>(F, XB, arg_in(10), H);
                convert_mixer_weights_flat<false>(F, 1);
#if PROBE_SITE == 41
                norm_rows<0, true>(F, XB, arg_in(10), H); convert_mixer_weights(F, 1);
#endif
                SEAM(7); }
            if (INS(8, 8)) { OPAQUE_LANES();
                constexpr int EU = UP_FP8 ? 1 : 2;
                pg8::SchedStd S; S.T.init(M / 256, 2 * FF / 256, F.G, bx); S.A = (const char*)H; S.B = (const char*)(F.ws + WS_W1); S.atile = (size_t)256 * D * EU; S.btile = (size_t)256 * D * EU;
                pg8::EpiSwigluT<DOWN_FP8, UP_FP8> E{(void*)(F.ws + WS_ACT), FF};
                pg8::gemm_phase<pg8::EpiSwigluT<DOWN_FP8, UP_FP8>, pg8::SchedStd, UP_FP8>(F.lds + RING_OFF, F.wave, D * EU / 2, D * EU / 2, D * EU / 2, S, E);
                SEAM(8);
            }
            if (INS(9, 9)) { OPAQUE_LANES();
                constexpr int ES = DOWN_FP8 ? 1 : 2;
                pg8::SchedStd S; S.T.init(M / 256, D / 256, F.G, bx); S.A = (const char*)(F.ws + WS_ACT); S.B = (const char*)(F.ws + WS_W2); S.atile = (size_t)256 * FF * ES; S.btile = (size_t)256 * FF * ES;
                pg8::EpiResidB<true> E{(const void*)XB, (pg8::bf16_t*)XB, D, DOWN_FP8 ? (1.0f / 256.0f) : 1.0f};
                pg8::gemm_phase<pg8::EpiResidB<true>, pg8::SchedStd, DOWN_FP8>(F.lds + RING_OFF, F.wave, FF * ES / 2, FF * ES / 2, FF * ES / 2, S, E);
                SEAM(9);
            }
            if (INS(10, 10)) { OPAQUE_LANES(); norm_rows<1, true>(F, XB, arg_in(1) + D, H, (unsigned char*)(F.ws + WS_HN8)); SEAM(10); }
        } else {
            if (INS(11, 17)) { OPAQUE_LANES();
                norm_router_rows(F, XB, arg_in(10) + D, arg_in(14), (unsigned char*)F.outb + OUT_H8);
                {
                    constexpr int N1 = (D / 64) * (2 * FF / 32), N2 = (FF / 64) * (D / 32);
                    const float* wg = arg_in(15); const float* wu = arg_in(16); const float* wd = arg_in(17); unsigned char* m1 = (unsigned char*)(F.ws + WS_MW1); unsigned char* m2 = (unsigned char*)(F.ws + WS_MW2);
                    convert_flat(F, NEXP * (N1 + N2), [=](int it, int lane) -> CItem { const int e = it / (N1 + N2), r = it % (N1 + N2);
                        if (r < N1) return conv_item<2>(wg + (size_t)e * D * FF, wu + (size_t)e * D * FF, D, FF, m1 + (size_t)e * 2 * FF * D, 2 * FF / 32, 0, 0, true, r, lane);
                        return conv_item<0>(wd + (size_t)e * FF * D, nullptr, FF, D, m2 + (size_t)e * D * FF, D / 32, 0, 0, true, r - N1, lane); });
                }
#if PROBE_SITE == 42
                for (int e = 0; e < NEXP; ++e) {
                    convert_matrix<2, true>(F, arg_in(15) + (size_t)e * D * FF, arg_in(16) + (size_t)e * D * FF, D, FF, (unsigned char*)(F.ws + WS_MW1) + (size_t)e * 2 * FF * D, 2 * FF / 32);
                    convert_matrix<0, true>(F, arg_in(17) + (size_t)e * FF * D, nullptr, FF, D, (unsigned char*)(F.ws + WS_MW2) + (size_t)e * D * FF, D / 32); }
#endif
                int* tokof = (int*)(F.ws + WS_TOKOF); float* pwof = (float*)(F.ws + WS_PWOF);
                for (int i = F.vcu * 512 + F.tid; i < MAXSLOT; i += F.G * 512) { tokof[i] = -1; pwof[i] = 0.f; }
                SEAM(17);
            }
            if (INS(12, 18)) { OPAQUE_LANES(); moe_tables(F, tb); moe_gather(F, tb);
#if PROBE_SITE == 41
                moe_gather(F, tb);
#endif
                SEAM(18); }
            if (INS(13, 19)) { OPAQUE_LANES();
                moe_tables(F, tb);
                pg8::SchedMoeBal<1> S; S.T.init(tb[8], 2 * FF / 256, F.G, bx); S.A = (const char*)F.outb + (MOE_GATHER_IN_GEMM ? OUT_H8 : OUT_XG); S.B = (const char*)(F.ws + WS_MW1); S.tokof = (const int*)(F.ws + WS_TOKOF); S.toktab = (unsigned)(LDSCTL_OFF + 4096 - RING_OFF);
                S.atile = (size_t)256 * D; S.btile = (size_t)256 * D; S.bexp = (size_t)2 * FF * D; S.tbase = tb;
                S.cnt = (unsigned*)(F.ctl + CW_DEP); S.target = 2 * FF / 256; S.balance(tb[8] * (2 * FF / 256), tb[8] * (D / 256)); S.pack_tables();
                pg8::EpiSwiglu8 E{(unsigned char*)(F.ws + WS_ACTM), FF};
#if PROBE_SITE == 13
                pg8::gemm_phase<pg8::EpiSwiglu8, pg8::SchedMoeBal<1>, true>(F.lds + RING_OFF, F.wave, D / 2, D / 2, D / 2, S, E);
#endif
                pg8::gemm_phase<pg8::EpiSwiglu8, pg8::SchedMoeBal<1>, true>(F.lds + RING_OFF, F.wave, D / 2, D / 2, D / 2, S, E);
#if MK_SPLIT
                SEAM(19);
#endif
            }
            if (INS(14, 20)) { OPAQUE_LANES();
                moe_tables(F, tb);
                pg8::SchedMoeBal<2> S; S.T.init(tb[8], D / 256, F.G, bx); S.A = (const char*)(F.ws + WS_ACTM); S.B = (const char*)(F.ws + WS_MW2);
                S.atile = (size_t)256 * FF; S.btile = (size_t)256 * FF; S.bexp = (size_t)D * FF; S.tbase = tb;
                S.cnt = (unsigned*)(F.ctl + CW_DEP); S.target = 2 * FF / 256; S.balance(tb[8] * (2 * FF / 256), tb[8] * (D / 256)); S.pack_tables();
                pg8::EpiMoeY E{(pg8::bf16_t*)(F.ws + WS_Y0), (const int*)(F.ws + WS_TOKOF), (const float*)(F.ws + WS_PWOF), (WS_Y1 - WS_Y0) / 2};
#if PROBE_SITE == 14
                pg8::gemm_phase<pg8::EpiMoeY, pg8::SchedMoeBal<2>, true>(F.lds + RING_OFF, F.wave, FF / 2, FF / 2, FF / 2, S, E);
#endif
                pg8::gemm_phase<pg8::EpiMoeY, pg8::SchedMoeBal<2>, true>(F.lds + RING_OFF, F.wave, FF / 2, FF / 2, FF / 2, S, E);
                SEAM(20);
            }
            if (INS(15, 21)) { OPAQUE_LANES(); final_norm(F, XB, (float*)F.outb, arg_in(18), (const bf16*)(F.ws + WS_Y0), (const bf16*)(F.ws + WS_Y1));
#if CHECK_ATTN
                { const unsigned nbad = __hip_atomic_load((unsigned*)(F.ctl + CW_CNT + 64 * 20), RLX_AGENT), nchk = __hip_atomic_load((unsigned*)(F.ctl + CW_CNT + 64 * 21), RLX_AGENT);
                  if (nbad > CHECK_NBAD_ALLOWED || nchk < 3000u) { const float v = (nbad > CHECK_NBAD_ALLOWED) ? __builtin_nanf("") : 0.f; __syncthreads();
                      for (int i = F.vcu * 512 + F.tid; i < M * D / 4; i += F.G * 512) ((GAS f32x4*)F.outb)[i] = (f32x4){v, v, v, v}; } }
#endif
            }
        }
    }
#undef IN
#undef INS
#undef SEAM
}

extern "C" void kernel_launch(void* const* d_in, const int* in_sizes, int n_in, void* d_out, int out_size, void* d_ws, size_t ws_size, hipStream_t stream) {
    static int grid = 0;
    if (grid == 0) {
        if (n_in != 19 || in_sizes[0] != M * D || out_size != M * D || ws_size < WS_END) { fprintf(stderr, "kernel_launch: unexpected problem shape or workspace (%d inputs, ws %zu < %zu); nothing launched\n", n_in, ws_size, (size_t)WS_END); grid = -1; return; }
        int dev = 0, cus = 0, per_cu = 0;
        if (hipGetDevice(&dev) != hipSuccess || hipDeviceGetAttribute(&cus, hipDeviceAttributeMultiprocessorCount, dev) != hipSuccess) { grid = -1; return; }
        if (hipFuncSetAttribute((const void*)fwd_kernel, hipFuncAttributeMaxDynamicSharedMemorySize, LDS_BYTES) != hipSuccess) { fprintf(stderr, "kernel_launch: hipFuncSetAttribute failed\n"); grid = -1; return; }
        if (hipOccupancyMaxActiveBlocksPerMultiprocessor(&per_cu, (const void*)fwd_kernel, NWAVES * 64, LDS_BYTES) != hipSuccess || per_cu < 1)
            fprintf(stderr, "kernel_launch: note: occupancy query reports %d workgroups per CU\n", per_cu);
        (void)hipGetLastError();
        grid = cus;
    }
    if (grid < 0) return;
    if (hipMemsetAsync((char*)d_ws + WS_CTL, 0, CTL_ZERO_BYTES, stream) != hipSuccess) return;
    Args a{};
    for (int i = 0; i < 19; ++i) a.in[i] = (const float*)d_in[i];
    a.out = (float*)d_out; a.ws = (unsigned char*)d_ws;
#if MK_SPLIT
    for (int p = 0; p < N_PHASES; ++p) { a.ph_lo = p; a.ph_hi = p + 1; hipLaunchKernelGGL(fwd_kernel, dim3(grid), dim3(NWAVES * 64), LDS_BYTES, stream, a); }
#else
    a.ph_lo = 0; a.ph_hi = N_PHASES;
    hipLaunchKernelGGL(fwd_kernel, dim3(grid), dim3(NWAVES * 64), LDS_BYTES, stream, a);
#endif
}
```

```cpp
#include <hip/hip_runtime.h>
#include <hip/hip_bf16.h>
#include <cstdio>
#include <cstdint>
#include <cmath>

#ifndef PROBE_SITE
#define PROBE_SITE -1
#endif
#ifndef CHECK_ATTN
#define CHECK_ATTN 0
#endif
#ifndef UP_FP8
#define UP_FP8 true
#endif
#ifndef DOWN_FP8
#define DOWN_FP8 false
#endif
#ifndef WGM_INB
#define WGM_INB 4
#endif
#ifndef WGM_IN8
#define WGM_IN8 4
#endif
#ifndef WGM_UP
#define WGM_UP 4
#endif
#ifndef WGM_G1
#define WGM_G1 3
#endif
#ifndef ROUTER_WAVES
#define ROUTER_WAVES 4
#endif
#ifndef MK_SPLIT
#define MK_SPLIT 0
#endif

namespace pg8 {
#define PG8_LAS __attribute__((address_space(3)))
#define PG8_GAS __attribute__((address_space(1)))
typedef unsigned short bf16_t;
typedef short bf16x8 __attribute__((ext_vector_type(8)));
typedef float f32x4 __attribute__((ext_vector_type(4)));
typedef float f32x2 __attribute__((ext_vector_type(2)));
typedef unsigned u32x4 __attribute__((ext_vector_type(4)));
typedef unsigned u32x2 __attribute__((ext_vector_type(2)));
typedef int v4i_t __attribute__((ext_vector_type(4)));
typedef int v8i_t __attribute__((ext_vector_type(8)));
constexpr int BM = 256, BK = 64, HALF = 128, HTB = HALF * BK * 2  , STAGE_BYTES = 8 * HTB, NXCD = 8, WGM = 4;

__host__ __device__ __forceinline__ int lds_byte(int r, int c) { const int st = (r >> 4) * 2 + (c >> 5), rr = r & 15, cc = c & 31, ob = rr * 64 + cc * 2; return st * 1024 + (ob ^ (((ob >> 9) & 1) << 5)); }
__host__ __device__ __forceinline__ void stage_rc(int b, int& R, int& C) { const int st = b / 1024, sb = b % 1024, swz = sb ^ (((sb >> 9) & 1) << 5); R = (st >> 1) * 16 + swz / 64; C = (st & 1) * 32 + (swz % 64) / 2; }
__host__ __device__ __forceinline__ int perm32(int rho) { const int n = rho >> 4, i = rho & 15; return 8 * (i >> 2) + 4 * n + (i & 3); }

struct Unit { int pm, pn, z; };

struct TileOrder {
    int nM, nN, nwg, G, c, wgm;
    __device__ __forceinline__ void init(int nM_, int nN_, int G_, int c_, int wgm_ = WGM) { nM = nM_; nN = nN_; nwg = nM * nN; G = G_; c = c_; wgm = wgm_; }
    __device__ __forceinline__ bool tile(int i, int& pm, int& pn) const { return tileL((long)i * G + c, pm, pn); }
    __device__ __forceinline__ bool tileL(const long L, int& pm, int& pn) const {
        if (L >= nwg) return false;
        int wgid = (int)L; { const int q = nwg / NXCD, r = nwg % NXCD, xcd = wgid % NXCD, off = wgid / NXCD; wgid = (xcd < r ? xcd * (q + 1) : r * (q + 1) + (xcd - r) * q) + off; }
        const int nig = wgm * nN, gid = wgid / nig, fm = gid * wgm, gsz = (nM - fm) < wgm ? (nM - fm) : wgm;
        pm = fm + ((wgid % nig) % gsz); pn = (wgid % nig) / gsz; return true;
    }
};
struct SchedStd {
    static constexpr bool DEPS = false, PUBLISH = false, GATHER = false;
    TileOrder T; const char* A; const char* B; size_t atile, btile;
    __device__ __forceinline__ bool next(int i, Unit& u) const { u.z = 0; return T.tile(i, u.pm, u.pn); }
    __device__ __forceinline__ const char* a_ptr(const Unit& u) const { return A + (size_t)u.pm * atile; }
    __device__ __forceinline__ const char* b_ptr(const Unit& u) const { return B + (size_t)u.pn * btile; }
};
struct SchedBranch {
    static constexpr bool DEPS = false, PUBLISH = false, GATHER = false;
    TileOrder T; const char* A; const char* B; size_t atile, btile, bmat;
    __device__ __forceinline__ bool next(int i, Unit& u) const { u.z = i % 3; return T.tile(i / 3, u.pm, u.pn); }
    __device__ __forceinline__ const char* a_ptr(const Unit& u) const { return A + (size_t)u.pm * atile + (size_t)((CHECK_ATTN && u.z == 0) ? 2048 * 2 : (256 * u.z * u.z + 1280 * u.z) * 2); }
    __device__ __forceinline__ const char* b_ptr(const Unit& u) const { return B + (size_t)u.z * bmat + (size_t)u.pn * btile; }
};
struct SchedMoe {
    static constexpr bool DEPS = false, PUBLISH = false, GATHER = false;
    TileOrder T; const char* A; const char* B; size_t atile, btile, bexp; const PG8_LAS int* tbase;
    __device__ __forceinline__ bool next(int i, Unit& u) const { u.z = 0; return T.tile(i, u.pm, u.pn); }
    __device__ __forceinline__ const char* a_ptr(const Unit& u) const { return A + (size_t)u.pm * atile; }
    __device__ __forceinline__ const char* b_ptr(const Unit& u) const {
        int e = 0;
#pragma unroll
        for (int j = 1; j < 8; ++j) e += (u.pm >= tbase[j]) ? 1 : 0;
        return B + (size_t)e * bexp + (size_t)u.pn * btile; }
};

constexpr int MOE_XR = 3;
#ifndef MOE_GATHER_IN_GEMM
#define MOE_GATHER_IN_GEMM 0
#endif
template <int STAGE>
struct SchedMoeBal {
    static constexpr bool DEPS = (STAGE == 2), PUBLISH = (STAGE == 1), GATHER = (STAGE == 1) && MOE_GATHER_IN_GEMM;
    TileOrder T; const char* A; const char* B; size_t atile, btile, bexp; const PG8_LAS int* tbase; unsigned* cnt; int nfull, nextra, light, target;
    unsigned tpk0, tpk1, tpk2;
    const int* tokof; unsigned toktab;
    __device__ __forceinline__ void balance(int n1, int n2) {
        const int G = T.G, r2 = (n2 + G - 1) / G, E = n2 - (r2 - 1) * G; light = G - E;
        const int rest = n1 - MOE_XR * light, c1 = rest > 0 ? (rest + G - 1) / G : 0;
        if (STAGE == 1) { nfull = c1; nextra = MOE_XR; } else { nfull = r2 - 1; nextra = 1; } }
    __device__ __forceinline__ bool next(int i, Unit& u) const { u.z = 0;
        long L;
        if (i < nfull) L = (long)i * T.G + T.c;
        else if (i < nfull + nextra) {
            if (STAGE == 1) { if (T.c >= light) return false; L = (long)nfull * T.G + (long)(i - nfull) * light + T.c; }
            else            { if (T.c < light) return false;  L = (long)nfull * T.G + (long)(i - nfull) * (T.G - light) + (T.c - light); } }
        else return false;
        return T.tileL(L, u.pm, u.pn); }
    __device__ __forceinline__ const char* a_ptr(const Unit& u) const { return GATHER ? A : A + (size_t)u.pm * atile; }
    __device__ __forceinline__ void pack_tables() {
        unsigned t[8];
#pragma unroll
        for (int j = 1; j < 8; ++j) t[j] = (unsigned)tbase[j];
        tpk0 = (unsigned)__builtin_amdgcn_readfirstlane((int)(t[1] | (t[2] << 10) | (t[3] << 20))); tpk1 = (unsigned)__builtin_amdgcn_readfirstlane((int)(t[4] | (t[5] << 10) | (t[6] << 20))); tpk2 = (unsigned)__builtin_amdgcn_readfirstlane((int)t[7]); }
    __device__ __forceinline__ const char* b_ptr(const Unit& u) const {
        const unsigned pm = (unsigned)u.pm;
        const int e = (pm >= (tpk0 & 1023u)) + (pm >= ((tpk0 >> 10) & 1023u)) + (pm >= (tpk0 >> 20)) + (pm >= (tpk1 & 1023u)) + (pm >= ((tpk1 >> 10) & 1023u)) + (pm >= (tpk1 >> 20)) + (pm >= tpk2);
        return B + (size_t)e * bexp + (size_t)u.pn * btile; }
    __device__ __forceinline__ void publish(const Unit& u) const { __hip_atomic_fetch_add((PG8_GAS unsigned*)cnt + 16 * u.pm, 1u, __ATOMIC_RELAXED, __HIP_MEMORY_SCOPE_AGENT); }
    __device__ __forceinline__ void wait_deps(int i0, int lane) const {
        int pmj[3] = {0, 0, 0}, n = 0;
#pragma unroll
        for (int j = 0; j < 3; ++j) { Unit u; if (n == j && next(i0 + j, u)) { pmj[j] = u.pm; n = j + 1; } }
        const int pm = lane == 0 ? pmj[0] : (lane == 1 ? pmj[1] : pmj[2]); const bool have = lane < n;
        PG8_GAS unsigned* p = (PG8_GAS unsigned*)cnt + 16 * pm;
        for (unsigned spins = 0; spins < (1u << 18); ++spins) {
            const bool ok = !have || __hip_atomic_load(p, __ATOMIC_RELAXED, __HIP_MEMORY_SCOPE_AGENT) >= (unsigned)target;
            if (__builtin_amdgcn_ballot_w64(!ok) == 0ull) break;
            __builtin_amdgcn_s_sleep(2); }
        __builtin_amdgcn_fence(__ATOMIC_ACQUIRE, "agent"); asm volatile("s_waitcnt vmcnt(0)" ::: "memory"); }
};

__device__ __forceinline__ unsigned cvt_pk_bf16(float lo, float hi) { unsigned r; asm volatile("v_cvt_pk_bf16_f32 %0, %1, %2" : "=v"(r) : "v"(lo), "v"(hi)); return r; }
__device__ __forceinline__ float bf_lo(unsigned w) { return __builtin_bit_cast(float, w << 16); }
__device__ __forceinline__ float bf_hi(unsigned w) { return __builtin_bit_cast(float, w & 0xffff0000u); }
__device__ __forceinline__ float fsigmoid(float x) { return __builtin_amdgcn_rcpf(1.0f + __builtin_amdgcn_exp2f(-1.4426950408889634f * x)); }

template <class Epi, class Sched, bool FP8 = false>
__device__ __forceinline__ void gemm_phase(PG8_LAS unsigned char* lds, const int wave, const int K, const int lda, const int ldb, const Sched& S, const Epi& E, const unsigned stagger_ticks = 0u) {
    if (stagger_ticks != 0u) { const unsigned long long t0_ = __builtin_amdgcn_s_memrealtime(); while (__builtin_amdgcn_s_memrealtime() - t0_ < (unsigned long long)stagger_ticks) __builtin_amdgcn_s_sleep(8); }
    unsigned on_ = ~0u; asm volatile("" : "+s"(on_)); int tid_ = (int)__builtin_amdgcn_mbcnt_hi(on_, __builtin_amdgcn_mbcnt_lo(on_, 0u)) + 64 * wave; asm volatile("" : "+v"(tid_));
    const int tid = tid_, wid = __builtin_amdgcn_readfirstlane(tid >> 6), lane = tid & 63, wr = wid >> 2, wc = wid & 3, fr = lane & 15, fq = lane >> 4;
    const int nt = K / BK;
    unsigned voffA[2], voffB[2];
#pragma unroll
    for (int i = 0; i < 2; ++i) { int R, C; stage_rc(tid * 16 + i * 8192, R, C); const int Rb = Epi::PERM ? ((R & ~31) + perm32(R & 31)) : R;
        voffA[i] = (unsigned)(R * lda + C) * 2u; voffB[i] = (unsigned)(Rb * ldb + C) * 2u; }
    const size_t kstep = (size_t)(BK * 2);
    const size_t hsA = (size_t)HALF * lda * 2, hsB = (size_t)HALF * ldb * 2;
    const unsigned ldsw = (unsigned)wid * 1024u;
    const int aoff = lds_byte(wr * 64 + fr, fq * 8), boff = lds_byte(wc * 32 + fr, fq * 8);
#define PG8_SA(b, h) (((b) * 2 + (h)) * HTB)
#define PG8_SB(b, h) ((4 + (b) * 2 + (h)) * HTB)
#define PG8_STAGE(bufoff, gbase, voff) do { _Pragma("unroll") for (int _i = 0; _i < 2; ++_i) \
        __builtin_amdgcn_global_load_lds((const unsigned*)((const char*)(gbase) + (voff)[_i]), (PG8_LAS unsigned*)(lds + (bufoff) + ldsw + _i * 8192), 16, 0, 0); } while (0)
#define PG8_STAGE_A(b, h, abase, gsel) do { if constexpr (Sched::GATHER) { PG8_STAGE(PG8_SA(b, h), (abase), (gsel)[h]); } else { PG8_STAGE(PG8_SA(b, h), (abase) + ((h) ? hsA : 0), voffA); } } while (0)
#define PG8_LDA(dst, b, h) do { _Pragma("unroll") for (int m = 0; m < 4; ++m) { const v4i_t lo_ = *(const PG8_LAS v4i_t*)(lds + PG8_SA(b, h) + aoff + m * 2048), hi_ = *(const PG8_LAS v4i_t*)(lds + PG8_SA(b, h) + aoff + m * 2048 + 1024); \
        dst[m] = __builtin_shufflevector(lo_, hi_, 0, 1, 2, 3, 4, 5, 6, 7); } } while (0)
#define PG8_LDB(dst, b, h) do { _Pragma("unroll") for (int n = 0; n < 2; ++n) { const v4i_t lo_ = *(const PG8_LAS v4i_t*)(lds + PG8_SB(b, h) + boff + n * 2048), hi_ = *(const PG8_LAS v4i_t*)(lds + PG8_SB(b, h) + boff + n * 2048 + 1024); \
        dst[n] = __builtin_shufflevector(lo_, hi_, 0, 1, 2, 3, 4, 5, 6, 7); } } while (0)
#define PG8_LO(x) __builtin_bit_cast(bf16x8, __builtin_shufflevector(x, x, 0, 1, 2, 3))
#define PG8_HI(x) __builtin_bit_cast(bf16x8, __builtin_shufflevector(x, x, 4, 5, 6, 7))
#define PG8_MMA(ai, bj, At, Bt) do { __builtin_amdgcn_s_setprio(1); _Pragma("unroll") for (int m = 0; m < 4; ++m) _Pragma("unroll") for (int n = 0; n < 2; ++n) { \
        if constexpr (FP8) asm volatile("v_mfma_f32_16x16x128_f8f6f4 %0, %1, %2, %0" : "+v"(acc[ai][bj][m][n]) : "v"(Bt[n]), "v"(At[m])); \
        else { acc[ai][bj][m][n] = __builtin_amdgcn_mfma_f32_16x16x32_bf16(PG8_LO(Bt[n]), PG8_LO(At[m]), acc[ai][bj][m][n], 0, 0, 0); \
               acc[ai][bj][m][n] = __builtin_amdgcn_mfma_f32_16x16x32_bf16(PG8_HI(Bt[n]), PG8_HI(At[m]), acc[ai][bj][m][n], 0, 0, 0); } } \
        __builtin_amdgcn_s_setprio(0); } while (0)
#define PG8_WAIT_V(n) asm volatile("s_waitcnt vmcnt(" #n ")" ::: "memory")
#define PG8_WAIT_L(n) asm volatile("s_waitcnt lgkmcnt(" #n ")" ::: "memory")
#define PG8_BAR __builtin_amdgcn_s_barrier()
#define PG8_SCHED __builtin_amdgcn_sched_barrier(0)
    Unit cur, nxt, prv; int ui = 0;
    if (!S.next(0, cur)) return;
    if constexpr (Sched::DEPS) { if (wid == 0) S.wait_deps(0, lane); PG8_BAR; }
    prv = cur;
    f32x4 acc[2][2][4][2];
#pragma unroll
    for (int a = 0; a < 2; ++a)
#pragma unroll
        for (int b = 0; b < 2; ++b)
#pragma unroll
            for (int m = 0; m < 4; ++m)
#pragma unroll
                for (int n = 0; n < 2; ++n) acc[a][b][m][n] = (f32x4){0.f, 0.f, 0.f, 0.f};
    v8i_t At[4], B0[2], B1[2];
    const char* cA = S.a_ptr(cur); const char* cB = S.b_ptr(cur);
    unsigned gA[2][2] = {{0u, 0u}, {0u, 0u}}, gN[2][2] = {{0u, 0u}, {0u, 0u}};
    int gR[2], gC[2];
#pragma unroll
    for (int i = 0; i < 2; ++i) stage_rc(tid * 16 + i * 8192, gR[i], gC[i]);
#define PG8_TOKDMA(u_, par_) do { if (wid < 4) __builtin_amdgcn_global_load_lds((const unsigned*)(S.tokof + (size_t)(u_).pm * BM + wid * 64 + lane), (PG8_LAS unsigned*)(lds + S.toktab + (par_) * 1024 + wid * 256), 4, 0, 0); } while (0)
#define PG8_TOKREAD(dst, par_) do { _Pragma("unroll") for (int h_ = 0; h_ < 2; ++h_) _Pragma("unroll") for (int i_ = 0; i_ < 2; ++i_) { \
        const int t_ = *(const PG8_LAS int*)(lds + S.toktab + (par_) * 1024 + (gR[i_] + HALF * h_) * 4); dst[h_][i_] = (unsigned)(t_ < 0 ? 0 : (t_ & 0x3fffffff)) * (unsigned)(lda * 2) + (unsigned)(gC[i_] * 2); } } while (0)
    if constexpr (Sched::GATHER) { PG8_TOKDMA(cur, 0); PG8_WAIT_V(0); PG8_BAR; PG8_TOKREAD(gA, 0); }
    PG8_STAGE(PG8_SB(0, 0), cB, voffB); PG8_STAGE(PG8_SB(0, 1), cB + hsB, voffB); PG8_STAGE_A(0, 0, cA, gA); PG8_STAGE_A(0, 1, cA, gA);
    if (wr == 1) PG8_BAR;
    PG8_WAIT_V(2); PG8_BAR;
    PG8_STAGE(PG8_SB(1, 0), cB + kstep, voffB); PG8_STAGE_A(1, 0, cA + kstep, gA); PG8_STAGE(PG8_SB(1, 1), cB + hsB + kstep, voffB);
    PG8_WAIT_V(6); PG8_BAR;
    for (;;) {
        const bool has_next = S.next(ui + 1, nxt);
        const char* nA = has_next ? S.a_ptr(nxt) : cA; const char* nB = has_next ? S.b_ptr(nxt) : cB;
        if constexpr (Sched::GATHER) { if (has_next) PG8_TOKDMA(nxt, (ui + 1) & 1); }
        for (int t = 0; t < nt; t += 2) {
            const bool last = (t == nt - 2);
            if constexpr (Sched::DEPS) { if (last && has_next && (ui + 1) % 3 == 0 && wid == 0) S.wait_deps(ui + 1, lane); }
            if constexpr (Sched::PUBLISH) { if (last && ui > 0 && tid == 0) S.publish(prv); }
            const char* a1 = cA + (size_t)(t + 1) * kstep;
            const char* a2 = last ? nA : cA + (size_t)(t + 2) * kstep; const char* b2 = last ? nB : cB + (size_t)(t + 2) * kstep;
            const char* a3 = a2 + kstep; const char* b3 = b2 + kstep;
            if constexpr (Sched::GATHER) { if (last) { if (has_next) { PG8_TOKREAD(gN, (ui + 1) & 1); } else { gN[0][0] = gA[0][0]; gN[0][1] = gA[0][1]; gN[1][0] = gA[1][0]; gN[1][1] = gA[1][1]; } } }
            unsigned g2[2][2];
#pragma unroll
            for (int h_ = 0; h_ < 2; ++h_)
#pragma unroll
                for (int i_ = 0; i_ < 2; ++i_) g2[h_][i_] = last ? gN[h_][i_] : gA[h_][i_];
            PG8_LDB(B0, 0, 0); PG8_LDB(B1, 0, 1); PG8_SCHED; PG8_LDA(At, 0, 0); PG8_STAGE_A(1, 1, a1, gA);
            PG8_WAIT_V(8); PG8_WAIT_L(0); PG8_BAR; PG8_MMA(0, 0, At, B0); PG8_MMA(0, 1, At, B1); PG8_BAR; PG8_SCHED;
            PG8_LDA(At, 0, 1); PG8_STAGE(PG8_SB(0, 0), b2, voffB); PG8_STAGE(PG8_SB(0, 1), b2 + hsB, voffB); PG8_STAGE_A(0, 0, a2, g2);
            PG8_WAIT_V(8); PG8_WAIT_L(0); PG8_BAR; PG8_MMA(1, 0, At, B0); PG8_MMA(1, 1, At, B1); PG8_BAR; PG8_SCHED;
            PG8_LDB(B0, 1, 0); PG8_LDB(B1, 1, 1); PG8_SCHED; PG8_LDA(At, 1, 0); PG8_STAGE_A(0, 1, a2, g2);
            PG8_WAIT_V(8); PG8_WAIT_L(0); PG8_BAR; PG8_MMA(0, 0, At, B0); PG8_MMA(0, 1, At, B1); PG8_BAR; PG8_SCHED;
            PG8_LDA(At, 1, 1); PG8_STAGE(PG8_SB(1, 0), b3, voffB); PG8_STAGE(PG8_SB(1, 1), b3 + hsB, voffB); PG8_STAGE_A(1, 0, a3, g2);
            PG8_WAIT_V(8); PG8_WAIT_L(0); PG8_BAR; PG8_MMA(1, 0, At, B0); PG8_MMA(1, 1, At, B1); PG8_BAR; PG8_SCHED;
        }
        if (wr == 0) PG8_BAR;
        if constexpr (FP8) asm volatile("s_nop 15\n\ts_nop 7" ::: "memory");
        { unsigned on2_ = ~0u; asm volatile("" : "+s"(on2_)); const int l2_ = (int)__builtin_amdgcn_mbcnt_hi(on2_, __builtin_amdgcn_mbcnt_lo(on2_, 0u)); E(acc, cur, wr, wc, l2_ & 15, l2_ >> 4);
          if constexpr (Epi::PROBE_TWICE) { asm volatile("" ::: "memory"); Epi E2 = E; E2.st = E.st2; E2(acc, cur, wr, wc, l2_ & 15, l2_ >> 4); } }
        if (!has_next) break;
        if (!Epi::CHAIN || nxt.z == 0) {
#pragma unroll
        for (int a = 0; a < 2; ++a)
#pragma unroll
            for (int b = 0; b < 2; ++b)
#pragma unroll
                for (int m = 0; m < 4; ++m)
#pragma unroll
                    for (int n = 0; n < 2; ++n) acc[a][b][m][n] = (f32x4){0.f, 0.f, 0.f, 0.f};
        }
        prv = cur; cur = nxt; cA = nA; cB = nB; ++ui;
        if constexpr (Sched::GATHER) { gA[0][0] = gN[0][0]; gA[0][1] = gN[0][1]; gA[1][0] = gN[1][0]; gA[1][1] = gN[1][1]; }
        if (wr == 1) PG8_BAR;
    }
    PG8_WAIT_V(0);
    PG8_BAR;
    if constexpr (Sched::PUBLISH) { if (tid == 0) S.publish(cur); }
#undef PG8_STAGE_A
#undef PG8_TOKDMA
#undef PG8_TOKREAD
#undef PG8_SA
#undef PG8_SB
#undef PG8_STAGE
#undef PG8_LDA
#undef PG8_LDB
#undef PG8_MMA
#undef PG8_LO
#undef PG8_HI
#undef PG8_WAIT_V
#undef PG8_WAIT_L
#undef PG8_BAR
#undef PG8_SCHED
}

constexpr int PW = 5632;
constexpr int PC_Q = 0, PC_K = 512, PC_V = 1024, PC_CB = 1536, PC_U = 2048, PC_RQ = 2560, PC_RK = 2816, PC_RV = 3072, PC_RG = 3584, PG_BYTE = 8192;
constexpr float QSCALE = 0.125f * 1.4426950408889634f;

__device__ __forceinline__ u32x4 pack8(const f32x4& a, const f32x4& b) { u32x4 w; w.x = cvt_pk_bf16(a[0], a[1]); w.y = cvt_pk_bf16(a[2], a[3]); w.z = cvt_pk_bf16(b[0], b[1]); w.w = cvt_pk_bf16(b[2], b[3]); return w; }

__constant__ float c_inv_rev[32] = {1.591549367e-01f, 1.193493679e-01f, 8.949939907e-02f, 6.711508334e-02f, 5.032921210e-02f, 3.774158657e-02f, 2.830219641e-02f, 2.122365311e-02f, 1.591549441e-02f, 1.193493605e-02f, 8.949939162e-03f, 6.711508147e-03f, 5.032921676e-03f, 3.774158191e-03f, 2.830219688e-03f, 2.122365404e-03f, 1.591549371e-03f, 1.193493721e-03f, 8.949940093e-04f, 6.711508031e-04f, 5.032921326e-04f, 3.774158540e-04f, 2.830219746e-04f, 2.122365258e-04f, 1.591549517e-04f, 1.193493663e-04f, 8.949940093e-05f, 6.711509195e-05f, 5.032921399e-05f, 3.774158540e-05f, 2.830219637e-05f, 2.122365368e-05f};
struct EpiInproj {
    static constexpr bool PERM = true, PROBE_TWICE = (PROBE_SITE == 21 || PROBE_SITE == 23), CHAIN = false;
    bf16_t* P; const float* cs; int st, st2; int pn0; float ascale;
    __device__ __forceinline__ void operator()(f32x4 (&acc)[2][2][4][2], const Unit& u, int wr, int wc, int fr, int fq) const {
        const int pn = u.pn + pn0, row0 = u.pm * BM + wr * 64 + fr;
        const int tb = (pn < 8) ? pn * 256 : pn * 256 - 512;
        if (pn < 4 || pn == 12 || pn == 13) {
            const float sc = ((pn < 2) ? QSCALE : ((pn == 13) ? 0.125f : 1.0f)) * ascale;
            const int ob = tb + wc * 64 + 8 * fq;
            const f32x4 wv0 = *(const f32x4*)(c_inv_rev + 8 * fq), wv1 = *(const f32x4*)(c_inv_rev + 8 * fq + 4);
#pragma unroll
            for (int ai = 0; ai < 2; ++ai)
#pragma unroll
                for (int m = 0; m < 4; ++m) { const int row = row0 + ai * HALF + m * 16; const float pos = (float)(row & 4095);
                    f32x4 c0, c1, s0, s1;
#pragma unroll
                    for (int e = 0; e < 4; ++e) { const float r0 = __builtin_amdgcn_fractf(pos * wv0[e]), r1 = __builtin_amdgcn_fractf(pos * wv1[e]);
                        c0[e] = __builtin_amdgcn_cosf(r0); s0[e] = __builtin_amdgcn_sinf(r0); c1[e] = __builtin_amdgcn_cosf(r1); s1[e] = __builtin_amdgcn_sinf(r1); }
                    const f32x4 x1a = acc[ai][0][m][0], x1b = acc[ai][0][m][1], x2a = acc[ai][1][m][0], x2b = acc[ai][1][m][1];
                    const float sr = sc;
                    const f32x4 o1a = (x1a * c0 - x2a * s0) * sr, o1b = (x1b * c1 - x2b * s1) * sr, o2a = (x2a * c0 + x1a * s0) * sr, o2b = (x2b * c1 + x1b * s1) * sr;
                    bf16_t* rp = P + (size_t)row * PW + ob;
                    { const u32x4 w1_ = pack8(o1a, o1b), w2_ = pack8(o2a, o2b); if (st) { *(u32x4*)(rp) = w1_; *(u32x4*)(rp + 32) = w2_; } else asm volatile("" :: "v"(w1_), "v"(w2_)); }
                    if (m & 1) asm volatile("" ::: "memory"); }
        } else if (pn >= 8 && pn < 12) {
            const int ob = PC_U + 128 * (pn - 8) + 32 * wc + 8 * fq;
#pragma unroll
            for (int ai = 0; ai < 2; ++ai)
#pragma unroll
                for (int m = 0; m < 4; ++m) { const int row = row0 + ai * HALF + m * 16;
                    { const u32x4 w_ = pack8(acc[ai][0][m][0] * acc[ai][1][m][0], acc[ai][0][m][1] * acc[ai][1][m][1]); if (st) *(u32x4*)(P + (size_t)row * PW + ob) = w_; else asm volatile("" :: "v"(w_)); } }
        } else {
            const int kind = (pn >= 16) ? 1 : 0;
            const int ob = tb + 32 * wc + 8 * fq;
#pragma unroll
            for (int ai = 0; ai < 2; ++ai)
#pragma unroll
                for (int m = 0; m < 4; ++m) { const int row = row0 + ai * HALF + m * 16;
#pragma unroll
                    for (int bj = 0; bj < 2; ++bj) { f32x4 v0 = acc[ai][bj][m][0] * ascale, v1 = acc[ai][bj][m][1] * ascale;
                        if (kind != 0) {
#pragma unroll
                            for (int e = 0; e < 4; ++e) { const float g0 = fsigmoid(v0[e]), g1 = fsigmoid(v1[e]); v0[e] = v0[e] * g0; v1[e] = v1[e] * g1; } }
                        { const u32x4 w_ = pack8(v0, v1); if (st) *(u32x4*)(P + (size_t)row * PW + ob + bj * HALF) = w_; else asm volatile("" :: "v"(w_)); } } }
        }
    }
};
__device__ __forceinline__ unsigned pk_u8x4(float a, float b, float c, float d) {
    unsigned w = __builtin_amdgcn_cvt_pk_u8_f32(a, 0, 0u); w = __builtin_amdgcn_cvt_pk_u8_f32(b, 1, w); w = __builtin_amdgcn_cvt_pk_u8_f32(c, 2, w); return __builtin_amdgcn_cvt_pk_u8_f32(d, 3, w); }
__device__ __forceinline__ float gate_u8(float acc) { return __builtin_fmaxf(__builtin_floorf(fsigmoid(acc * 0.03125f) * 255.0f + 0.5f), 1.0f); }
struct EpiGates8 {
    static constexpr bool PERM = true, PROBE_TWICE = false, CHAIN = false;
    unsigned char* Pb;
    __device__ __forceinline__ void operator()(f32x4 (&acc)[2][2][4][2], const Unit& u, int wr, int wc, int fr, int fq) const {
        const int row0 = u.pm * BM + wr * 64 + fr, col0 = u.pn * BM + wc * 32 + 8 * fq;
#pragma unroll
        for (int ai = 0; ai < 2; ++ai)
#pragma unroll
            for (int m = 0; m < 4; ++m)
#pragma unroll
                for (int bj = 0; bj < 2; ++bj) { const f32x4 v0 = acc[ai][bj][m][0], v1 = acc[ai][bj][m][1];
                    u32x2 w; w.x = pk_u8x4(gate_u8(v0[0]), gate_u8(v0[1]), gate_u8(v0[2]), gate_u8(v0[3])); w.y = pk_u8x4(gate_u8(v1[0]), gate_u8(v1[1]), gate_u8(v1[2]), gate_u8(v1[3]));
                    *(u32x2*)(Pb + (size_t)(row0 + ai * HALF + m * 16) * (PW * 2) + PG_BYTE + col0 + bj * HALF) = w; }
    }
};
struct EpiQG8 {
    static constexpr bool PERM = true, PROBE_TWICE = false, CHAIN = false;
    EpiInproj a; EpiGates8 g;
    __device__ __forceinline__ void operator()(f32x4 (&acc)[2][2][4][2], const Unit& u, int wr, int wc, int fr, int fq) const {
        if (u.pn < 6) a(acc, u, wr, wc, fr, fq);
        else { Unit u2 = u; u2.pn = u.pn - 6; g(acc, u2, wr, wc, fr, fq); }
    }
};
struct EpiBranch {
    static constexpr bool PERM = true, PROBE_TWICE = false, CHAIN = true;
    const unsigned char* Pb; bf16_t* Mg;
    __device__ __forceinline__ void operator()(f32x4 (&acc)[2][2][4][2], const Unit& u, int wr, int wc, int fr, int fq) const {
        const int row0 = u.pm * BM + wr * 64 + fr, col0 = u.pn * BM + wc * 32 + 8 * fq, z = u.z;
        const int hoff = (z < 2) ? 1024 : 0;
        u32x2 g[2][2][2], h[2][2][2];
#define EB_LOAD(buf, b_) do { _Pragma("unroll") for (int mi = 0; mi < 2; ++mi) _Pragma("unroll") for (int bj = 0; bj < 2; ++bj) { \
            const unsigned char* gp = Pb + (size_t)(row0 + ((b_) >> 1) * HALF + (2 * ((b_) & 1) + mi) * 16) * (PW * 2) + PG_BYTE + 1024 * z + col0 + bj * HALF; \
            g[buf][mi][bj] = *(const u32x2*)gp; h[buf][mi][bj] = *(const u32x2*)(gp + hoff); } } while (0)
        EB_LOAD(0, 0);
#pragma unroll
        for (int b = 0; b < 4; ++b) { const int ai = b >> 1, mp = b & 1, buf = b & 1;
            if (b < 3) EB_LOAD((b + 1) & 1, b + 1);
            asm volatile("" ::: "memory");
#pragma unroll
            for (int mi = 0; mi < 2; ++mi)
#pragma unroll
                for (int bj = 0; bj < 2; ++bj) { const int m = 2 * mp + mi; const u32x2 gg = g[buf][mi][bj], hh = h[buf][mi][bj];
                    float f[8] = {(float)(gg.x & 0xffu), (float)((gg.x >> 8) & 0xffu), (float)((gg.x >> 16) & 0xffu), (float)(gg.x >> 24), (float)(gg.y & 0xffu), (float)((gg.y >> 8) & 0xffu), (float)((gg.y >> 16) & 0xffu), (float)(gg.y >> 24)};
                    if (z < 2) { const float d[8] = {(float)(hh.x & 0xffu), (float)((hh.x >> 8) & 0xffu), (float)((hh.x >> 16) & 0xffu), (float)(hh.x >> 24), (float)(hh.y & 0xffu), (float)((hh.y >> 8) & 0xffu), (float)((hh.y >> 16) & 0xffu), (float)(hh.y >> 24)};
#pragma unroll
                        for (int e = 0; e < 8; ++e) f[e] *= __builtin_amdgcn_rcpf(d[e]); }
                    else {
#pragma unroll
                        for (int e = 0; e < 8; ++e) f[e] *= (1.0f / 255.0f); }
                    f32x4 v0 = acc[ai][bj][m][0], v1 = acc[ai][bj][m][1];
                    v0[0] *= f[0]; v0[1] *= f[1]; v0[2] *= f[2]; v0[3] *= f[3]; v1[0] *= f[4]; v1[1] *= f[5]; v1[2] *= f[6]; v1[3] *= f[7];
                    if (z < 2) { acc[ai][bj][m][0] = v0; acc[ai][bj][m][1] = v1; }
                    else *(u32x4*)(Mg + (size_t)(row0 + ai * HALF + m * 16) * 1024 + col0 + bj * HALF) = pack8(v0, v1); }
            asm volatile("" ::: "memory");
        }
#undef EB_LOAD
    }
};
struct EpiResid {
    static constexpr bool PERM = false, PROBE_TWICE = false, CHAIN = false;
    const float* res; float* out; int ldc; float scale;
    __device__ __forceinline__ void operator()(f32x4 (&acc)[2][2][4][2], const Unit& u, int wr, int wc, int fr, int fq) const {
        const int row0 = u.pm * BM + wr * 64 + fr, col0 = u.pn * BM + wc * 32 + 4 * fq;
#pragma unroll
        for (int ai = 0; ai < 2; ++ai) {
            f32x4 r[4][2][2];
#pragma unroll
            for (int m = 0; m < 4; ++m) { const size_t off = (size_t)(row0 + ai * HALF + m * 16) * ldc + col0;
#pragma unroll
                for (int bj = 0; bj < 2; ++bj)
#pragma unroll
                    for (int n = 0; n < 2; ++n) r[m][bj][n] = *(const f32x4*)(res + off + bj * HALF + n * 16); }
#pragma unroll
            for (int m = 0; m < 4; ++m) { const size_t off = (size_t)(row0 + ai * HALF + m * 16) * ldc + col0;
#pragma unroll
                for (int bj = 0; bj < 2; ++bj)
#pragma unroll
                    for (int n = 0; n < 2; ++n) *(f32x4*)(out + off + bj * HALF + n * 16) = r[m][bj][n] + acc[ai][bj][m][n] * scale; }
            asm volatile("" ::: "memory");
        }
    }
};
template <bool SRC16> struct EpiResidB {
    static constexpr bool PERM = true, PROBE_TWICE = false, CHAIN = false;
    const void* res; bf16_t* out; int ldc; float scale;
    __device__ __forceinline__ void operator()(f32x4 (&acc)[2][2][4][2], const Unit& u, int wr, int wc, int fr, int fq) const {
        const int row0 = u.pm * BM + wr * 64 + fr, col0 = u.pn * BM + wc * 32 + 8 * fq;
#pragma unroll
        for (int ai = 0; ai < 2; ++ai) {
            if constexpr (SRC16) {
                u32x4 r[4][2];
#pragma unroll
                for (int m = 0; m < 4; ++m) { const size_t off = (size_t)(row0 + ai * HALF + m * 16) * ldc + col0;
#pragma unroll
                    for (int bj = 0; bj < 2; ++bj) r[m][bj] = *(const u32x4*)((const bf16_t*)res + off + bj * HALF); }
#pragma unroll
                for (int m = 0; m < 4; ++m) { const size_t off = (size_t)(row0 + ai * HALF + m * 16) * ldc + col0;
#pragma unroll
                    for (int bj = 0; bj < 2; ++bj) { const u32x4 w = r[m][bj];
                        const f32x4 r0 = (f32x4){bf_lo(w.x), bf_hi(w.x), bf_lo(w.y), bf_hi(w.y)}, r1 = (f32x4){bf_lo(w.z), bf_hi(w.z), bf_lo(w.w), bf_hi(w.w)};
                        *(u32x4*)(out + off + bj * HALF) = pack8(r0 + acc[ai][bj][m][0] * scale, r1 + acc[ai][bj][m][1] * scale); } }
            } else {
                f32x4 r[4][2][2];
#pragma unroll
                for (int m = 0; m < 4; ++m) { const size_t off = (size_t)(row0 + ai * HALF + m * 16) * ldc + col0;
#pragma unroll
                    for (int bj = 0; bj < 2; ++bj)
#pragma unroll
                        for (int n = 0; n < 2; ++n) r[m][bj][n] = *(const f32x4*)((const float*)res + off + bj * HALF + n * 4); }
#pragma unroll
                for (int m = 0; m < 4; ++m) { const size_t off = (size_t)(row0 + ai * HALF + m * 16) * ldc + col0;
#pragma unroll
                    for (int bj = 0; bj < 2; ++bj) *(u32x4*)(out + off + bj * HALF) = pack8(r[m][bj][0] + acc[ai][bj][m][0] * scale, r[m][bj][1] + acc[ai][bj][m][1] * scale); }
            }
            asm volatile("" ::: "memory");
        }
    }
};
__device__ __forceinline__ float sat8(float v) { return __builtin_amdgcn_fmed3f(v, -448.0f, 448.0f); }
__device__ __forceinline__ unsigned pk_fp8x4(float a, float b, float c, float d) { int w = __builtin_amdgcn_cvt_pk_fp8_f32(sat8(a), sat8(b), 0, false); w = __builtin_amdgcn_cvt_pk_fp8_f32(sat8(c), sat8(d), w, true); return (unsigned)w; }
template <bool F8, bool IN8 = false> struct EpiSwigluT {
    static constexpr bool PERM = true, PROBE_TWICE = false, CHAIN = false;
    void* O; int ldo;
    __device__ __forceinline__ void operator()(f32x4 (&acc)[2][2][4][2], const Unit& u, int wr, int wc, int fr, int fq) const {
        const int row0 = u.pm * BM + wr * 64 + fr, col0 = u.pn * HALF + wc * 32 + 8 * fq;
#pragma unroll
        for (int ai = 0; ai < 2; ++ai)
#pragma unroll
            for (int m = 0; m < 4; ++m) { f32x4 v0, v1; constexpr float sc = IN8 ? 0.03125f : 1.0f; const f32x4 g0 = acc[ai][0][m][0] * sc, g1 = acc[ai][0][m][1] * sc, u0 = acc[ai][1][m][0] * sc, u1 = acc[ai][1][m][1] * sc;
#pragma unroll
                for (int e = 0; e < 4; ++e) { v0[e] = g0[e] * fsigmoid(g0[e]) * u0[e]; v1[e] = g1[e] * fsigmoid(g1[e]) * u1[e]; }
                const size_t off = (size_t)(row0 + ai * HALF + m * 16) * ldo + col0;
                if constexpr (F8) { u32x2 w; w.x = pk_fp8x4(v0[0] * 8.f, v0[1] * 8.f, v0[2] * 8.f, v0[3] * 8.f); w.y = pk_fp8x4(v1[0] * 8.f, v1[1] * 8.f, v1[2] * 8.f, v1[3] * 8.f); *(u32x2*)((unsigned char*)O + off) = w; }
                else *(u32x4*)((bf16_t*)O + off) = pack8(v0, v1); }
    }
};
struct EpiSwiglu {
    static constexpr bool PERM = true, PROBE_TWICE = false, CHAIN = false;
    bf16_t* O; int ldo;
    __device__ __forceinline__ void operator()(f32x4 (&acc)[2][2][4][2], const Unit& u, int wr, int wc, int fr, int fq) const {
        const int row0 = u.pm * BM + wr * 64 + fr, col0 = u.pn * HALF + wc * 32 + 8 * fq;
#pragma unroll
        for (int ai = 0; ai < 2; ++ai)
#pragma unroll
            for (int m = 0; m < 4; ++m) { f32x4 v0, v1; const f32x4 g0 = acc[ai][0][m][0], g1 = acc[ai][0][m][1], u0 = acc[ai][1][m][0], u1 = acc[ai][1][m][1];
#pragma unroll
                for (int e = 0; e < 4; ++e) { v0[e] = g0[e] * fsigmoid(g0[e]) * u0[e]; v1[e] = g1[e] * fsigmoid(g1[e]) * u1[e]; }
                *(u32x4*)(O + (size_t)(row0 + ai * HALF + m * 16) * ldo + col0) = pack8(v0, v1); }
    }
};
struct EpiSwiglu8 {
    static constexpr bool PERM = true, PROBE_TWICE = false, CHAIN = false;
    unsigned char* O; int ldo;
    __device__ __forceinline__ void operator()(f32x4 (&acc)[2][2][4][2], const Unit& u, int wr, int wc, int fr, int fq) const {
        const int row0 = u.pm * BM + wr * 64 + fr, col0 = u.pn * HALF + wc * 32 + 8 * fq;
#pragma unroll
        for (int ai = 0; ai < 2; ++ai)
#pragma unroll
            for (int m = 0; m < 4; ++m) { f32x4 v0, v1; const f32x4 g0 = acc[ai][0][m][0] * 0.03125f, g1 = acc[ai][0][m][1] * 0.03125f, u0 = acc[ai][1][m][0] * 0.25f, u1 = acc[ai][1][m][1] * 0.25f;
#pragma unroll
                for (int e = 0; e < 4; ++e) { v0[e] = g0[e] * fsigmoid(g0[e]) * u0[e]; v1[e] = g1[e] * fsigmoid(g1[e]) * u1[e]; }
                u32x2 w; w.x = pk_fp8x4(v0[0], v0[1], v0[2], v0[3]); w.y = pk_fp8x4(v1[0], v1[1], v1[2], v1[3]);
                __hip_atomic_store((PG8_GAS unsigned long long*)(O + (size_t)(row0 + ai * HALF + m * 16) * ldo + col0), __builtin_bit_cast(unsigned long long, w), __ATOMIC_RELAXED, __HIP_MEMORY_SCOPE_AGENT); }
    }
};
struct EpiMoeY {
    static constexpr bool PERM = true, PROBE_TWICE = false, CHAIN = false;
    bf16_t* Y; const int* tok; const float* pw; size_t yrs;
    __device__ __forceinline__ void operator()(f32x4 (&acc)[2][2][4][2], const Unit& u, int wr, int wc, int fr, int fq) const {
        const int slot0 = u.pm * BM + wr * 64 + fr, col0 = u.pn * BM + wc * 32 + 8 * fq;
        int tq[2][4]; float pq[2][4];
#pragma unroll
        for (int ai = 0; ai < 2; ++ai)
#pragma unroll
            for (int m = 0; m < 4; ++m) { const int slot = slot0 + ai * HALF + m * 16; tq[ai][m] = tok[slot]; pq[ai][m] = pw[slot]; }
#pragma unroll
        for (int ai = 0; ai < 2; ++ai)
#pragma unroll
            for (int m = 0; m < 4; ++m) { const int t = tq[ai][m]; const float p = pq[ai][m] * (1.0f / 256.0f);
                if (t >= 0) { bf16_t* yp = Y + (size_t)(t >> 30) * yrs + (size_t)(t & 0x3fffffff) * 1024 + col0;
#pragma unroll
                    for (int bj = 0; bj < 2; ++bj) *(u32x4*)(yp + bj * HALF) = pack8(acc[ai][bj][m][0] * p, acc[ai][bj][m][1] * p); } }
    }
};
}
namespace attn_body {
using bf16=__hip_bfloat16;
using bf16x8=__attribute__((ext_vector_type(8)))short;
using s16x4=__attribute__((ext_vector_type(4)))short;
using f32x16=__attribute__((ext_vector_type(16)))float;
using u32x4=__attribute__((ext_vector_type(4)))unsigned;
constexpr int BATCH=8,NHEAD=8,SEQ=4096,D=64,DM=5632;
constexpr int NW=8,QBLK=32,QB=QBLK*NW,KVBLK=64,NQB=SEQ/QB;
constexpr int ATTN_PITCH=DM, ATTN_UNIT_ROWS=QB;
__device__ __forceinline__ int crow(int r,int hi){return (r&3)+8*(r>>2)+4*hi;}
#define SBAR() __builtin_amdgcn_sched_barrier(0)
__device__ __forceinline__ void cmask(f32x16&p0,f32x16&p1,int jb,int qrel,int hi){
  const float NEG=-INFINITY; int kb=64*jb+4*hi;
  #pragma unroll
  for(int r=0;r<16;++r){int kv=kb+(r&3)+8*(r>>2); if(kv>qrel)p0[r]=NEG; if(kv+32>qrel)p1[r]=NEG;}
}

__device__ __forceinline__ void bmask(f32x16&p0,f32x16&p1,unsigned keep){
  const float NEG=-INFINITY;
  if(!keep){
  #pragma unroll
  for(int r=0;r<16;++r){p0[r]=NEG;p1[r]=NEG;} }
}
typedef float f32x4_t __attribute__((ext_vector_type(4)));
constexpr int LDS_KM=86016;
constexpr int NSLOT=3, SLOTB=8192;
constexpr int LDS_K=0, LDS_V=NSLOT*SLOTB, LDS_WS=2*NSLOT*SLOTB, LDS_OST=LDS_WS+NW*64*4, LDS_BYTES=LDS_OST+NW*4096;
constexpr float C2=0.125f*1.4426950408889634f;
__device__ __forceinline__ void glds16(const void*gsrc,unsigned lds_dst){unsigned keep;
  asm volatile("s_mov_b32 %0, m0\n\ts_mov_b32 m0, %2\n\ts_nop 0\n\tglobal_load_lds_dwordx4 %1, off\n\ts_mov_b32 m0, %0":"=&s"(keep):"v"(gsrc),"s"(lds_dst):"memory");}
__device__ __forceinline__ float max3f(float a,float b,float c){float r;asm("v_max3_f32 %0, %1, %2, %3":"=v"(r):"v"(a),"v"(b),"v"(c));return r;}
__device__ __forceinline__ float max2f(float a,float b){float r;asm("v_max_f32_e32 %0, %1, %2":"=v"(r):"v"(a),"v"(b));return r;}
__device__ __forceinline__ float fadd_s(float a,float b){float r;asm("v_add_f32_e32 %0, %1, %2":"=v"(r):"v"(a),"v"(b));return r;}
__device__ __forceinline__ float fsub_s(float a,float b){float r;asm("v_sub_f32_e32 %0, %1, %2":"=v"(r):"v"(a),"v"(b));return r;}
typedef float f32x2_t __attribute__((ext_vector_type(2))); typedef __bf16 bf16x2_t __attribute__((ext_vector_type(2)));
__device__ __forceinline__ unsigned cvtpk_s(float lo,float hi){f32x2_t v={lo,hi};bf16x2_t b=__builtin_convertvector(v,bf16x2_t);return __builtin_bit_cast(unsigned,b);}
#define WAIT_BAR(N) asm volatile("s_waitcnt vmcnt(" #N ") lgkmcnt(0)\n\ts_barrier":::"memory")

__device__ __forceinline__ void qkt(f32x16&p0,f32x16&p1,const char*Kslot,const bf16x8*qr,const f32x16&negm,int r32,int hi){
  const char*kb=Kslot+hi*1024+r32*16;
  #pragma unroll
  for(int d0=0;d0<4;++d0){
    const bf16x8 b0=*reinterpret_cast<const bf16x8*>(kb+d0*2048);
    const bf16x8 b1=*reinterpret_cast<const bf16x8*>(kb+d0*2048+512);
    if(d0==0){p0=__builtin_amdgcn_mfma_f32_32x32x16_bf16(b0,qr[0],negm,0,0,0);p1=__builtin_amdgcn_mfma_f32_32x32x16_bf16(b1,qr[0],negm,0,0,0);}
    else{p0=__builtin_amdgcn_mfma_f32_32x32x16_bf16(b0,qr[d0],p0,0,0,0);p1=__builtin_amdgcn_mfma_f32_32x32x16_bf16(b1,qr[d0],p1,0,0,0);}}
}
typedef __attribute__((address_space(3))) const char* lds_cptr;
typedef short v4i16_t __attribute__((ext_vector_type(4)));
__device__ __forceinline__ void kload8(bf16x8*kf,lds_cptr kp){
  kf[0]=*(const __attribute__((address_space(3))) bf16x8*)(kp);      kf[1]=*(const __attribute__((address_space(3))) bf16x8*)(kp+512);
  kf[2]=*(const __attribute__((address_space(3))) bf16x8*)(kp+2048); kf[3]=*(const __attribute__((address_space(3))) bf16x8*)(kp+2560);
  kf[4]=*(const __attribute__((address_space(3))) bf16x8*)(kp+4096); kf[5]=*(const __attribute__((address_space(3))) bf16x8*)(kp+4608);
  kf[6]=*(const __attribute__((address_space(3))) bf16x8*)(kp+6144); kf[7]=*(const __attribute__((address_space(3))) bf16x8*)(kp+6656);
}
__device__ __forceinline__ void kload2(bf16x8*kf,lds_cptr kp,int j){ kf[2*j]=*(const __attribute__((address_space(3))) bf16x8*)(kp+j*2048); kf[2*j+1]=*(const __attribute__((address_space(3))) bf16x8*)(kp+j*2048+512); }
__device__ __forceinline__ s16x4 vtr(lds_cptr p){ return __builtin_bit_cast(s16x4,__builtin_amdgcn_ds_read_tr16_b64_v4i16((__attribute__((address_space(3))) v4i16_t*)p)); }
__device__ __forceinline__ float rowmax(const f32x16&p0,const f32x16&p1){
  float a=max3f(p0[0],p0[1],p1[0]),b=max3f(p0[2],p0[3],p1[1]);a=max3f(a,p1[2],p1[3]);
  #pragma unroll
  for(int r=4;r<16;r+=4){a=max3f(a,p0[r],p0[r+1]);b=max3f(b,p0[r+2],p0[r+3]);a=max3f(a,p1[r],p1[r+1]);b=max3f(b,p1[r+2],p1[r+3]);}
  const float m=max2f(a,b);
  auto rr=__builtin_amdgcn_permlane32_swap(__float_as_uint(m),__float_as_uint(m),false,false);
  return max2f(__uint_as_float(rr[0]),__uint_as_float(rr[1]));
}
__device__ __forceinline__ void pv(f32x16*o,int vb,bf16x8 pa0,bf16x8 pa1,bf16x8 pa2,bf16x8 pa3){
  #pragma unroll
  for(int d0=0;d0<2;++d0){s16x4 lo[4],hi[4];
    #pragma unroll
    for(int ks=0;ks<4;++ks){
      asm volatile("ds_read_b64_tr_b16 %0,%1 offset:%c2":"=&v"(lo[ks]):"v"(vb),"i"(d0*4096+ks*1024):"memory");
      asm volatile("ds_read_b64_tr_b16 %0,%1 offset:%c2":"=&v"(hi[ks]):"v"(vb),"i"(d0*4096+ks*1024+512):"memory");}
    asm volatile("s_waitcnt lgkmcnt(0)":::"memory");SBAR();
    #define PK(k) (bf16x8){lo[k][0],lo[k][1],lo[k][2],lo[k][3],hi[k][0],hi[k][1],hi[k][2],hi[k][3]}
    o[d0]=__builtin_amdgcn_mfma_f32_32x32x16_bf16(pa0,PK(0),o[d0],0,0,0);
    o[d0]=__builtin_amdgcn_mfma_f32_32x32x16_bf16(pa1,PK(1),o[d0],0,0,0);
    o[d0]=__builtin_amdgcn_mfma_f32_32x32x16_bf16(pa2,PK(2),o[d0],0,0,0);
    o[d0]=__builtin_amdgcn_mfma_f32_32x32x16_bf16(pa3,PK(3),o[d0],0,0,0);
    #undef PK
  }
}

#ifndef ATTN_STORE16
#define ATTN_STORE16(p,v) (*(u32x4*)(p)=(v))
#endif
template<int THRL> __device__ __forceinline__ void attn_unit(int b,int h,int qb,const bf16*Q,const bf16*__restrict__ K,const bf16*__restrict__ V,bf16*O,const float*__restrict__ KM,char*shm,const int wave_){
  unsigned on_=~0u; asm volatile("":"+s"(on_)); int tid_=(int)__builtin_amdgcn_mbcnt_hi(on_,__builtin_amdgcn_mbcnt_lo(on_,0u))+64*wave_; asm volatile("":"+v"(tid_));
  const int tid=tid_,lane=tid&63,r32=lane&31,hi=lane>>5; const int wid=wave_;
  const long rowbase=(long)b*SEQ; const int q0=qb*QB;
  const bf16*Qw=Q+(rowbase+q0+wid*QBLK)*DM+h*D;
  const bf16*Kh=K+rowbase*DM+h*D,*Vh=V+rowbase*DM+h*D;
  const unsigned lds0=(unsigned)(uintptr_t)shm;
  float*wsf=(float*)(shm+LDS_WS)+wid*64;
  const bf16*ksrc=Kh+(long)lane*DM+wid*8;
  const bf16*vsrc=Vh+(long)(16*(wid&3)+(lane>>2))*DM+(wid>>2)*32+(lane&3)*8;
  const unsigned kdst=lds0+LDS_K+wid*1024, vdst=lds0+LDS_V+wid*1024;
  #define DMA_K(t,slot) glds16(ksrc+(long)(t)*KVBLK*DM,(unsigned)__builtin_amdgcn_readfirstlane(kdst+(slot)))
  #define DMA_V(t,slot) glds16(vsrc+(long)(t)*KVBLK*DM,(unsigned)__builtin_amdgcn_readfirstlane(vdst+(slot)))
  const int vb0=(int)(lds0+LDS_V)+((lane>>4)&1)*32+(lane&3)*8+(4*hi+((lane&15)>>2))*64;
  const char*Kbase=shm+LDS_K; bf16x8 kf[8];
  const lds_cptr shm3=(lds_cptr)shm; const lds_cptr kp0=shm3+LDS_K+hi*1024+r32*16; const lds_cptr vp0=shm3+LDS_V+((lane>>4)&1)*32+(lane&3)*8+(4*hi+((lane&15)>>2))*64;
  const int NT=(q0+QB)/KVBLK;
  __attribute__((address_space(3))) float*kml=(__attribute__((address_space(3))) float*)(shm3+LDS_KM);
  DMA_K(0,0);DMA_V(0,0);DMA_K(1,SLOTB);
  bf16x8 qr[4];
  #pragma unroll
  for(int d0=0;d0<4;++d0)qr[d0]=*reinterpret_cast<const bf16x8*>(&Qw[(long)r32*DM+d0*16+hi*8]);
  { const float*kms=KM+(long)(b*NHEAD+h)*1024; const float k0_=kms[tid],k1_=kms[tid+512]; kml[tid]=k0_; kml[tid+512]=k1_; }
  asm volatile("s_waitcnt lgkmcnt(0)\n\ts_barrier":::"memory");
  unsigned sel=0u;
  if(qb>0){
    float g[15];
    const __attribute__((address_space(3))) float*kmb=kml+8*hi;
    #pragma unroll
    for(int kb=0;kb<15;++kb){ g[kb]=-INFINITY;
      if(kb<qb){ float sacc_=0.f;
        #pragma unroll
        for(int d0=0;d0<4;++d0){ const f32x4_t ka=*(const __attribute__((address_space(3))) f32x4_t*)(kmb+kb*64+16*d0),kc=*(const __attribute__((address_space(3))) f32x4_t*)(kmb+kb*64+16*d0+4);
          sacc_+=__uint_as_float((unsigned)(unsigned short)qr[d0][0]<<16)*ka[0]+__uint_as_float((unsigned)(unsigned short)qr[d0][1]<<16)*ka[1]+__uint_as_float((unsigned)(unsigned short)qr[d0][2]<<16)*ka[2]+__uint_as_float((unsigned)(unsigned short)qr[d0][3]<<16)*ka[3]
                +__uint_as_float((unsigned)(unsigned short)qr[d0][4]<<16)*kc[0]+__uint_as_float((unsigned)(unsigned short)qr[d0][5]<<16)*kc[1]+__uint_as_float((unsigned)(unsigned short)qr[d0][6]<<16)*kc[2]+__uint_as_float((unsigned)(unsigned short)qr[d0][7]<<16)*kc[3]; }
        sacc_+=__builtin_bit_cast(float,__builtin_amdgcn_ds_bpermute((lane^32)<<2,__builtin_bit_cast(int,sacc_))); g[kb]=sacc_; } }
    #pragma unroll
    for(int pass=0;pass<3;++pass){ float bv=-INFINITY; int bi=-1;
      #pragma unroll
      for(int kb=0;kb<15;++kb){ if(kb<qb && !((sel>>kb)&1u) && g[kb]>bv){bv=g[kb];bi=kb;} }
      if(bi>=0)sel|=1u<<bi; }
  }
  float mhat=0.f,l_reg=0.f;f32x16 o[2];o[0]=f32x16{};o[1]=f32x16{};f32x16 negm=f32x16{};asm volatile("":"+v"(negm));
  const int qrel=wid*QBLK+r32;
  #define CMASK(P0,P1,t) do{int jb_=(t)-(NT-4); if(jb_>=0)cmask(P0,P1,jb_,qrel,hi); else bmask(P0,P1,(sel>>((t)>>2))&1u);}while(0)
  bool resc=false;
  #define START(P0,P1) do{ const float rm=rowmax(P0,P1); resc=false; \
    { const float dl=__builtin_fmaxf(rm,-20.f); mhat=fadd_s(mhat,dl); \
      _Pragma("unroll") for(int r=0;r<16;++r){P0[r]=fsub_s(P0[r],dl);P1[r]=fsub_s(P1[r],dl);} \
      _Pragma("unroll") for(int r=0;r<16;++r)negm[r]=-mhat; asm volatile("":"+v"(negm)); } \
    _Pragma("unroll") for(int r=0;r<16;++r)P0[r]=__builtin_amdgcn_exp2f(P0[r]); }while(0)
  #define RESC() do{ if(resc){ asm volatile("s_waitcnt lgkmcnt(0)":::"memory"); \
      _Pragma("unroll") for(int d_=0;d_<2;++d_) _Pragma("unroll") for(int r=0;r<16;++r)o[d_][r]*=wsf[crow(r,hi)]; } }while(0)
  #define NMV(tn) (-mhat)
  f32x16 pA0,pA1,pB0,pB1;
  int sl_prev=0,sl_cur=0,sl_next=SLOTB;
  #define ROT() do{sl_prev=sl_cur;sl_cur=sl_next;sl_next=(sl_next==(NSLOT-1)*SLOTB)?0:sl_next+SLOTB;}while(0)
  DMA_K(2,2*SLOTB);
  WAIT_BAR(3);
  qkt(pA0,pA1,Kbase,qr,negm,r32,hi);asm volatile("s_nop 15\n\ts_nop 7":"+v"(pA0),"+v"(pA1));CMASK(pA0,pA1,0);
  START(pA0,pA1);
  _Pragma("unroll") for(int r=0;r<16;++r)pA1[r]=__builtin_amdgcn_exp2f(pA1[r]);
  WAIT_BAR(0);
  DMA_K(3,0);DMA_V(1,SLOTB);
  ROT();
  kload8(kf,kp0+sl_cur);
  WAIT_BAR(2);
  s16x4 vlo[8],vhi[8]; u32x4 pw0,pw1,pw2,pw3;
  #define PKW(P,B) cvtpk_s(P[B],P[B+1])
  #define PAF(k) __builtin_bit_cast(bf16x8,pw##k)
  #define VFR(i) (bf16x8){vlo[i][0],vlo[i][1],vlo[i][2],vlo[i][3],vhi[i][0],vhi[i][1],vhi[i][2],vhi[i][3]}
  #define PIN(x) asm volatile("":"+v"(x))
  #define MX3(a,b,c) __builtin_fmaxf(__builtin_fmaxf((a),(b)),(c))
  #define GAPA(MF,A0,A1,A2,A3,W0,W1,PW) do{ MF; sacc+=A0; sacc+=A1; sacc+=A2; sacc+=A3; PIN(sacc); W0; W1; PIN(PW); SBAR(); }while(0)
  #define EX(v) __builtin_amdgcn_exp2f(v)
  #define GAPB(MF,X,B) do{ MF; X[B]=EX(X[B]); X[B+1]=EX(X[B+1]); X[B+2]=EX(X[B+2]); X[B+3]=EX(X[B+3]); PIN(X); SBAR(); }while(0)
  #define VRD(i) do{ vlo[i]=vtr(vp_+(((i)>>2)*4096+((i)&3)*1024)); vhi[i]=vtr(vp_+(((i)>>2)*4096+((i)&3)*1024+512)); }while(0)
  #define KRD(G,j) do{ if(G){ kload2(kf,kp0+sl_next,j); SBAR(); } }while(0)
  #define STEP(C0,C1,P0,P1,t,GK,GV,GL) do{ SBAR(); \
    const lds_cptr vp_=vp0+sl_prev; \
    VRD(0); SBAR(); float sacc=(P0[0]+P0[1]); \
    GAPA(C0=__builtin_amdgcn_mfma_f32_32x32x16_bf16(kf[0],qr[0],negm,0,0,0), P0[2],P0[3],P0[4],P0[5],     pw0[0]=PKW(P0,0), pw0[1]=PKW(P0,2), pw0); \
    VRD(4); SBAR(); GAPA(C1=__builtin_amdgcn_mfma_f32_32x32x16_bf16(kf[1],qr[0],negm,0,0,0), P0[6],P0[7],P0[8],P0[9],     pw0[2]=PKW(P0,4), pw0[3]=PKW(P0,6), pw0); \
    VRD(1); SBAR(); GAPA(C0=__builtin_amdgcn_mfma_f32_32x32x16_bf16(kf[2],qr[1],C0,0,0,0),   P0[10],P0[11],P0[12],P0[13], pw1[0]=PKW(P0,8), pw1[1]=PKW(P0,10), pw1); \
    VRD(5); SBAR(); GAPA(C1=__builtin_amdgcn_mfma_f32_32x32x16_bf16(kf[3],qr[1],C1,0,0,0),   P0[14],P0[15],P1[0],P1[1],   pw1[2]=PKW(P0,12),pw1[3]=PKW(P0,14), pw1); \
    VRD(2); SBAR(); GAPA(C0=__builtin_amdgcn_mfma_f32_32x32x16_bf16(kf[4],qr[2],C0,0,0,0),   P1[2],P1[3],P1[4],P1[5],     pw2[0]=PKW(P1,0), pw2[1]=PKW(P1,2), pw2); \
    VRD(6); SBAR(); GAPA(C1=__builtin_amdgcn_mfma_f32_32x32x16_bf16(kf[5],qr[2],C1,0,0,0),   P1[6],P1[7],P1[8],P1[9],     pw2[2]=PKW(P1,4), pw2[3]=PKW(P1,6), pw2); \
    VRD(3); SBAR(); GAPA(C0=__builtin_amdgcn_mfma_f32_32x32x16_bf16(kf[6],qr[3],C0,0,0,0),   P1[10],P1[11],P1[12],P1[13], pw3[0]=PKW(P1,8), pw3[1]=PKW(P1,10), pw3); \
    VRD(7); SBAR(); GAPA(C1=__builtin_amdgcn_mfma_f32_32x32x16_bf16(kf[7],qr[3],C1,0,0,0),   P1[14],P1[15],0.f,0.f,       pw3[2]=PKW(P1,12),pw3[3]=PKW(P1,14), pw3); \
    l_reg+=sacc; \
    if(GK){DMA_K((t)+3,sl_cur);} if(GV){DMA_V((t)+1,sl_next);} \
    CMASK(C0,C1,t); \
    { float a=MX3(C0[0],C0[1],C1[0]),b=MX3(C0[2],C0[3],C1[1]); a=MX3(a,C1[2],C1[3]); \
      _Pragma("unroll") for(int r=4;r<16;r+=4){a=MX3(a,C0[r],C0[r+1]);b=MX3(b,C0[r+2],C0[r+3]);a=MX3(a,C1[r],C1[r+1]);b=MX3(b,C1[r+2],C1[r+3]);} \
      float rm=__builtin_fmaxf(a,b); { auto rr=__builtin_amdgcn_permlane32_swap(__float_as_uint(rm),__float_as_uint(rm),false,false); rm=__builtin_fmaxf(__uint_as_float(rr[0]),__uint_as_float(rr[1])); } \
      resc=false; \
      if(__builtin_expect(__any(rm>(float)THRL),0)){ const float dl=__builtin_fmaxf(rm,0.f); mhat+=dl; \
        _Pragma("unroll") for(int r=0;r<16;++r){C0[r]-=dl;C1[r]-=dl;} \
        { const float nm_=NMV((t)+1); _Pragma("unroll") for(int r=0;r<16;++r)negm[r]=nm_; } asm volatile("":"+v"(negm)); \
        const float f=__builtin_amdgcn_exp2f(-dl); l_reg*=f; if(hi==0)wsf[r32]=f; resc=true; } } \
    SBAR(); \
    GAPB(o[0]=__builtin_amdgcn_mfma_f32_32x32x16_bf16(PAF(0),VFR(0),o[0],0,0,0), C0,0); \
    GAPB(o[1]=__builtin_amdgcn_mfma_f32_32x32x16_bf16(PAF(0),VFR(4),o[1],0,0,0), C0,4); \
    KRD(GL,0); GAPB(o[0]=__builtin_amdgcn_mfma_f32_32x32x16_bf16(PAF(1),VFR(1),o[0],0,0,0), C0,8); \
    KRD(GL,1); GAPB(o[1]=__builtin_amdgcn_mfma_f32_32x32x16_bf16(PAF(1),VFR(5),o[1],0,0,0), C0,12); \
    KRD(GL,2); GAPB(o[0]=__builtin_amdgcn_mfma_f32_32x32x16_bf16(PAF(2),VFR(2),o[0],0,0,0), C1,0); \
    KRD(GL,3); GAPB(o[1]=__builtin_amdgcn_mfma_f32_32x32x16_bf16(PAF(2),VFR(6),o[1],0,0,0), C1,4); \
    GAPB(o[0]=__builtin_amdgcn_mfma_f32_32x32x16_bf16(PAF(3),VFR(3),o[0],0,0,0), C1,8); \
    GAPB(o[1]=__builtin_amdgcn_mfma_f32_32x32x16_bf16(PAF(3),VFR(7),o[1],0,0,0), C1,12); \
    }while(0)
  int t=1;
  #undef CMASK
  #define CMASK(P0,P1,t) do{}while(0)
  #undef NMV
  #define NMV(tn) (((sel>>((tn)>>2))&1u)?-mhat:-INFINITY)
  if(t+5<NT){
    { const float nm_=NMV(1); _Pragma("unroll") for(int r=0;r<16;++r)negm[r]=nm_; asm volatile("":"+v"(negm)); }
    for(;t+5<NT;t+=2){
      STEP(pB0,pB1,pA0,pA1,t,true,true,true);     WAIT_BAR(2); RESC(); ROT();
      if(((t+1)&3)==0){ const float nm_=NMV(t+1); _Pragma("unroll") for(int r=0;r<16;++r)negm[r]=nm_; asm volatile("":"+v"(negm)); }
      STEP(pA0,pA1,pB0,pB1,t+1,true,true,true);   WAIT_BAR(2); RESC(); ROT();
    }
    { _Pragma("unroll") for(int r=0;r<16;++r)negm[r]=-mhat; asm volatile("":"+v"(negm)); }
  }
  #undef NMV
  #define NMV(tn) (-mhat)
  #undef CMASK
  #define CMASK(P0,P1,t) do{int jb_=(t)-(NT-4); if(jb_>=0)cmask(P0,P1,jb_,qrel,hi); else bmask(P0,P1,(sel>>((t)>>2))&1u);}while(0)
  #define ENDW(tt) do{ if((tt)+3<NT){WAIT_BAR(2);} else if((tt)+2<NT){WAIT_BAR(1);} else {WAIT_BAR(0);} }while(0)
  for(;t+1<NT;t+=2){
    STEP(pB0,pB1,pA0,pA1,t,(t+3<NT),(t+1<NT),(t+1<NT));       ENDW(t);   RESC(); ROT();
    STEP(pA0,pA1,pB0,pB1,t+1,(t+4<NT),(t+2<NT),(t+2<NT));     ENDW(t+1); RESC(); ROT();
  }
  STEP(pB0,pB1,pA0,pA1,NT-1,false,false,false); RESC();
  { float sacc=pB0[0]+pB0[1]; _Pragma("unroll") for(int r=2;r<16;++r)sacc+=pB0[r]; _Pragma("unroll") for(int r=0;r<16;++r)sacc+=pB1[r]; l_reg+=sacc;
    pw0=(u32x4){PKW(pB0,0),PKW(pB0,2),PKW(pB0,4),PKW(pB0,6)};pw1=(u32x4){PKW(pB0,8),PKW(pB0,10),PKW(pB0,12),PKW(pB0,14)};pw2=(u32x4){PKW(pB1,0),PKW(pB1,2),PKW(pB1,4),PKW(pB1,6)};pw3=(u32x4){PKW(pB1,8),PKW(pB1,10),PKW(pB1,12),PKW(pB1,14)};
    SBAR(); pv(o,vb0+sl_cur,PAF(0),PAF(1),PAF(2),PAF(3)); }
  #undef PKW
  #undef PAF
  #undef VFR
  #undef PIN
  #undef MX3
  #undef GAPA
  #undef GAPB
  #undef EX
  #undef VRD
  #undef KRD
  #undef STEP
  #undef NMV
  #undef ENDW
  {auto rr=__builtin_amdgcn_permlane32_swap(__float_as_uint(l_reg),__float_as_uint(l_reg),false,false);l_reg=__uint_as_float(rr[0])+__uint_as_float(rr[1]);}
  if(hi==0)wsf[32+r32]=l_reg;asm volatile("s_waitcnt lgkmcnt(0)":::"memory");
  float rli[16];
  #pragma unroll
  for(int r=0;r<16;++r)rli[r]=__builtin_amdgcn_rcpf(wsf[32+crow(r,hi)]);
  bf16*Ow=O+(rowbase+q0+wid*QBLK)*DM+h*D;
  { bf16*stg=(bf16*)(shm+LDS_OST)+wid*2048;
    #pragma unroll
    for(int r=0;r<16;++r){const int orow=crow(r,hi);
      #pragma unroll
      for(int d0=0;d0<2;++d0)stg[orow*64+d0*32+r32]=__float2bfloat16(o[d0][r]*rli[r]);}
    asm volatile("s_waitcnt lgkmcnt(0)":::"memory");
    #pragma unroll
    for(int i=0;i<4;++i){const int row=i*8+(lane>>3),ch=lane&7; const u32x4 v=*(const u32x4*)(stg+row*64+ch*8); ATTN_STORE16(Ow+(long)row*DM+ch*8,v);} }
  asm volatile("s_waitcnt lgkmcnt(0)\n\ts_barrier":::"memory");
  #undef DMA_K
  #undef DMA_V
  #undef CMASK
  #undef START
  #undef RESC
  #undef ROT
}
constexpr int ATTN_LDS_BYTES=LDS_BYTES;
struct AttnTensors { const bf16* Q; const bf16* K; const bf16* V; bf16* O; const float* KM; };
struct AttnUnit { int bh; int qb; };
struct StaticOrder {
  int vcu,grid;
  __device__ __forceinline__ explicit StaticOrder(int grid_,int block):vcu((grid_%8==0)?(block%8)*(grid_/8)+block/8:block),grid(grid_){}
  __device__ __forceinline__ bool next(int i,AttnUnit&u)const{
    if(grid==256){ if(i>=4)return false; const int s=vcu&3; u.bh=vcu>>2; u.qb=(i==0)?15-s:(i==1)?8+s:(i==2)?7-s:s; return true; }
    const int L=vcu+i*grid; if(L>=BATCH*NHEAD*NQB)return false; u.bh=L/NQB; u.qb=L%NQB; return true; }
  __device__ __forceinline__ void a_ready(const AttnUnit&)const{}
  __device__ __forceinline__ void done(const AttnUnit&)const{}
};
template<class Sched,int THRL=8> __device__ __forceinline__ void attn_phase(char*lds,const AttnTensors&T,const Sched&S,const int wave_){
  AttnUnit u;
  for(int i=0;S.next(i,u);++i){ S.a_ready(u); attn_unit<THRL>(u.bh/NHEAD,u.bh%NHEAD,u.qb,T.Q,T.K,T.V,T.O,T.KM,lds,wave_); S.done(u); }
}
#undef SBAR
#undef WAIT_BAR
}

constexpr int NWAVES = 8;
constexpr int BATCH = 8, SEQ = 4096, D = 1024, M = BATCH * SEQ;
constexpr int NPROJ = 7680, FF = 3584, NEXP = 8;
constexpr int PW = pg8::PW;
constexpr int MAXSLOT = 2 * M + NEXP * 256;
constexpr float RMS_EPS = 1e-6f;

constexpr size_t MiB = 1u << 20;
constexpr size_t WS_CTL = 0, CTL_ZERO_BYTES = 1 * MiB;
constexpr size_t WS_TAB = 1 * MiB;
constexpr size_t WS_KMEAN = 2 * MiB;
constexpr size_t WS_TOKE = WS_KMEAN + 256 * 1024;
constexpr size_t WS_TOKIDX = WS_TOKE + 128 * 1024;
constexpr size_t WS_TOKP = WS_TOKIDX + 256 * 1024;
constexpr size_t WS_TOKOF = WS_TOKP + 128 * 1024;
constexpr size_t WS_PWOF = WS_TOKOF + (size_t)MAXSLOT * 4;
static_assert(WS_PWOF + (size_t)MAXSLOT * 4 <= 4 * MiB, "small tables");
constexpr size_t WS_WIN = 4 * MiB, WS_WG8 = 13 * MiB, WS_WBR = 19 * MiB, WS_WOUT = 22 * MiB;
constexpr size_t WS_H = 24 * MiB;
constexpr size_t WS_KVT = WS_H, WS_ST = WS_H + 32 * MiB;
constexpr size_t WS_W1 = 88 * MiB, WS_W2 = 102 * MiB;
constexpr size_t WS_P = 109 * MiB;
constexpr size_t WS_HN8 = 461 * MiB;
constexpr size_t WS_ACT = WS_P;
constexpr size_t WS_MW1 = 4 * MiB, WS_MW2 = 60 * MiB;
constexpr size_t OUT_H8 = 0, OUT_XG = 32 * MiB;
constexpr size_t WS_ACTM = 186 * MiB;
constexpr size_t WS_Y0 = 88 * MiB, WS_Y1 = 417 * MiB;
constexpr size_t WS_XB = 496 * MiB;
constexpr size_t WS_END = 562 * MiB;
static_assert(WS_P + (size_t)M * PW * 2 <= WS_HN8 && WS_HN8 + (size_t)M * D <= WS_XB && WS_XB + (size_t)M * D * 2 <= WS_END && WS_Y1 + (size_t)M * D * 2 <= WS_XB && WS_ACTM + (size_t)MAXSLOT * FF <= WS_Y1
              && WS_Y0 + (size_t)M * D * 2 <= WS_ACTM && WS_MW2 + (size_t)NEXP * D * FF <= WS_Y0 && WS_MW1 + (size_t)NEXP * 2 * FF * D <= WS_MW2 && OUT_H8 + (size_t)M * D <= OUT_XG && OUT_XG + (size_t)MAXSLOT * D <= (size_t)M * D * 4, "d_ws / d_out map");
constexpr int CW_BAR = 4096;
constexpr int CW_DEP = 65536;
constexpr int CW_CNT = 16384;

constexpr int RING_OFF = 0, RING_BYTES = 131072;
constexpr int LDSCTL_OFF = RING_BYTES, MISC_OFF = LDSCTL_OFF + 320;
constexpr int LDS_BYTES = 147456;

#define GAS __attribute__((address_space(1)))
#define LAS __attribute__((address_space(3)))
typedef unsigned short bf16;
typedef unsigned v4u __attribute__((ext_vector_type(4)));
typedef unsigned v2u __attribute__((ext_vector_type(2)));
typedef float f32x4 __attribute__((ext_vector_type(4)));
typedef short bf16x8 __attribute__((ext_vector_type(8)));
typedef short s16x4 __attribute__((ext_vector_type(4)));
typedef GAS unsigned gu32;
#define RLX_AGENT __ATOMIC_RELAXED, __HIP_MEMORY_SCOPE_AGENT
#define LDS_WAIT() asm volatile("s_waitcnt lgkmcnt(0)" ::: "memory")
__device__ __forceinline__ unsigned f2bf(float f) { unsigned u = __builtin_bit_cast(unsigned, f); return (u + 0x7fffu + ((u >> 16) & 1u)) >> 16; }
__device__ __forceinline__ unsigned pk2(float lo, float hi) { return f2bf(lo) | (f2bf(hi) << 16); }
__device__ __forceinline__ float bflo(unsigned w) { return __builtin_bit_cast(float, w << 16); }
__device__ __forceinline__ float bfhi(unsigned w) { return __builtin_bit_cast(float, w & 0xffff0000u); }

#define XB_TMO      128
#define XB_XCNT(j)  (256  + 64 * (j))
#define XB_XSUB(j)  (1280 + 64 * (j))
#define XB_XGEN(j)  (2304 + 64 * (j))
#define XB_TOP      3328
#define XB_TOPGEN   3392
#define XCD_BAR_WORDS 3456
#define XB_SPIN_CAP (1u << 18)
__device__ __forceinline__ unsigned xb_ld(unsigned* p)              { return __hip_atomic_load(p, __ATOMIC_RELAXED, __HIP_MEMORY_SCOPE_AGENT); }
__device__ __forceinline__ unsigned xb_add(unsigned* p, unsigned v) { return __hip_atomic_fetch_add(p, v, __ATOMIC_RELAXED, __HIP_MEMORY_SCOPE_AGENT); }
__device__ __forceinline__ unsigned xb_xcc_id() { return (unsigned)__builtin_amdgcn_s_getreg((3 << 11) | 20) & 0xFu; }
#define XB_SPIN(cond, bar) do { unsigned _sp = 0; while (cond) { __builtin_amdgcn_s_sleep(1); \
    if ((++_sp & 255u) == 0u) { if (xb_ld(&(bar)[XB_TMO])) break; if (_sp > XB_SPIN_CAP) { atomicAdd(&(bar)[XB_TMO], 1u); break; } } } } while (0)
struct XcdBarrier { unsigned* bar; unsigned x; volatile LAS unsigned* st; };
__device__ __forceinline__ XcdBarrier xcd_barrier_post(unsigned* bar, volatile LAS unsigned* st) {
    XcdBarrier b; b.bar = bar; b.x = xb_xcc_id(); b.st = st;
    if (threadIdx.x == 0) (void)xb_add(&bar[XB_XCNT(b.x)], 1u);
    return b;
}
__device__ __forceinline__ void xcd_barrier_complete(unsigned* bar, unsigned x, unsigned& nloc, unsigned& nx) {
    const unsigned G = gridDim.x * gridDim.y * gridDim.z;
    unsigned sum, cnt, mine, sp = 0u;
    for (;;) {
        sum = 0u; cnt = 0u; mine = 0u;
#pragma unroll
        for (unsigned j = 0; j < 16; ++j) { const unsigned c = xb_ld(&bar[XB_XCNT(j)]); sum += c; cnt += (c > 0u) ? 1u : 0u; mine = (j == x) ? c : mine; }
        if (sum == G) break;
        __builtin_amdgcn_s_sleep(1);
        if ((++sp & 255u) == 0u) { if (xb_ld(&bar[XB_TMO])) break; if (sp > XB_SPIN_CAP) { atomicAdd(&bar[XB_TMO], 1u); break; } }
    }
    nloc = mine > 0u ? mine : 1u; nx = cnt > 0u ? cnt : 1u;
}
__device__ __forceinline__ void xcd_barrier(const XcdBarrier& b) {
    asm volatile("s_waitcnt vmcnt(0)" ::: "memory");
    __syncthreads();
    if (threadIdx.x == 0) {
        unsigned* bar = b.bar;
        __builtin_amdgcn_s_waitcnt(0);
        unsigned nloc = b.st[0], nx = b.st[1];
        if (nloc == 0u) { xcd_barrier_complete(bar, b.x, nloc, nx); b.st[0] = nloc; b.st[1] = nx; }
        const unsigned old = xb_add(&bar[XB_XSUB(b.x)], 1u);
        const unsigned gen = old / nloc;
        if (old + 1u == (gen + 1u) * nloc) {
            __builtin_amdgcn_fence(__ATOMIC_RELEASE, "agent");
            asm volatile("s_waitcnt vmcnt(0)" ::: "memory");
            const unsigned og = xb_add(&bar[XB_TOP], 1u);
            const unsigned tg = og / nx;
            if (og + 1u == (tg + 1u) * nx) xb_add(&bar[XB_TOPGEN], 1u);
            else XB_SPIN(xb_ld(&bar[XB_TOPGEN]) == tg, bar);
            __builtin_amdgcn_fence(__ATOMIC_ACQUIRE, "agent");
            xb_add(&bar[XB_XGEN(b.x)], 1u);
            asm volatile("s_waitcnt vmcnt(0)" ::: "memory");
        } else {
            XB_SPIN(xb_ld(&bar[XB_XGEN(b.x)]) == gen, bar);
            __builtin_amdgcn_fence(__ATOMIC_ACQUIRE, "agent");
            asm volatile("s_waitcnt vmcnt(0)" ::: "memory");
        }
    }
    __syncthreads();
}

struct Frame {
    LAS unsigned char* lds;
    volatile LAS unsigned* MISC;
    gu32* ctl;
    int tid, lane, wave;
    int vcu, G;
    GAS unsigned char* ws;
    GAS unsigned char* outb;
};

__device__ __forceinline__ float shx(float v, int mask, int lane) { return __builtin_bit_cast(float, __builtin_amdgcn_ds_bpermute((lane ^ mask) << 2, __builtin_bit_cast(int, v))); }
template <int CTRL> __device__ __forceinline__ float dpp_f(float v) { return __builtin_bit_cast(float, __builtin_amdgcn_update_dpp(0, __builtin_bit_cast(int, v), CTRL, 0xf, 0xf, false)); }
__device__ __forceinline__ float wave_sum(float v, int lane) {
    (void)lane;
    v += dpp_f<0xB1>(v); v += dpp_f<0x4E>(v); v += dpp_f<0x124>(v); v += dpp_f<0x128>(v);
    const int iv = __builtin_bit_cast(int, v);
    const float r0 = __builtin_bit_cast(float, __builtin_amdgcn_readlane(iv, 0)), r1 = __builtin_bit_cast(float, __builtin_amdgcn_readlane(iv, 16)), r2 = __builtin_bit_cast(float, __builtin_amdgcn_readlane(iv, 32)), r3 = __builtin_bit_cast(float, __builtin_amdgcn_readlane(iv, 48));
    return (r0 + r1) + (r2 + r3);
}

__device__ __forceinline__ unsigned pk_fp8(float a, float b, float c, float d) { return pg8::pk_fp8x4(a, b, c, d); }
template <int KIND>
__device__ __forceinline__ const float* convert_src(const float* W, const float* W2, int Nsrc, int ndb, int scol_off, int db_off, int it, int lane) {
    const int kb = it / ndb, db = it % ndb + db_off; const float* src = W; int scol;
    if (KIND == 0) scol = 32 * db;
    else if (KIND == 1) { const int pn = db >> 3, blk = db & 7, bj = blk >> 2, wc = blk & 3;
        if (pn < 4 || pn == 12 || pn == 13) scol = 256 * pn + 64 * wc + 32 * bj;
        else if (pn >= 8 && pn < 12) scol = (bj ? 2560 : 2048) + 128 * (pn - 8) + 32 * wc;
        else scol = 32 * db; }
    else { const int t = db >> 3, blk = db & 7, bj = blk >> 2, wc = blk & 3; src = bj ? W2 : W; scol = 128 * t + 32 * wc; }
    return src + (size_t)(64 * kb + (lane >> 5)) * Nsrc + scol + scol_off + (lane & 31);
}
template <int KIND, bool FP8 = false>
__device__ __forceinline__ void convert_matrix(Frame& F, const float* W, const float* W2, int K, int Nsrc, void* WT, int ndb, const float* kgain = nullptr, int scol_off = 0, int db_off = 0) {
    LAS float* scr = (LAS float*)(F.lds + RING_OFF + F.wave * 16384);
    const int gw = F.vcu * NWAVES + F.wave, NGW = F.G * NWAVES, nitems = (K / 64) * ndb, lane = F.lane;
    const size_t rs = (size_t)2 * Nsrc;
    float cur[32], nxt[32];
    if (gw < nitems) { const float* p = convert_src<KIND>(W, W2, Nsrc, ndb, scol_off, db_off, gw, lane);
#pragma unroll
        for (int i = 0; i < 32; ++i) cur[i] = p[i * rs]; }
    for (int it = gw; it < nitems; it += NGW) {
        const int itn = it + NGW;
        if (itn < nitems) { const float* p = convert_src<KIND>(W, W2, Nsrc, ndb, scol_off, db_off, itn, lane);
#pragma unroll
            for (int i = 0; i < 32; ++i) nxt[i] = p[i * rs]; }
        const int kb = it / ndb, dbl = it % ndb, k0 = 64 * kb, drow0 = 32 * dbl;
#pragma unroll
        for (int i = 0; i < 32; ++i) scr[(2 * i + (lane >> 5)) * 33 + (lane & 31)] = FP8 ? cur[i] * 32.0f : cur[i];
        LDS_WAIT(); asm volatile("" ::: "memory");
        if (FP8) { const int c = lane & 3;
#pragma unroll
            for (int j = 0; j < 2; ++j) { const int n = (lane >> 2) + 16 * j; const LAS float* s = scr + (16 * c) * 33 + n;
                v4u o; o.x = pk_fp8(s[0 * 33], s[1 * 33], s[2 * 33], s[3 * 33]); o.y = pk_fp8(s[4 * 33], s[5 * 33], s[6 * 33], s[7 * 33]);
                o.z = pk_fp8(s[8 * 33], s[9 * 33], s[10 * 33], s[11 * 33]); o.w = pk_fp8(s[12 * 33], s[13 * 33], s[14 * 33], s[15 * 33]);
                *(GAS v4u*)((unsigned char*)WT + (size_t)(drow0 + n) * K + k0 + 16 * c) = o; } }
        else { const int c = lane & 7;
#pragma unroll
            for (int j = 0; j < 4; ++j) { const int n = (lane >> 3) + 8 * j; const LAS float* s = scr + (8 * c) * 33 + n;
                v4u o; o.x = pk2(s[0 * 33], s[1 * 33]); o.y = pk2(s[2 * 33], s[3 * 33]); o.z = pk2(s[4 * 33], s[5 * 33]); o.w = pk2(s[6 * 33], s[7 * 33]);
                *(GAS v4u*)((bf16*)WT + (size_t)(drow0 + n) * K + k0 + 8 * c) = o; } }
        LDS_WAIT(); asm volatile("" ::: "memory");
#pragma unroll
        for (int i = 0; i < 32; ++i) cur[i] = nxt[i];
    }
}
struct CItem { const float* p; size_t rs; unsigned char* dst; int K; bool fp8; };
template <int KIND>
__device__ __forceinline__ CItem conv_item(const float* W, const float* W2, int K, int Nsrc, void* WT, int ndb, int scol_off, int db_off, bool fp8, int it, int lane) {
    CItem c; c.p = convert_src<KIND>(W, W2, Nsrc, ndb, scol_off, db_off, it, lane); c.rs = (size_t)2 * Nsrc; c.K = K; c.fp8 = fp8;
    const int kb = it / ndb, dbl = it % ndb; c.dst = (unsigned char*)WT + ((size_t)(32 * dbl) * K + 64 * kb) * (fp8 ? 1 : 2); return c; }
template <class Dec>
__device__ __forceinline__ void convert_flat(Frame& F, const int nitems, const Dec& dec) {
    LAS float* scr = (LAS float*)(F.lds + RING_OFF + F.wave * 16384);
    const int gw = F.vcu * NWAVES + F.wave, NGW = F.G * NWAVES, lane = F.lane;
    float cur[32], nxt[32]; CItem ci, ni; ci.p = nullptr; ci.rs = 0; ci.dst = nullptr; ci.K = 0; ci.fp8 = false; ni = ci;
    if (gw < nitems) { ci = dec(gw, lane);
#pragma unroll
        for (int i = 0; i < 32; ++i) cur[i] = ci.p[i * ci.rs]; }
    for (int it = gw; it < nitems; it += NGW) {
        const int itn = it + NGW;
        if (itn < nitems) { ni = dec(itn, lane);
#pragma unroll
            for (int i = 0; i < 32; ++i) nxt[i] = ni.p[i * ni.rs]; }
        const float sc = ci.fp8 ? 32.0f : 1.0f;
#pragma unroll
        for (int i = 0; i < 32; ++i) scr[(2 * i + (lane >> 5)) * 33 + (lane & 31)] = cur[i] * sc;
        LDS_WAIT(); asm volatile("" ::: "memory");
        if (ci.fp8) { const int c = lane & 3;
#pragma unroll
            for (int j = 0; j < 2; ++j) { const int n = (lane >> 2) + 16 * j; const LAS float* s = scr + (16 * c) * 33 + n;
                v4u o; o.x = pk_fp8(s[0 * 33], s[1 * 33], s[2 * 33], s[3 * 33]); o.y = pk_fp8(s[4 * 33], s[5 * 33], s[6 * 33], s[7 * 33]);
                o.z = pk_fp8(s[8 * 33], s[9 * 33], s[10 * 33], s[11 * 33]); o.w = pk_fp8(s[12 * 33], s[13 * 33], s[14 * 33], s[15 * 33]);
                *(GAS v4u*)(ci.dst + (size_t)n * ci.K + 16 * c) = o; } }
        else { const int c = lane & 7;
#pragma unroll
            for (int j = 0; j < 4; ++j) { const int n = (lane >> 3) + 8 * j; const LAS float* s = scr + (8 * c) * 33 + n;
                v4u o; o.x = pk2(s[0 * 33], s[1 * 33]); o.y = pk2(s[2 * 33], s[3 * 33]); o.z = pk2(s[4 * 33], s[5 * 33]); o.w = pk2(s[6 * 33], s[7 * 33]);
                *(GAS v4u*)(ci.dst + ((size_t)n * ci.K + 8 * c) * 2) = o; } }
        LDS_WAIT(); asm volatile("" ::: "memory");
#pragma unroll
        for (int i = 0; i < 32; ++i) cur[i] = nxt[i];
        ci = ni;
    }
}
template <class Dec>
__device__ __forceinline__ void convert_flat_dyn(Frame& F, const int nitems, const Dec& dec, LAS unsigned* ctr) {
    LAS float* scr = (LAS float*)(F.lds + RING_OFF + F.wave * 16384);
    const int lane = F.lane, per = (nitems + F.G - 1) / F.G;
    float cur[32], nxt[32]; CItem ci, ni; ci.p = nullptr; ci.rs = 0; ci.dst = nullptr; ci.K = 0; ci.fp8 = false; ni = ci;
    auto ticket = [&]() -> int { unsigned t = 0u; if (lane == 0) t = __hip_atomic_fetch_add(ctr, 1u, __ATOMIC_RELAXED, __HIP_MEMORY_SCOPE_WORKGROUP); return __builtin_amdgcn_readfirstlane((int)t); };
    int j = ticket(); int it = F.vcu + j * F.G;
    if (j < per && it < nitems) { ci = dec(it, lane);
#pragma unroll
        for (int i = 0; i < 32; ++i) cur[i] = ci.p[i * ci.rs]; }
    while (j < per && it < nitems) {
        const int jn = ticket(); const int itn = F.vcu + jn * F.G;
        if (jn < per && itn < nitems) { ni = dec(itn, lane);
#pragma unroll
            for (int i = 0; i < 32; ++i) nxt[i] = ni.p[i * ni.rs]; }
        const float sc = ci.fp8 ? 32.0f : 1.0f;
#pragma unroll
        for (int i = 0; i < 32; ++i) scr[(2 * i + (lane >> 5)) * 33 + (lane & 31)] = cur[i] * sc;
        LDS_WAIT(); asm volatile("" ::: "memory");
        if (ci.fp8) { const int c = lane & 3;
#pragma unroll
            for (int jj = 0; jj < 2; ++jj) { const int n = (lane >> 2) + 16 * jj; const LAS float* s = scr + (16 * c) * 33 + n;
                v4u o; o.x = pk_fp8(s[0 * 33], s[1 * 33], s[2 * 33], s[3 * 33]); o.y = pk_fp8(s[4 * 33], s[5 * 33], s[6 * 33], s[7 * 33]);
                o.z = pk_fp8(s[8 * 33], s[9 * 33], s[10 * 33], s[11 * 33]); o.w = pk_fp8(s[12 * 33], s[13 * 33], s[14 * 33], s[15 * 33]);
                *(GAS v4u*)(ci.dst + (size_t)n * ci.K + 16 * c) = o; } }
        else { const int c = lane & 7;
#pragma unroll
            for (int jj = 0; jj < 4; ++jj) { const int n = (lane >> 3) + 8 * jj; const LAS float* s = scr + (8 * c) * 33 + n;
                v4u o; o.x = pk2(s[0 * 33], s[1 * 33]); o.y = pk2(s[2 * 33], s[3 * 33]); o.z = pk2(s[4 * 33], s[5 * 33]); o.w = pk2(s[6 * 33], s[7 * 33]);
                *(GAS v4u*)(ci.dst + ((size_t)n * ci.K + 8 * c) * 2) = o; } }
        LDS_WAIT(); asm volatile("" ::: "memory");
#pragma unroll
        for (int i = 0; i < 32; ++i) cur[i] = nxt[i];
        ci = ni; j = jn; it = itn;
    }
}
__device__ __forceinline__ const float* arg_in(int i) {
    int off = i * 8; asm volatile("" : "+s"(off));
    const char __attribute__((address_space(4)))* ka = (const char __attribute__((address_space(4)))*)__builtin_amdgcn_kernarg_segment_ptr();
    return (const float*)(const GAS float*)*(const float* const __attribute__((address_space(4)))*)(ka + off);
}
template <bool WITH_DENSE>
__device__ __forceinline__ void convert_mixer_weights_flat(Frame& F, int layer) {
    const float* win = arg_in(2) + (size_t)layer * D * NPROJ; const float* wb0 = arg_in(6) + (size_t)layer * 512 * D; const float* wb1 = arg_in(7) + (size_t)layer * 512 * D; const float* wb2 = arg_in(8) + (size_t)layer * 512 * D;
    const float* wo = arg_in(9) + (size_t)layer * D * D; const float* w1g = WITH_DENSE ? arg_in(11) : nullptr; const float* w1u = WITH_DENSE ? arg_in(12) : nullptr; const float* w2 = WITH_DENSE ? arg_in(13) : nullptr;
    GAS unsigned char* ws = F.ws;
    constexpr int NA = 16 * 96, NB = 16 * 48, NC = 16 * 96, NBR = 8 * 32, NO = 16 * 32, N1 = 16 * (2 * FF / 32), N2 = (FF / 64) * 32;
    constexpr int E0 = NA, E1 = E0 + NB, E2 = E1 + NC, E3 = E2 + NBR, E4 = E3 + NBR, E5 = E4 + NBR, E6 = E5 + NO, E7 = E6 + N1, E8 = E7 + N2;
    convert_flat(F, WITH_DENSE ? E8 : E6, [=](int it, int lane) -> CItem {
        if (it < E0) return conv_item<1>(win, nullptr, D, NPROJ, (void*)(ws + WS_WIN), 3072 / 32, 0, 48, false, it, lane);
        if (it < E1) return conv_item<1>(win, nullptr, D, NPROJ, (void*)(ws + WS_WG8), 1536 / 32, 0, 0, true, it - E0, lane);
        if (it < E2) return conv_item<0>(win, nullptr, D, NPROJ, (void*)(ws + WS_WG8 + (size_t)1536 * D), 3072 / 32, 4608, 0, true, it - E1, lane);
        if (it < E3) return conv_item<0>(wb0, nullptr, 512, D, (void*)(ws + WS_WBR), D / 32, 0, 0, false, it - E2, lane);
        if (it < E4) return conv_item<0>(wb1, nullptr, 512, D, (void*)(ws + WS_WBR + (size_t)D * 512 * 2), D / 32, 0, 0, false, it - E3, lane);
        if (it < E5) return conv_item<0>(wb2, nullptr, 512, D, (void*)(ws + WS_WBR + (size_t)2 * D * 512 * 2), D / 32, 0, 0, false, it - E4, lane);
        if (it < E6) return conv_item<0>(wo, nullptr, D, D, (void*)(ws + WS_WOUT), D / 32, 0, 0, false, it - E5, lane);
        if (it < E7) return conv_item<2>(w1g, w1u, D, FF, (void*)(ws + WS_W1), 2 * FF / 32, 0, 0, UP_FP8, it - E6, lane);
        return conv_item<0>(w2, nullptr, FF, D, (void*)(ws + WS_W2), D / 32, 0, 0, DOWN_FP8, it - E7, lane); });
}
__device__ __forceinline__ void convert_mixer_weights(Frame& F, int layer) {
    convert_matrix<1>(F, arg_in(2) + (size_t)layer * D * NPROJ, nullptr, D, NPROJ, (bf16*)(F.ws + WS_WIN), 3072 / 32, nullptr, 0, 48);
    convert_matrix<1, true>(F, arg_in(2) + (size_t)layer * D * NPROJ, nullptr, D, NPROJ, (unsigned char*)(F.ws + WS_WG8), 1536 / 32);
    convert_matrix<0, true>(F, arg_in(2) + (size_t)layer * D * NPROJ, nullptr, D, NPROJ, (unsigned char*)(F.ws + WS_WG8) + (size_t)1536 * D, 3072 / 32, nullptr, 4608);
    convert_matrix<0>(F, arg_in(6) + (size_t)layer * 512 * D, nullptr, 512, D, (bf16*)(F.ws + WS_WBR), D / 32);
    convert_matrix<0>(F, arg_in(7) + (size_t)layer * 512 * D, nullptr, 512, D, (bf16*)(F.ws + WS_WBR) + (size_t)D * 512, D / 32);
    convert_matrix<0>(F, arg_in(8) + (size_t)layer * 512 * D, nullptr, 512, D, (bf16*)(F.ws + WS_WBR) + (size_t)2 * D * 512, D / 32);
    convert_matrix<0>(F, arg_in(9) + (size_t)layer * D * D, nullptr, D, D, (bf16*)(F.ws + WS_WOUT), D / 32);
}

__constant__ float c_inv_freq[32] = {1.000000000e+00f, 7.498942018e-01f, 5.623413324e-01f, 4.216965139e-01f, 3.162277639e-01f, 2.371373922e-01f, 1.778279394e-01f, 1.333521456e-01f,
    1.000000015e-01f, 7.498941571e-02f, 5.623412877e-02f, 4.216964915e-02f, 3.162277862e-02f, 2.371373586e-02f, 1.778279431e-02f, 1.333521493e-02f,
    9.999999776e-03f, 7.498942316e-03f, 5.623413250e-03f, 4.216964822e-03f, 3.162277862e-03f, 2.371373819e-03f, 1.778279431e-03f, 1.333521446e-03f,
    1.000000047e-03f, 7.498941850e-04f, 5.623413017e-04f, 4.216965463e-04f, 3.162277862e-04f, 2.371373848e-04f, 1.778279402e-04f, 1.333521504e-04f};
__device__ __forceinline__ void rope_table(Frame& F) {
    float* cs = (float*)(F.ws + WS_TAB);
    for (int idx = F.vcu * 512 + F.tid; idx < 4096 * 32; idx += F.G * 512) {
        const int pos = idx >> 5, i = idx & 31;
        const float ang = (float)pos * c_inv_freq[i];
        const double rev = (double)ang * 0.15915494309189535; const double fr = rev - __builtin_rint(rev);
        const float f = (float)fr;
        cs[pos * 64 + i] = __builtin_amdgcn_cosf(f); cs[pos * 64 + 32 + i] = __builtin_amdgcn_sinf(f);
    }
}

template <int F8 = 0, bool X16 = false>
__device__ __forceinline__ void norm_rows(Frame& F, const void* xv, const float* gain, void* outv, unsigned char* out8 = nullptr) {
    const float* x = (const float*)xv;
    bf16* out = (bf16*)outv;
    const int gw = F.vcu * NWAVES + F.wave, NGW = F.G * NWAVES;
    f32x4 gv[4];
#pragma unroll
    for (int j = 0; j < 4; ++j) gv[j] = *((const f32x4*)gain + F.lane + 64 * j);
    for (int m0 = gw; m0 < M; m0 += 4 * NGW) {
        f32x4 v[4][4];
        if constexpr (X16) { v2u w[4][4];
#pragma unroll
            for (int q = 0; q < 4; ++q) { const int m = m0 + q * NGW; const GAS v2u* xr = (const GAS v2u*)((const bf16*)xv + (size_t)(m < M ? m : m0) * D) + F.lane;
#pragma unroll
                for (int j = 0; j < 4; ++j) w[q][j] = xr[64 * j]; }
#pragma unroll
            for (int q = 0; q < 4; ++q)
#pragma unroll
                for (int j = 0; j < 4; ++j) v[q][j] = (f32x4){bflo(w[q][j].x), bfhi(w[q][j].x), bflo(w[q][j].y), bfhi(w[q][j].y)};
        } else {
#pragma unroll
        for (int q = 0; q < 4; ++q) { const int m = m0 + q * NGW; const GAS f32x4* xr = (const GAS f32x4*)(x + (size_t)(m < M ? m : m0) * D) + F.lane;
#pragma unroll
            for (int j = 0; j < 4; ++j) v[q][j] = xr[64 * j]; }
        }
#pragma unroll
        for (int q = 0; q < 4; ++q) { const int m = m0 + q * NGW; if (m >= M) break;
            float s = 0.f;
#pragma unroll
            for (int j = 0; j < 4; ++j) s += (v[q][j].x * v[q][j].x + v[q][j].y * v[q][j].y) + (v[q][j].z * v[q][j].z + v[q][j].w * v[q][j].w);
            const float r = 1.0f / sqrtf(wave_sum(s, F.lane) * (1.f / D) + RMS_EPS);
            if (F8) { GAS unsigned* o4 = (GAS unsigned*)(out8 + (size_t)m * D) + F.lane;
#pragma unroll
                for (int j = 0; j < 4; ++j) o4[64 * j] = pk_fp8(v[q][j].x * r * gv[j].x, v[q][j].y * r * gv[j].y, v[q][j].z * r * gv[j].z, v[q][j].w * r * gv[j].w); }
            if (F8 != 2) { GAS v2u* o8 = (GAS v2u*)(out + (size_t)m * D) + F.lane;
#pragma unroll
                for (int j = 0; j < 4; ++j) { v2u w; w.x = pk2(v[q][j].x * r * gv[j].x, v[q][j].y * r * gv[j].y); w.y = pk2(v[q][j].z * r * gv[j].z, v[q][j].w * r * gv[j].w); o8[64 * j] = w; } }
        }
    }
}
__device__ __forceinline__ void final_norm(Frame& F, const bf16* xb, float* outp, const float* gain, const bf16* Y0, const bf16* Y1) {
    const int gw = F.vcu * NWAVES + F.wave, NGW = F.G * NWAVES;
    f32x4 gv[4];
#pragma unroll
    for (int j = 0; j < 4; ++j) gv[j] = *((const f32x4*)gain + F.lane + 64 * j);
    for (int m0 = gw; m0 < M; m0 += 4 * NGW) {
        v2u xw[4][4], y0[4][4], y1[4][4];
#pragma unroll
        for (int q = 0; q < 4; ++q) { const int m = m0 + q * NGW; const size_t ro = (size_t)(m < M ? m : m0) * D;
#pragma unroll
            for (int j = 0; j < 4; ++j) { xw[q][j] = *((const GAS v2u*)(xb + ro) + F.lane + 64 * j); y0[q][j] = *((const GAS v2u*)(Y0 + ro) + F.lane + 64 * j); y1[q][j] = *((const GAS v2u*)(Y1 + ro) + F.lane + 64 * j); } }
#pragma unroll
        for (int q = 0; q < 4; ++q) { const int m = m0 + q * NGW; if (m >= M) break;
            GAS f32x4* orow = (GAS f32x4*)(outp + (size_t)m * D) + F.lane; float s = 0.f; f32x4 v[4];
#pragma unroll
            for (int j = 0; j < 4; ++j) { f32x4& w = v[j];
                w.x = bflo(xw[q][j].x) + (bflo(y0[q][j].x) + bflo(y1[q][j].x)); w.y = bfhi(xw[q][j].x) + (bfhi(y0[q][j].x) + bfhi(y1[q][j].x));
                w.z = bflo(xw[q][j].y) + (bflo(y0[q][j].y) + bflo(y1[q][j].y)); w.w = bfhi(xw[q][j].y) + (bfhi(y0[q][j].y) + bfhi(y1[q][j].y));
                s += (w.x * w.x + w.y * w.y) + (w.z * w.z + w.w * w.w); }
            const float r = 1.0f / sqrtf(wave_sum(s, F.lane) * (1.f / D) + RMS_EPS);
#pragma unroll
            for (int j = 0; j < 4; ++j) orow[64 * j] = v[j] * r * gv[j];
        }
    }
}

__device__ __forceinline__ void kmean_phase(Frame& F, const bf16* P) {
    const int gw = F.vcu * NWAVES + F.wave, NGW = F.G * NWAVES;
    float* KM = (float*)(F.ws + WS_KMEAN);
    for (int it = gw; it < 64 * 16; it += NGW) {
        const int bh = it >> 4, blk = it & 15, b = bh >> 3, h = bh & 7;
        const bf16* base = P + (size_t)(b * SEQ + blk * 256 + (F.lane >> 3)) * PW + pg8::PC_K + h * 64 + (F.lane & 7) * 8;
        float a[8];
#pragma unroll
        for (int j = 0; j < 8; ++j) a[j] = 0.f;
        v4u wv[32];
#pragma unroll
        for (int i = 0; i < 32; ++i) wv[i] = *(const GAS v4u*)(base + (size_t)i * 8 * PW);
#pragma unroll
        for (int i = 0; i < 32; ++i) { const v4u w = wv[i];
            a[0] += bflo(w.x); a[1] += bfhi(w.x); a[2] += bflo(w.y); a[3] += bfhi(w.y); a[4] += bflo(w.z); a[5] += bfhi(w.z); a[6] += bflo(w.w); a[7] += bfhi(w.w); }
#pragma unroll
        for (int j = 0; j < 8; ++j) { a[j] += shx(a[j], 8, F.lane); a[j] += shx(a[j], 16, F.lane); a[j] += shx(a[j], 32, F.lane); }
        if (F.lane < 8) { float* o = KM + (size_t)it * 64 + F.lane * 8;
#pragma unroll
            for (int j = 0; j < 8; ++j) o[j] = a[j] * (1.f / 256.f); }
    }
}

__device__ __forceinline__ void conv_phase(Frame& F, bf16* P, const float* cw, const float* cbias) {
    const int gw = F.vcu * NWAVES + F.wave, NGW = F.G * NWAVES, c0 = F.lane * 8;
    float w0[8], w1[8], w2[8], bb[8];
#pragma unroll
    for (int j = 0; j < 8; ++j) { w0[j] = cw[c0 + j]; w1[j] = cw[512 + c0 + j]; w2[j] = cw[1024 + c0 + j]; bb[j] = cbias[c0 + j]; }
    for (int run = gw; run < M / 8; run += NGW) {
        const int m0 = run * 8, t0 = m0 & (SEQ - 1);
        v4u cb[8], u[10];
        u[0] = (v4u){0u, 0u, 0u, 0u}; u[1] = (v4u){0u, 0u, 0u, 0u};
        if (t0 >= 2) { u[0] = *(const GAS v4u*)(P + (size_t)(m0 - 2) * PW + pg8::PC_U + c0); u[1] = *(const GAS v4u*)(P + (size_t)(m0 - 1) * PW + pg8::PC_U + c0); }
#pragma unroll
        for (int q = 0; q < 8; ++q) { const bf16* rp = P + (size_t)(m0 + q) * PW; cb[q] = *(const GAS v4u*)(rp + pg8::PC_CB + c0); u[q + 2] = *(const GAS v4u*)(rp + pg8::PC_U + c0); }
        asm volatile("" ::: "memory");
#pragma unroll
        for (int q = 0; q < 8; ++q) {
            float y[8];
            const unsigned cbw[4] = {cb[q].x, cb[q].y, cb[q].z, cb[q].w}, a2[4] = {u[q + 2].x, u[q + 2].y, u[q + 2].z, u[q + 2].w}, a1[4] = {u[q + 1].x, u[q + 1].y, u[q + 1].z, u[q + 1].w}, a0[4] = {u[q].x, u[q].y, u[q].z, u[q].w};
#pragma unroll
            for (int k = 0; k < 4; ++k) {
                y[2 * k] = bflo(cbw[k]) * (w0[2 * k] * bflo(a0[k]) + w1[2 * k] * bflo(a1[k]) + w2[2 * k] * bflo(a2[k]) + bb[2 * k]);
                y[2 * k + 1] = bfhi(cbw[k]) * (w0[2 * k + 1] * bfhi(a0[k]) + w1[2 * k + 1] * bfhi(a1[k]) + w2[2 * k + 1] * bfhi(a2[k]) + bb[2 * k + 1]); }
            v4u o; o.x = pk2(y[0], y[1]); o.y = pk2(y[2], y[3]); o.z = pk2(y[4], y[5]); o.w = pk2(y[6], y[7]);
            *(GAS v4u*)(P + (size_t)(m0 + q) * PW + pg8::PC_CB + c0) = o; }
    }
}

__device__ __forceinline__ float ret_lg2(int h) { return h == 0 ? -0.04580368961312479f : (h == 1 ? -0.02272007650008353f : (h == 2 ? -0.011315313227834146f : -0.005646563141142063f)); }
constexpr int RT_QS = 0, RT_KS = 18432, RT_VT = 36864, RT_KZT = 36864 + 34816, RT_ST = RT_KZT;
__device__ __forceinline__ void ret_kv_phase(Frame& F, const bf16* P) {
    LAS bf16* vT = (LAS bf16*)(F.lds + RT_VT); LAS bf16* kzT = (LAS bf16*)(F.lds + RT_KZT);
    float* KVt = (float*)(F.ws + WS_KVT);
    const int fr = F.lane & 15, quad = F.lane >> 4;
    v4u pv[4], pk[2];
#define RKV_LOAD(unit_) do { const int bh_ = (unit_) >> 5, ch_ = (unit_) & 31, b_ = bh_ >> 2, h_ = bh_ & 3; const size_t r0_ = (size_t)b_ * SEQ + ch_ * 128; \
        _Pragma("unroll") for (int i = 0; i < 4; ++i) { const int p = F.tid + 512 * i, mrow = p & 127, c = p >> 7; pv[i] = *(const GAS v4u*)(P + (r0_ + mrow) * PW + pg8::PC_RV + h_ * 128 + c * 8); } \
        _Pragma("unroll") for (int i = 0; i < 2; ++i) { const int p = F.tid + 512 * i, mrow = p & 127, c = p >> 7; pk[i] = *(const GAS v4u*)(P + (r0_ + mrow) * PW + pg8::PC_RK + h_ * 64 + c * 8); } } while (0)
    if (F.vcu < 32 * 32) RKV_LOAD(F.vcu);
    for (int unit = F.vcu; unit < 32 * 32; unit += F.G) {
        const int bh = unit >> 5, h = bh & 3; const float lg = ret_lg2(h);
#pragma unroll
        for (int i = 0; i < 4; ++i) { const int p = F.tid + 512 * i, mrow = p & 127, c = p >> 7;
            const v4u w = pv[i]; const unsigned ww[4] = {w.x, w.y, w.z, w.w};
#pragma unroll
            for (int q = 0; q < 4; ++q) { vT[(c * 8 + 2 * q) * 136 + mrow] = (bf16)(ww[q] & 0xffffu); vT[(c * 8 + 2 * q + 1) * 136 + mrow] = (bf16)(ww[q] >> 16); } }
#pragma unroll
        for (int i = 0; i < 2; ++i) { const int p = F.tid + 512 * i, mrow = p & 127, c = p >> 7;
            const v4u w = pk[i]; const unsigned ww[4] = {w.x, w.y, w.z, w.w};
            const float zeta = __builtin_amdgcn_exp2f((float)(127 - mrow) * lg);
#pragma unroll
            for (int q = 0; q < 4; ++q) { kzT[(c * 8 + 2 * q) * 136 + mrow] = (bf16)f2bf(bflo(ww[q]) * zeta); kzT[(c * 8 + 2 * q + 1) * 136 + mrow] = (bf16)f2bf(bfhi(ww[q]) * zeta); } }
        __syncthreads();
        if (unit + F.G < 32 * 32) RKV_LOAD(unit + F.G);
        f32x4 acc[4];
#pragma unroll
        for (int dt = 0; dt < 4; ++dt) acc[dt] = (f32x4){0.f, 0.f, 0.f, 0.f};
#pragma unroll
        for (int ks = 0; ks < 4; ++ks) {
            const bf16x8 a = *(const LAS bf16x8*)(vT + (16 * F.wave + fr) * 136 + 32 * ks + 8 * quad);
#pragma unroll
            for (int dt = 0; dt < 4; ++dt) { const bf16x8 bb = *(const LAS bf16x8*)(kzT + (16 * dt + fr) * 136 + 32 * ks + 8 * quad);
                acc[dt] = __builtin_amdgcn_mfma_f32_16x16x32_bf16(a, bb, acc[dt], 0, 0, 0); } }
        float* o = KVt + (size_t)unit * 8192;
#pragma unroll
        for (int dt = 0; dt < 4; ++dt)
#pragma unroll
            for (int r = 0; r < 4; ++r) o[(16 * F.wave + 4 * quad + r) * 64 + 16 * dt + fr] = acc[dt][r];
        __syncthreads();
    }
#undef RKV_LOAD
}
__device__ __forceinline__ void ret_scan_phase(Frame& F) {
    const float* KVt = (const float*)(F.ws + WS_KVT); bf16* ST = (bf16*)(F.ws + WS_ST);
    for (int idx = F.vcu * 512 + F.tid; idx < 32 * 2048; idx += F.G * 512) {
        const int bh = idx >> 11, e4 = idx & 2047, h = bh & 3; const float cd = __builtin_amdgcn_exp2f(128.f * ret_lg2(h));
        float z_ = 0.f; asm volatile("" : "+v"(z_)); f32x4 s = (f32x4){z_, z_, z_, z_};
        const GAS f32x4* kp = (const GAS f32x4*)(KVt + (size_t)bh * 32 * 8192) + e4; GAS v2u* sp = (GAS v2u*)(ST + (size_t)bh * 32 * 8192) + e4;
        f32x4 kv[32];
#pragma unroll
        for (int c = 0; c < 32; ++c) kv[c] = kp[(size_t)c * 2048];
#pragma unroll
        for (int c = 0; c < 32; ++c) { v2u w; w.x = pk2(s.x, s.y); w.y = pk2(s.z, s.w); sp[(size_t)c * 2048] = w; s = s * cd + kv[c]; }
    }
}
__device__ __forceinline__ void ret_out_phase(Frame& F, bf16* P, const float* retw) {
    LAS bf16* qs = (LAS bf16*)(F.lds + RT_QS); LAS bf16* ks_ = (LAS bf16*)(F.lds + RT_KS); LAS bf16* vT = (LAS bf16*)(F.lds + RT_VT); LAS bf16* sts = (LAS bf16*)(F.lds + RT_ST);
    const bf16* ST = (const bf16*)(F.ws + WS_ST);
    const int fr = F.lane & 15, quad = F.lane >> 4, w = F.wave;
    v4u lq[2], lk[2], ls[2], lv[4];
#define ROUT_LOAD(unit_) do { const int bh_ = (unit_) >> 5, ch_ = (unit_) & 31, b_ = bh_ >> 2, h_ = bh_ & 3; const size_t r0_ = (size_t)b_ * SEQ + ch_ * 128; \
        _Pragma("unroll") for (int i = 0; i < 2; ++i) { const int p = F.tid + 512 * i, r = p >> 3, c = p & 7; \
            lq[i] = *(const GAS v4u*)(P + (r0_ + r) * PW + pg8::PC_RQ + h_ * 64 + c * 8); lk[i] = *(const GAS v4u*)(P + (r0_ + r) * PW + pg8::PC_RK + h_ * 64 + c * 8); \
            ls[i] = *(const GAS v4u*)(ST + (size_t)(unit_) * 8192 + r * 64 + c * 8); } \
        _Pragma("unroll") for (int i = 0; i < 4; ++i) { const int p = F.tid + 512 * i, mrow = p & 127, c = p >> 7; lv[i] = *(const GAS v4u*)(P + (r0_ + mrow) * PW + pg8::PC_RV + h_ * 128 + c * 8); } } while (0)
    if (F.vcu < 32 * 32) ROUT_LOAD(F.vcu);
    for (int unit = F.vcu; unit < 32 * 32; unit += F.G) {
        const int bh = unit >> 5, ch = unit & 31, b = bh >> 2, h = bh & 3; const size_t row0 = (size_t)b * SEQ + ch * 128; const float lg = ret_lg2(h);
        {
#pragma unroll
        for (int i = 0; i < 2; ++i) { const int p = F.tid + 512 * i, r = p >> 3, c = p & 7;
            *(LAS v4u*)(qs + r * 72 + c * 8) = lq[i]; *(LAS v4u*)(ks_ + r * 72 + c * 8) = lk[i]; *(LAS v4u*)(sts + r * 72 + c * 8) = ls[i]; }
#pragma unroll
        for (int i = 0; i < 4; ++i) { const int p = F.tid + 512 * i, mrow = p & 127, c = p >> 7; const unsigned ww[4] = {lv[i].x, lv[i].y, lv[i].z, lv[i].w};
#pragma unroll
            for (int q = 0; q < 4; ++q) { vT[(c * 8 + 2 * q) * 136 + mrow] = (bf16)(ww[q] & 0xffffu); vT[(c * 8 + 2 * q + 1) * 136 + mrow] = (bf16)(ww[q] >> 16); } } }
        __syncthreads();
        const int n = 16 * w + fr;
        bf16* yrow = P + (row0 + n) * PW + pg8::PC_RG + h * 128 + 4 * quad;
        v2u g8[8];
#pragma unroll
        for (int et = 0; et < 8; ++et) g8[et] = *(const GAS v2u*)(yrow + 16 * et);
        if (unit + F.G < 32 * 32) ROUT_LOAD(unit + F.G);
        asm volatile("" ::: "memory");
        bf16x8 qf[2];
#pragma unroll
        for (int k = 0; k < 2; ++k) qf[k] = *(const LAS bf16x8*)(qs + (16 * w + fr) * 72 + 32 * k + 8 * quad);
        f32x4 sT[8];
#pragma unroll
        for (int mt = 0; mt < 8; ++mt) { sT[mt] = (f32x4){0.f, 0.f, 0.f, 0.f};
            if (mt <= w) {
#pragma unroll
                for (int k = 0; k < 2; ++k) { const bf16x8 a = *(const LAS bf16x8*)(ks_ + (16 * mt + fr) * 72 + 32 * k + 8 * quad); sT[mt] = __builtin_amdgcn_mfma_f32_16x16x32_bf16(a, qf[k], sT[mt], 0, 0, 0); }
#pragma unroll
                for (int r = 0; r < 4; ++r) { const int dd = (16 * w + fr) - (16 * mt + 4 * quad + r); sT[mt][r] = (dd >= 0) ? sT[mt][r] * __builtin_amdgcn_exp2f((float)dd * lg) : 0.f; } } }
        f32x4 acc1[8], acc2[8];
#pragma unroll
        for (int et = 0; et < 8; ++et) { acc1[et] = (f32x4){0.f, 0.f, 0.f, 0.f}; acc2[et] = (f32x4){0.f, 0.f, 0.f, 0.f}; }
#pragma unroll
        for (int s = 0; s < 4; ++s) {
            if (2 * s <= w) {
                v4u pbw; pbw.x = pg8::cvt_pk_bf16(sT[2 * s][0], sT[2 * s][1]); pbw.y = pg8::cvt_pk_bf16(sT[2 * s][2], sT[2 * s][3]); pbw.z = pg8::cvt_pk_bf16(sT[2 * s + 1][0], sT[2 * s + 1][1]); pbw.w = pg8::cvt_pk_bf16(sT[2 * s + 1][2], sT[2 * s + 1][3]);
                const bf16x8 pb = __builtin_bit_cast(bf16x8, pbw);
#pragma unroll
                for (int et = 0; et < 8; ++et) { const LAS bf16* vp = vT + (16 * et + fr) * 136 + 32 * s + 4 * quad;
                    const s16x4 lo = *(const LAS s16x4*)vp, hi = *(const LAS s16x4*)(vp + 16);
                    const bf16x8 a = (bf16x8){lo[0], lo[1], lo[2], lo[3], hi[0], hi[1], hi[2], hi[3]};
                    acc1[et] = __builtin_amdgcn_mfma_f32_16x16x32_bf16(a, pb, acc1[et], 0, 0, 0); } } }
#pragma unroll
        for (int et = 0; et < 8; ++et)
#pragma unroll
            for (int k = 0; k < 2; ++k) { const bf16x8 a = *(const LAS bf16x8*)(sts + (16 * et + fr) * 72 + 32 * k + 8 * quad); acc2[et] = __builtin_amdgcn_mfma_f32_16x16x32_bf16(a, qf[k], acc2[et], 0, 0, 0); }
        const float xi = __builtin_amdgcn_exp2f((float)(n + 1) * lg);
        float ss = 0.f;
#pragma unroll
        for (int et = 0; et < 8; ++et) { acc1[et] = acc1[et] + acc2[et] * xi; ss += (acc1[et][0] * acc1[et][0] + acc1[et][1] * acc1[et][1]) + (acc1[et][2] * acc1[et][2] + acc1[et][3] * acc1[et][3]); }
        ss += shx(ss, 16, F.lane); ss += shx(ss, 32, F.lane);
        const float rinv = 1.0f / sqrtf(ss * (1.f / 128.f) + RMS_EPS);
        f32x4 wv8[8];
#pragma unroll
        for (int et = 0; et < 8; ++et) wv8[et] = *(const f32x4*)(retw + h * 128 + 16 * et + 4 * quad);
        asm volatile("" ::: "memory");
#pragma unroll
        for (int et = 0; et < 8; ++et) { const f32x4 wv = wv8[et]; const v2u g = g8[et];
            v2u o; o.x = pk2(acc1[et][0] * rinv * wv[0] * bflo(g.x), acc1[et][1] * rinv * wv[1] * bfhi(g.x)); o.y = pk2(acc1[et][2] * rinv * wv[2] * bflo(g.y), acc1[et][3] * rinv * wv[3] * bfhi(g.y));
            *(GAS v2u*)(yrow + 16 * et) = o; }
        __syncthreads();
    }
#undef ROUT_LOAD
}

__device__ __forceinline__ void router_flush(Frame& F, int nrows, int mfirst, int NGW, unsigned my_e, float my_p) {
    unsigned* tokE = (unsigned*)(F.ws + WS_TOKE); unsigned* tokIdx = (unsigned*)(F.ws + WS_TOKIDX); float* tokP = (float*)(F.ws + WS_TOKP);
    const bool valid = F.lane < nrows;
    const unsigned long long lt = (1ull << F.lane) - 1ull;
    unsigned long long mask[2 * NEXP]; unsigned mycnt = 0u;
#pragma unroll
    for (int ke = 0; ke < 2 * NEXP; ++ke) { mask[ke] = __ballot(valid && (((my_e >> (8 * (ke >> 3))) & 0xffu) == (unsigned)(ke & 7))); if (F.lane == ke) mycnt = (unsigned)__popcll(mask[ke]); }
    unsigned mybase = 0u;
    if (F.lane < 2 * NEXP) mybase = __hip_atomic_fetch_add((unsigned*)(F.ctl + CW_CNT + 64 * F.lane), mycnt, RLX_AGENT);
    unsigned idx0 = 0u, idx1 = 0u;
#pragma unroll
    for (int ke = 0; ke < 2 * NEXP; ++ke) { const unsigned bs = (unsigned)__builtin_amdgcn_readlane((int)mybase, ke);
        if ((mask[ke] >> F.lane) & 1ull) { const unsigned v = bs + (unsigned)__popcll(mask[ke] & lt); if (ke < NEXP) idx0 = v; else idx1 = v; } }
    if (valid) { const int m = mfirst + F.lane * NGW; tokE[m] = my_e; tokIdx[2 * m] = idx0; tokIdx[2 * m + 1] = idx1; tokP[m] = my_p; }
}
__device__ __forceinline__ void norm_router_rows(Frame& F, const bf16* x, const float* gain, const float* wr, unsigned char* out, const int nwv = NWAVES) {
    const int gw = F.vcu * nwv + F.wave, NGW = F.G * nwv;
    f32x4 gv[4];
#pragma unroll
    for (int j = 0; j < 4; ++j) gv[j] = *((const f32x4*)gain + F.lane + 64 * j);
    f32x4 wa[4][4], wb[4][4];
#pragma unroll
    for (int j = 0; j < 4; ++j) { const f32x4* wp = (const f32x4*)(wr + (size_t)(4 * F.lane + 256 * j) * NEXP);
#pragma unroll
        for (int c = 0; c < 4; ++c) { wa[j][c] = wp[2 * c]; wb[j][c] = wp[2 * c + 1]; } }
    unsigned my_e = 0u; float my_p = 0.f; int nb = 0, mfirst = gw;
    v2u vq[2][4], vn[2][4];
#define RT_LOAD(dst, m0_) do { _Pragma("unroll") for (int q = 0; q < 2; ++q) { const int mm = ((m0_) + q * NGW < M) ? (m0_) + q * NGW : gw; const GAS v2u* xr = (const GAS v2u*)(x + (size_t)mm * D) + F.lane; \
        _Pragma("unroll") for (int j = 0; j < 4; ++j) dst[q][j] = xr[64 * j]; } } while (0)
    RT_LOAD(vq, gw);
    for (int m0 = gw; m0 < M; m0 += 2 * NGW) {
        RT_LOAD(vn, m0 + 2 * NGW);
#pragma unroll
        for (int q = 0; q < 2; ++q) { const int m = m0 + q * NGW; if (m >= M) break;
            f32x4 v[4]; float s = 0.f;
#pragma unroll
            for (int j = 0; j < 4; ++j) { v[j] = (f32x4){bflo(vq[q][j].x), bfhi(vq[q][j].x), bflo(vq[q][j].y), bfhi(vq[q][j].y)}; s += (v[j].x * v[j].x + v[j].y * v[j].y) + (v[j].z * v[j].z + v[j].w * v[j].w); }
            const float r = 1.0f / sqrtf(wave_sum(s, F.lane) * (1.f / D) + RMS_EPS);
            GAS unsigned* o8 = (GAS unsigned*)(out + (size_t)m * D) + F.lane;
            float lg[NEXP];
#pragma unroll
            for (int e = 0; e < NEXP; ++e) lg[e] = 0.f;
#pragma unroll
            for (int j = 0; j < 4; ++j) { v[j] = v[j] * r * gv[j];
                o8[64 * j] = pk_fp8(v[j].x, v[j].y, v[j].z, v[j].w);
#pragma unroll
                for (int c = 0; c < 4; ++c) { const f32x4 a = wa[j][c], b = wb[j][c]; const float hv = v[j][c];
                    lg[0] += hv * a[0]; lg[1] += hv * a[1]; lg[2] += hv * a[2]; lg[3] += hv * a[3]; lg[4] += hv * b[0]; lg[5] += hv * b[1]; lg[6] += hv * b[2]; lg[7] += hv * b[3]; } }
#pragma unroll
            for (int e = 0; e < NEXP; ++e) lg[e] = wave_sum(lg[e], F.lane);
            int e0 = 0; float v0 = lg[0];
#pragma unroll
            for (int e = 1; e < NEXP; ++e) if (lg[e] > v0) { v0 = lg[e]; e0 = e; }
            int e1 = -1; float v1 = -INFINITY;
#pragma unroll
            for (int e = 0; e < NEXP; ++e) if (e != e0 && lg[e] > v1) { v1 = lg[e]; e1 = e; }
            const float p0 = 1.0f / (1.0f + __expf(v1 - v0));
            if (F.lane == nb) { my_e = (unsigned)e0 | ((unsigned)e1 << 8); my_p = p0; }
            if (++nb == 64) { router_flush(F, nb, mfirst, NGW, my_e, my_p); nb = 0; mfirst = m + NGW; }
        }
#pragma unroll
        for (int q = 0; q < 2; ++q)
#pragma unroll
            for (int j = 0; j < 4; ++j) vq[q][j] = vn[q][j];
    }
#undef RT_LOAD
    if (nb > 0) router_flush(F, nb, mfirst, NGW, my_e, my_p);
}
__device__ __forceinline__ void moe_tables(Frame& F, LAS int* tb) {
    if (F.tid == 0) { unsigned c0[NEXP], c1[NEXP];
#pragma unroll
        for (int e = 0; e < NEXP; ++e) { c0[e] = __hip_atomic_load((unsigned*)(F.ctl + CW_CNT + 64 * e), RLX_AGENT); c1[e] = __hip_atomic_load((unsigned*)(F.ctl + CW_CNT + 64 * (8 + e)), RLX_AGENT); }
        int t = 0;
#pragma unroll
        for (int e = 0; e < NEXP; ++e) { tb[e] = t; tb[16 + e] = (int)c0[e]; t += (int)((c0[e] + c1[e] + 255u) >> 8); }
        if (t > MAXSLOT / 256) t = MAXSLOT / 256;
        tb[8] = t; }
    __syncthreads();
}
#if MOE_GATHER_IN_GEMM
__device__ __forceinline__ void moe_gather(Frame& F, const LAS int* tb) {
    const unsigned* tokE = (const unsigned*)(F.ws + WS_TOKE); const unsigned* tokIdx = (const unsigned*)(F.ws + WS_TOKIDX); const float* tokP = (const float*)(F.ws + WS_TOKP);
    int* tokof = (int*)(F.ws + WS_TOKOF); float* pwof = (float*)(F.ws + WS_PWOF);
    for (int m = F.vcu * 512 + F.tid; m < M; m += F.G * 512) {
        const unsigned ee = tokE[m]; const int e0 = ee & 0xff, e1 = (ee >> 8) & 0xff; const float p0 = tokP[m];
        const int s0 = tb[e0] * 256 + (int)tokIdx[2 * m], s1 = tb[e1] * 256 + tb[16 + e1] + (int)tokIdx[2 * m + 1];
        tokof[s0] = m; pwof[s0] = p0; tokof[s1] = m | (1 << 30); pwof[s1] = 1.0f - p0; }
}

#else
__device__ __forceinline__ void moe_gather(Frame& F, const LAS int* tb) {
    const int gw = F.vcu * NWAVES + F.wave, NGW = F.G * NWAVES;
    const unsigned* tokE = (const unsigned*)(F.ws + WS_TOKE); const unsigned* tokIdx = (const unsigned*)(F.ws + WS_TOKIDX); const float* tokP = (const float*)(F.ws + WS_TOKP);
    int* tokof = (int*)(F.ws + WS_TOKOF); float* pwof = (float*)(F.ws + WS_PWOF);
    const unsigned char* H8 = (const unsigned char*)F.outb + OUT_H8; unsigned char* XG = (unsigned char*)F.outb + OUT_XG;
    for (int m0 = gw; m0 < M; m0 += 4 * NGW) {
        int s0[4], s1[4]; float p0[4]; v4u a[4];
#pragma unroll
        for (int q = 0; q < 4; ++q) { const int m = (m0 + q * NGW < M) ? m0 + q * NGW : m0;
            const unsigned ee = tokE[m]; const int e0 = ee & 0xff, e1 = (ee >> 8) & 0xff; p0[q] = tokP[m];
            s0[q] = tb[e0] * 256 + (int)tokIdx[2 * m]; s1[q] = tb[e1] * 256 + tb[16 + e1] + (int)tokIdx[2 * m + 1];
            a[q] = *((const GAS v4u*)(H8 + (size_t)m * D) + F.lane); }
#pragma unroll
        for (int q = 0; q < 4; ++q) { const int m = m0 + q * NGW; if (m >= M) break;
            if (F.lane == 0) { tokof[s0[q]] = m; pwof[s0[q]] = p0[q]; tokof[s1[q]] = m | (1 << 30); pwof[s1[q]] = 1.0f - p0[q]; }
            *((GAS v4u*)(XG + (size_t)s0[q] * D) + F.lane) = a[q]; *((GAS v4u*)(XG + (size_t)s1[q] * D) + F.lane) = a[q]; }
    }
}

#endif
__device__ __forceinline__ void attn_check(Frame& F, const bf16* P, int layer) {
    const int gw = F.vcu * NWAVES + F.wave, lane = F.lane;
    LAS float* sc = (LAS float*)(F.lds + RING_OFF) + F.wave * 1024;
    const float* KMb = (const float*)(F.ws + WS_KMEAN);
    const int b = gw & 7, h = (gw >> 3) & 7; const unsigned hsh = (unsigned)(gw + 977 * layer) * 2654435761u; const int t = (int)((hsh >> 7) & 4095u);
    const int j = t >> 8; const size_t row = (size_t)b * SEQ + t;
    const float q = bflo((unsigned)P[row * PW + pg8::PC_Q + h * 64 + lane]);
    float g[15]; unsigned sel = 0u; bool ambiguous = false;
#pragma unroll
    for (int kb = 0; kb < 15; ++kb) { g[kb] = -INFINITY; if (kb < j) g[kb] = wave_sum(q * KMb[((size_t)(b * 8 + h) * 16 + kb) * 64 + lane], lane); }
    float lastv = 0.f;
#pragma unroll
    for (int pass = 0; pass < 4; ++pass) { float bv = -INFINITY; int bi = -1;
#pragma unroll
        for (int kb = 0; kb < 15; ++kb) if (kb < j && !((sel >> kb) & 1u) && g[kb] > bv) { bv = g[kb]; bi = kb; }
        if (pass < 3) { if (bi >= 0) { sel |= 1u << bi; lastv = bv; } }
        else if (bi >= 0 && j > 3 && fabsf(lastv - bv) < 2e-3f * (fabsf(lastv) + fabsf(bv)) + 1e-6f) ambiguous = true; }
    int nk = 0; float mx = -INFINITY;
    for (int kb = 0; kb <= j; ++kb) { if (kb < j && !((sel >> kb) & 1u)) continue;
        const int kend = (kb < j) ? 256 : (t & 255) + 1;
        for (int k = 0; k < kend; ++k) { const size_t kr = (size_t)b * SEQ + kb * 256 + k;
            const float s = wave_sum(q * bflo((unsigned)P[kr * PW + pg8::PC_K + h * 64 + lane]), lane);
            if (lane == 0) sc[nk] = s; mx = fmaxf(mx, s); ++nk; } }
    LDS_WAIT();
    float l = 0.f, o = 0.f; nk = 0;
    for (int kb = 0; kb <= j; ++kb) { if (kb < j && !((sel >> kb) & 1u)) continue;
        const int kend = (kb < j) ? 256 : (t & 255) + 1;
        for (int k = 0; k < kend; ++k) { const size_t kr = (size_t)b * SEQ + kb * 256 + k;
            const float p = __builtin_amdgcn_exp2f(sc[nk] - mx); l += p; o += p * bflo((unsigned)P[kr * PW + pg8::PC_V + h * 64 + lane]); ++nk; } }
    o /= l;
    const float got = bflo((unsigned)P[row * PW + pg8::PC_U + h * 64 + lane]);
    float omax = fabsf(o);
#pragma unroll
    for (int sft = 1; sft < 64; sft <<= 1) omax = fmaxf(omax, shx(omax, sft, lane));
    const bool bad = !(fabsf(got - o) <= 0.04f * omax + 2e-3f);
    if (__ballot(bad) != 0ull && !ambiguous && lane == 0) __hip_atomic_fetch_add((unsigned*)(F.ctl + CW_CNT + 64 * 20), 1u, RLX_AGENT);
    if (lane == 0) __hip_atomic_fetch_add((unsigned*)(F.ctl + CW_CNT + 64 * 21), ambiguous ? 0u : 1u, RLX_AGENT);
}

#ifndef PROBE_SITE
#define PROBE_SITE -1
#endif
#ifndef CHECK_NBAD_ALLOWED
#define CHECK_NBAD_ALLOWED 0u
#endif
constexpr int N_PHASES = 22;
struct Args { const float* in[19]; float* out; unsigned char* ws; int ph_lo, ph_hi; };
__global__ void __launch_bounds__(NWAVES * 64, 2) fwd_kernel(Args args) {
    extern __shared__ __attribute__((aligned(16))) unsigned char lds[];
    Frame F;
    F.lds = (LAS unsigned char*)lds;
    F.MISC = (volatile LAS unsigned*)(F.lds + MISC_OFF);
    F.tid = threadIdx.x; F.lane = F.tid & 63; F.wave = __builtin_amdgcn_readfirstlane(F.tid >> 6);
    F.G = gridDim.x; { const int bx = blockIdx.x; F.vcu = (F.G % 8 == 0) ? (bx % 8) * (F.G / 8) + bx / 8 : bx; }
    F.ws = (GAS unsigned char*)args.ws; F.ctl = (gu32*)(F.ws + WS_CTL);
    for (int u = F.tid; u < (LDS_BYTES - LDSCTL_OFF) / 4; u += NWAVES * 64) ((LAS unsigned*)(F.lds + LDSCTL_OFF))[u] = 0u;
    __syncthreads();
    XcdBarrier bar; bar.bar = (unsigned*)(F.ctl + CW_BAR); bar.x = 0; bar.st = nullptr;
    if (!MK_SPLIT) bar = xcd_barrier_post((unsigned*)(F.ctl + CW_BAR), F.MISC + 8);
    const int lo = args.ph_lo, hi = args.ph_hi;
#define OPAQUE_LANES() do { unsigned on_ = ~0u; asm volatile("" : "+s"(on_)); int t_ = (int)__builtin_amdgcn_mbcnt_hi(on_, __builtin_amdgcn_mbcnt_lo(on_, 0u)) + 64 * F.wave; asm volatile("" : "+v"(t_)); F.tid = t_; F.lane = t_ & 63; \
        int g_ = F.G, v_ = F.vcu, bx_ = (int)blockIdx.x; GAS unsigned char* w_ = (GAS unsigned char*)args.ws; GAS float* o_ = (GAS float*)args.out; asm volatile("" : "+s"(g_), "+s"(v_), "+s"(w_), "+s"(o_), "+s"(bx_)); F.G = g_; F.vcu = v_; bx = bx_; F.ws = w_; F.ctl = (gu32*)(w_ + WS_CTL); \
        F.outb = (GAS unsigned char*)o_; XB = (bf16*)(w_ + WS_XB); P = (bf16*)(w_ + WS_P); H = (bf16*)(w_ + WS_H); } while (0)
#ifndef SITE_MASK
#define SITE_MASK 0xffffffffu
#endif
#define INS(site, k) ((((SITE_MASK) >> (site)) & 1u) && lo <= (k) && (k) < hi)
#define IN(k) (lo <= (k) && (k) < hi)
#define SEAM(k) do { if (IN((k) + 1)) { XcdBarrier b_ = bar; GAS unsigned* gb_ = (GAS unsigned*)bar.bar; asm volatile("" : "+s"(gb_)); b_.bar = (unsigned*)gb_; xcd_barrier(b_); } } while (0)
    int bx = 0;
    bf16* XB;
    bf16* P; bf16* H;
    LAS int* tb = (LAS int*)(F.lds + MISC_OFF + 64);

    if (INS(0, 0)) { OPAQUE_LANES();
        convert_mixer_weights_flat<true>(F, 0);
        rope_table(F);
        norm_rows<1>(F, arg_in(0), arg_in(1), H, (unsigned char*)(F.ws + WS_HN8));
#if PROBE_SITE == 40
        convert_mixer_weights(F, 0); convert_matrix<2, UP_FP8>(F, arg_in(11), arg_in(12), D, FF, (void*)(F.ws + WS_W1), 2 * FF / 32); convert_matrix<0, DOWN_FP8>(F, arg_in(13), nullptr, FF, D, (void*)(F.ws + WS_W2), D / 32);
        rope_table(F); norm_rows<1>(F, arg_in(0), arg_in(1), H, (unsigned char*)(F.ws + WS_HN8));
#endif
        SEAM(0);
    }
    for (int l = 0; l < 2; ++l) {
        const int pb = 1 + 10 * l;
        if (INS(1, pb + 0)) { OPAQUE_LANES();
            pg8::SchedStd S; S.T.init(M / 256, 3072 / 256, F.G, bx, WGM_INB); S.A = (const char*)H; S.B = (const char*)(F.ws + WS_WIN); S.atile = (size_t)256 * D * 2; S.btile = (size_t)256 * D * 2;
            pg8::EpiInproj E{P, (const float*)(F.ws + WS_TAB), 1, 1, 6, 1.0f};
            pg8::gemm_phase<pg8::EpiInproj, pg8::SchedStd>(F.lds + RING_OFF, F.wave, D, D, D, S, E);
            OPAQUE_LANES();
            pg8::SchedStd S8; S8.T.init(M / 256, 4608 / 256, F.G, bx, WGM_IN8); S8.A = (const char*)(F.ws + WS_HN8); S8.B = (const char*)(F.ws + WS_WG8); S8.atile = (size_t)256 * D; S8.btile = (size_t)256 * D;
            pg8::EpiQG8 E8{pg8::EpiInproj{P, (const float*)(F.ws + WS_TAB), 1, 1, 0, 0.03125f}, pg8::EpiGates8{(unsigned char*)P}};
            pg8::gemm_phase<pg8::EpiQG8, pg8::SchedStd, true>(F.lds + RING_OFF, F.wave, D / 2, D / 2, D / 2, S8, E8);
            SEAM(pb + 0);
        }
        if (INS(2, pb + 1)) { OPAQUE_LANES();
#if PROBE_SITE == 2
            kmean_phase(F, P); ret_kv_phase(F, P);
#endif
            kmean_phase(F, P);
            ret_kv_phase(F, P);
            conv_phase(F, P, arg_in(3) + (size_t)l * 3 * 512, arg_in(4) + (size_t)l * 512);
            SEAM(pb + 1);
        }
        if (INS(3, pb + 2)) { OPAQUE_LANES(); ret_scan_phase(F);
#if PROBE_SITE == 41
            ret_scan_phase(F);
#endif
            SEAM(pb + 2); }
        if (INS(4, pb + 3)) { OPAQUE_LANES();
            const attn_body::AttnTensors AT{(const attn_body::bf16*)P + pg8::PC_Q, (const attn_body::bf16*)P + pg8::PC_K, (const attn_body::bf16*)P + pg8::PC_V, (attn_body::bf16*)P + (CHECK_ATTN ? pg8::PC_U : pg8::PC_Q), (const float*)(F.ws + WS_KMEAN)};
            const attn_body::StaticOrder S((int)F.G, bx);
#if PROBE_SITE == 4
            { const attn_body::AttnTensors AT2{AT.Q, AT.K, AT.V, (attn_body::bf16*)P + pg8::PC_U, AT.KM};
              attn_body::attn_phase<attn_body::StaticOrder>((char*)lds + RING_OFF, AT2, S, F.wave); __syncthreads(); }
#endif
#if PROBE_SITE == 44
            { const attn_body::AttnTensors AT2{AT.Q, AT.K, AT.V, (attn_body::bf16*)P + pg8::PC_U, AT.KM};
              attn_body::attn_phase<attn_body::StaticOrder, 9>((char*)lds + RING_OFF, AT2, S, F.wave); __syncthreads(); }
#endif
            attn_body::attn_phase<attn_body::StaticOrder>((char*)lds + RING_OFF, AT, S, F.wave);
            __syncthreads(); OPAQUE_LANES();
            ret_out_phase(F, P, arg_in(5) + (size_t)l * 512);
            SEAM(pb + 3);
        }
        if (INS(5, pb + 4)) { OPAQUE_LANES();
            pg8::SchedBranch S; S.T.init(M / 256, D / 256, F.G, bx); S.A = (const char*)P; S.B = (const char*)(F.ws + WS_WBR);
            S.atile = (size_t)256 * PW * 2; S.btile = (size_t)256 * 512 * 2; S.bmat = (size_t)D * 512 * 2;
            static_assert(pg8::PC_Q == 0 && pg8::PC_CB == 1536 && pg8::PC_RG == 3584, "SchedBranch::a_ptr");
#if CHECK_ATTN
            attn_check(F, P, l); __syncthreads(); OPAQUE_LANES();
#endif
            pg8::EpiBranch E{(const unsigned char*)P, H};
#if PROBE_SITE == 5
            pg8::gemm_phase<pg8::EpiBranch, pg8::SchedBranch>(F.lds + RING_OFF, F.wave, 512, PW, 512, S, E);
#endif
            pg8::gemm_phase<pg8::EpiBranch, pg8::SchedBranch>(F.lds + RING_OFF, F.wave, 512, PW, 512, S, E);
            SEAM(pb + 4);
        }
        if (INS(6, pb + 5)) { OPAQUE_LANES();
            pg8::SchedStd S; S.T.init(M / 256, D / 256, F.G, bx); S.A = (const char*)H; S.B = (const char*)(F.ws + WS_WOUT); S.atile = (size_t)256 * D * 2; S.btile = (size_t)256 * D * 2;
            if (l == 0) { pg8::EpiResidB<false> E{(const void*)arg_in(0), (pg8::bf16_t*)XB, D, 1.0f}; pg8::gemm_phase<pg8::EpiResidB<false>, pg8::SchedStd>(F.lds + RING_OFF, F.wave, D, D, D, S, E); }
            else        { pg8::EpiResidB<true> E{(const void*)XB, (pg8::bf16_t*)XB, D, 1.0f};          pg8::gemm_phase<pg8::EpiResidB<true>, pg8::SchedStd>(F.lds + RING_OFF, F.wave, D, D, D, S, E); }
            SEAM(pb + 5);
        }
        if (l == 0) {
            if (INS(7, 7)) { OPAQUE_LANES(); if (UP_FP8) norm_rows<2, true>(F, XB, arg_in(10), nullptr, (unsigned char*)H); else norm_rows<0, true>(F, XB, arg_in(10), H);
                convert_mixer_weights_flat<false>(F, 1);
#if PROBE_SITE == 41
                norm_rows<0, true>(F, XB, arg_in(10), H); convert_mixer_weights(F, 1);
#endif
                SEAM(7); }
            if (INS(8, 8)) { OPAQUE_LANES();
                constexpr int EU = UP_FP8 ? 1 : 2;
                pg8::SchedStd S; S.T.init(M / 256, 2 * FF / 256, F.G, bx, WGM_UP); S.A = (const char*)H; S.B = (const char*)(F.ws + WS_W1); S.atile = (size_t)256 * D * EU; S.btile = (size_t)256 * D * EU;
                pg8::EpiSwigluT<DOWN_FP8, UP_FP8> E{(void*)(F.ws + WS_ACT), FF};
                pg8::gemm_phase<pg8::EpiSwigluT<DOWN_FP8, UP_FP8>, pg8::SchedStd, UP_FP8>(F.lds + RING_OFF, F.wave, D * EU / 2, D * EU / 2, D * EU / 2, S, E);
                SEAM(8);
            }
            if (INS(9, 9)) { OPAQUE_LANES();
                constexpr int ES = DOWN_FP8 ? 1 : 2;
                pg8::SchedStd S; S.T.init(M / 256, D / 256, F.G, bx); S.A = (const char*)(F.ws + WS_ACT); S.B = (const char*)(F.ws + WS_W2); S.atile = (size_t)256 * FF * ES; S.btile = (size_t)256 * FF * ES;
                pg8::EpiResidB<true> E{(const void*)XB, (pg8::bf16_t*)XB, D, DOWN_FP8 ? (1.0f / 256.0f) : 1.0f};
                pg8::gemm_phase<pg8::EpiResidB<true>, pg8::SchedStd, DOWN_FP8>(F.lds + RING_OFF, F.wave, FF * ES / 2, FF * ES / 2, FF * ES / 2, S, E);
                SEAM(9);
            }
            if (INS(10, 10)) { OPAQUE_LANES(); norm_rows<1, true>(F, XB, arg_in(1) + D, H, (unsigned char*)(F.ws + WS_HN8)); SEAM(10); }
        } else {
            if (INS(11, 17)) { OPAQUE_LANES();
                { int* tokof = (int*)(F.ws + WS_TOKOF); float* pwof = (float*)(F.ws + WS_PWOF);
                  for (int i = F.vcu * 512 + F.tid; i < MAXSLOT; i += F.G * 512) { tokof[i] = -1; pwof[i] = 0.f; } }
                LAS unsigned* cvt_ctr = (LAS unsigned*)(F.lds + MISC_OFF + 256);
                if (F.tid == 0) *cvt_ctr = 0u;
                __syncthreads();
                if (F.wave < ROUTER_WAVES) norm_router_rows(F, XB, arg_in(10) + D, arg_in(14), (unsigned char*)F.outb + OUT_H8, ROUTER_WAVES);
                {
                    constexpr int N1 = (D / 64) * (2 * FF / 32), N2 = (FF / 64) * (D / 32);
                    const float* wg = arg_in(15); const float* wu = arg_in(16); const float* wd = arg_in(17); unsigned char* m1 = (unsigned char*)(F.ws + WS_MW1); unsigned char* m2 = (unsigned char*)(F.ws + WS_MW2);
                    convert_flat_dyn(F, NEXP * (N1 + N2), [=](int it, int lane) -> CItem { const int e = it / (N1 + N2), r = it % (N1 + N2);
                        if (r < N1) return conv_item<2>(wg + (size_t)e * D * FF, wu + (size_t)e * D * FF, D, FF, m1 + (size_t)e * 2 * FF * D, 2 * FF / 32, 0, 0, true, r, lane);
                        return conv_item<0>(wd + (size_t)e * FF * D, nullptr, FF, D, m2 + (size_t)e * D * FF, D / 32, 0, 0, true, r - N1, lane); }, cvt_ctr);
                }
#if PROBE_SITE == 42
                for (int e = 0; e < NEXP; ++e) {
                    convert_matrix<2, true>(F, arg_in(15) + (size_t)e * D * FF, arg_in(16) + (size_t)e * D * FF, D, FF, (unsigned char*)(F.ws + WS_MW1) + (size_t)e * 2 * FF * D, 2 * FF / 32);
                    convert_matrix<0, true>(F, arg_in(17) + (size_t)e * FF * D, nullptr, FF, D, (unsigned char*)(F.ws + WS_MW2) + (size_t)e * D * FF, D / 32); }
#endif
                SEAM(17);
            }
            if (INS(12, 18)) { OPAQUE_LANES(); moe_tables(F, tb); moe_gather(F, tb);
#if PROBE_SITE == 41
                moe_gather(F, tb);
#endif
                SEAM(18); }
            if (INS(13, 19)) { OPAQUE_LANES();
                moe_tables(F, tb);
                pg8::SchedMoeBal<1> S; S.T.init(tb[8], 2 * FF / 256, F.G, bx, WGM_G1); S.A = (const char*)F.outb + (MOE_GATHER_IN_GEMM ? OUT_H8 : OUT_XG); S.B = (const char*)(F.ws + WS_MW1); S.tokof = (const int*)(F.ws + WS_TOKOF); S.toktab = (unsigned)(LDSCTL_OFF + 4096 - RING_OFF);
                S.atile = (size_t)256 * D; S.btile = (size_t)256 * D; S.bexp = (size_t)2 * FF * D; S.tbase = tb;
                S.cnt = (unsigned*)(F.ctl + CW_DEP); S.target = 2 * FF / 256; S.balance(tb[8] * (2 * FF / 256), tb[8] * (D / 256)); S.pack_tables();
                pg8::EpiSwiglu8 E{(unsigned char*)(F.ws + WS_ACTM), FF};
#if PROBE_SITE == 13
                pg8::gemm_phase<pg8::EpiSwiglu8, pg8::SchedMoeBal<1>, true>(F.lds + RING_OFF, F.wave, D / 2, D / 2, D / 2, S, E);
#endif
                pg8::gemm_phase<pg8::EpiSwiglu8, pg8::SchedMoeBal<1>, true>(F.lds + RING_OFF, F.wave, D / 2, D / 2, D / 2, S, E);
#if MK_SPLIT
                SEAM(19);
#endif
            }
            if (INS(14, 20)) { OPAQUE_LANES();
                moe_tables(F, tb);
                pg8::SchedMoeBal<2> S; S.T.init(tb[8], D / 256, F.G, bx); S.A = (const char*)(F.ws + WS_ACTM); S.B = (const char*)(F.ws + WS_MW2);
                S.atile = (size_t)256 * FF; S.btile = (size_t)256 * FF; S.bexp = (size_t)D * FF; S.tbase = tb;
                S.cnt = (unsigned*)(F.ctl + CW_DEP); S.target = 2 * FF / 256; S.balance(tb[8] * (2 * FF / 256), tb[8] * (D / 256)); S.pack_tables();
                pg8::EpiMoeY E{(pg8::bf16_t*)(F.ws + WS_Y0), (const int*)(F.ws + WS_TOKOF), (const float*)(F.ws + WS_PWOF), (WS_Y1 - WS_Y0) / 2};
#if PROBE_SITE == 14
                pg8::gemm_phase<pg8::EpiMoeY, pg8::SchedMoeBal<2>, true>(F.lds + RING_OFF, F.wave, FF / 2, FF / 2, FF / 2, S, E);
#endif
                pg8::gemm_phase<pg8::EpiMoeY, pg8::SchedMoeBal<2>, true>(F.lds + RING_OFF, F.wave, FF / 2, FF / 2, FF / 2, S, E);
                SEAM(20);
            }
            if (INS(15, 21)) { OPAQUE_LANES(); final_norm(F, XB, (float*)F.outb, arg_in(18), (const bf16*)(F.ws + WS_Y0), (const bf16*)(F.ws + WS_Y1));
#if CHECK_ATTN
                { const unsigned nbad = __hip_atomic_load((unsigned*)(F.ctl + CW_CNT + 64 * 20), RLX_AGENT), nchk = __hip_atomic_load((unsigned*)(F.ctl + CW_CNT + 64 * 21), RLX_AGENT);
                  if (nbad > CHECK_NBAD_ALLOWED || nchk < 3000u) { const float v = (nbad > CHECK_NBAD_ALLOWED) ? __builtin_nanf("") : 0.f; __syncthreads();
                      for (int i = F.vcu * 512 + F.tid; i < M * D / 4; i += F.G * 512) ((GAS f32x4*)F.outb)[i] = (f32x4){v, v, v, v}; } }
#endif
            }
        }
    }
#undef IN
#undef INS
#undef SEAM
}

extern "C" void kernel_launch(void* const* d_in, const int* in_sizes, int n_in, void* d_out, int out_size, void* d_ws, size_t ws_size, hipStream_t stream) {
    static int grid = 0;
    if (grid == 0) {
        if (n_in != 19 || in_sizes[0] != M * D || out_size != M * D || ws_size < WS_END) { fprintf(stderr, "kernel_launch: unexpected problem shape or workspace (%d inputs, ws %zu < %zu); nothing launched\n", n_in, ws_size, (size_t)WS_END); grid = -1; return; }
        int dev = 0, cus = 0, per_cu = 0;
        if (hipGetDevice(&dev) != hipSuccess || hipDeviceGetAttribute(&cus, hipDeviceAttributeMultiprocessorCount, dev) != hipSuccess) { grid = -1; return; }
        if (hipFuncSetAttribute((const void*)fwd_kernel, hipFuncAttributeMaxDynamicSharedMemorySize, LDS_BYTES) != hipSuccess) { fprintf(stderr, "kernel_launch: hipFuncSetAttribute failed\n"); grid = -1; return; }
        if (hipOccupancyMaxActiveBlocksPerMultiprocessor(&per_cu, (const void*)fwd_kernel, NWAVES * 64, LDS_BYTES) != hipSuccess || per_cu < 1)
            fprintf(stderr, "kernel_launch: note: occupancy query reports %d workgroups per CU\n", per_cu);
        (void)hipGetLastError();
        grid = cus;
    }
    if (grid < 0) return;
    if (hipMemsetAsync((char*)d_ws + WS_CTL, 0, CTL_ZERO_BYTES, stream) != hipSuccess) return;
    Args a{};
    for (int i = 0; i < 19; ++i) a.in[i] = (const float*)d_in[i];
    a.out = (float*)d_out; a.ws = (unsigned char*)d_ws;
#if MK_SPLIT
    for (int p = 0; p < N_PHASES; ++p) { a.ph_lo = p; a.ph_hi = p + 1; hipLaunchKernelGGL(fwd_kernel, dim3(grid), dim3(NWAVES * 64), LDS_BYTES, stream, a); }
#else
    a.ph_lo = 0; a.ph_hi = N_PHASES;
    hipLaunchKernelGGL(fwd_kernel, dim3(grid), dim3(NWAVES * 64), LDS_BYTES, stream, a);
#endif
}
```
